# Optimizing an MI355X kernel written in HIP

```python
import functools
import jax, jax.numpy as jnp
from jax import lax
import numpy as np

D_MODEL = 1024
BATCH = 4
SEQ = 4096
DEPTH = 2
DEC_BATCH = 128
DEC_SEQ = 8
PAST_LEN = 16384
PAGE_SIZE = 128

HEAD_DIM = 64
N_HEADS = 8
N_KV_HEADS = 2
KV_WIDTH = N_KV_HEADS * HEAD_DIM
WINDOW = 128
ATTN_BLOCK = 128
ROPE_THETA = 500000.0
ROPE_DIMS = HEAD_DIM // 4
ATTN_WIDTH = N_HEADS * HEAD_DIM
GMLP_WIDTH = D_MODEL - ATTN_WIDTH
GMLP_GROUPS = 4
GMLP_GW = GMLP_WIDTH // GMLP_GROUPS
CHUNK = 128
MIX_WIDTH = ATTN_WIDTH + GMLP_WIDTH
IN_WIDTH = ATTN_WIDTH + 2 * KV_WIDTH + 2 * GMLP_WIDTH
IN_SPLITS = (ATTN_WIDTH, ATTN_WIDTH + KV_WIDTH, ATTN_WIDTH + 2 * KV_WIDTH,
             ATTN_WIDTH + 2 * KV_WIDTH + GMLP_WIDTH)
D_FF = 2816
CONV_W = 3
EPS = 1e-6
NEG = -1e30

kernel_name = 'hymba_swa_sink_gmlp_convffn_adaln_step'


def _rmsnorm(x, g):
    xf = x.astype(jnp.float32)
    y = xf * lax.rsqrt(jnp.mean(xf * xf, axis=-1, keepdims=True) + EPS)
    return (y * g.astype(jnp.float32)).astype(x.dtype)


def _layernorm(x, g, b):
    xf = x.astype(jnp.float32)
    mu = jnp.mean(xf, axis=-1, keepdims=True)
    xc = xf - mu
    y = xc * lax.rsqrt(jnp.mean(xc * xc, axis=-1, keepdims=True) + EPS)
    return (y * g.astype(jnp.float32) + b.astype(jnp.float32)).astype(x.dtype)


def _rope(x, pos):
    half = ROPE_DIMS // 2
    inv = ROPE_THETA ** (-jnp.arange(0, ROPE_DIMS, 2, dtype=jnp.float32) / ROPE_DIMS)
    ang = pos.astype(jnp.float32)[:, None] * inv[None, :]
    cos = jnp.cos(ang)[:, None, :]
    sin = jnp.sin(ang)[:, None, :]
    xr = x[..., :ROPE_DIMS].astype(jnp.float32)
    x1, x2 = xr[..., :half], xr[..., half:]
    rot = jnp.concatenate([x1 * cos - x2 * sin, x2 * cos + x1 * sin], axis=-1).astype(x.dtype)
    return jnp.concatenate([rot, x[..., ROPE_DIMS:]], axis=-1)


def _sink_attention(q, k, v, mask, sinks):
    lead = q.shape[:-3]
    tq = q.shape[-3]
    grp = N_HEADS // N_KV_HEADS
    qg = q.reshape(*lead, tq, N_KV_HEADS, grp, HEAD_DIM)
    s = jnp.einsum('...qkgd,...skd->...kgqs', qg, k).astype(jnp.float32) * (HEAD_DIM ** -0.5)
    s = jnp.where(mask, s, NEG)
    sink = jnp.broadcast_to(sinks.astype(jnp.float32).reshape(N_KV_HEADS, grp, 1, 1), s.shape[:-1] + (1,))
    p = jax.nn.softmax(jnp.concatenate([s, sink], axis=-1), axis=-1)[..., :-1]
    o = jnp.einsum('...kgqs,...skd->...qkgd', p.astype(v.dtype), v)
    return o.reshape(*lead, tq, N_HEADS * HEAD_DIM)


def _swa_prompt(q, k, v, sinks):
    b, t = q.shape[:2]
    nb = t // ATTN_BLOCK
    qb = q.reshape(b, nb, ATTN_BLOCK, N_HEADS, HEAD_DIM)

    def band(z):
        zb = z.reshape(b, nb, ATTN_BLOCK, N_KV_HEADS, HEAD_DIM)
        prev = jnp.pad(zb[:, :-1], ((0, 0), (1, 0), (0, 0), (0, 0), (0, 0)))
        return jnp.concatenate([prev, zb], axis=2)

    blk = jnp.arange(nb)[:, None]
    qpos = blk * ATTN_BLOCK + jnp.arange(ATTN_BLOCK)[None, :]
    kpos = (blk - 1) * ATTN_BLOCK + jnp.arange(2 * ATTN_BLOCK)[None, :]
    diff = qpos[:, :, None] - kpos[:, None, :]
    mask = (diff >= 0) & (diff < WINDOW) & (kpos[:, None, :] >= 0)
    o = _sink_attention(qb, band(k), band(v), mask[:, None, None], sinks)
    return o.reshape(b, t, ATTN_WIDTH)


def _swa_sample(q, k, v, sinks, k_cache, v_cache):
    b, t = q.shape[:2]
    wc = k_cache.shape[1]
    kk = jnp.concatenate([k_cache.astype(k.dtype), k], axis=1)
    vv = jnp.concatenate([v_cache.astype(v.dtype), v], axis=1)
    qpos = PAST_LEN + jnp.arange(t)
    kpos = jnp.concatenate([PAST_LEN - wc + jnp.arange(wc), qpos])
    diff = qpos[:, None] - kpos[None, :]
    mask = (diff >= 0) & (diff < WINDOW)
    return _sink_attention(q, kk, vv, mask, sinks).reshape(b, t, ATTN_WIDTH)


def _spatial_gate(u, v, w_s, b_s):
    b, l = u.shape[:2]
    lp = -(-l // CHUNK) * CHUNK
    vp = jnp.pad(v, ((0, 0), (0, lp - l), (0, 0))).reshape(b, lp // CHUNK, CHUNK, GMLP_GROUPS, GMLP_GW)
    causal = jnp.tril(jnp.ones((CHUNK, CHUNK), dtype=bool))
    w = jnp.where(causal[None], w_s, jnp.zeros((), w_s.dtype))
    z = jnp.einsum('gts,bcsgw->bctgw', w, vp) + b_s.T[None, None, :, :, None]
    return u * z.reshape(b, lp, GMLP_WIDTH)[:, :l]


def _layer(x, c, pos, attend, conv_prev, p):
    b, t, _ = x.shape
    mod = jnp.dot(jax.nn.silu(c), p['w_ada']) + p['b_ada']
    sh_a, sc_a, g_a, sh_f, sc_f, g_f = [m[:, None, :] for m in jnp.split(mod, 6, axis=-1)]
    h = _rmsnorm(x, p['g_attn']) * (1 + sc_a) + sh_a
    q, k, v, zu, zv = jnp.split(h @ p['w_in'], IN_SPLITS, axis=-1)
    q = _rope(_rmsnorm(q.reshape(b, t, N_HEADS, HEAD_DIM), p['g_q']), pos)
    k = _rope(_rmsnorm(k.reshape(b, t, N_KV_HEADS, HEAD_DIM), p['g_k']), pos)
    v = v.reshape(b, t, N_KV_HEADS, HEAD_DIM)
    a_out = attend(q, k, v, p['sinks'])
    u = jax.nn.gelu(zu)
    vg = _layernorm(jax.nn.gelu(zv).reshape(b, t, GMLP_GROUPS, GMLP_GW), p['ln_g'], p['ln_b'])
    vg = vg.reshape(b, t, GMLP_WIDTH)
    s_out = _spatial_gate(u, vg, p['w_s'], p['b_s'])
    x = x + g_a * (jnp.concatenate([a_out, s_out], axis=-1) @ p['w_out'])
    h = _rmsnorm(x, p['g_ffn']) * (1 + sc_f) + sh_f
    hu = h @ p['w_ffn_in']
    ext = jnp.concatenate([conv_prev.astype(hu.dtype), hu], axis=1)
    conv = p['conv_b'] + sum(p['conv_w'][j] * ext[:, j:j + t] for j in range(CONV_W))
    gate, up = jnp.split(conv, 2, axis=-1)
    x = x + g_f * ((jax.nn.silu(gate) * up) @ p['w_ffn_out'])
    return x, k, v, vg, ext[:, -(CONV_W - 1):]


def setup_inputs(seed: int = 0) -> dict:
    key = jax.random.key(seed)
    ks = jax.random.split(key, 32)
    f32 = jnp.float32
    nrm = lambda k, shape, s: jax.random.normal(k, shape, f32) * s
    return {
        'x_prompt': nrm(ks[0], (BATCH, SEQ, D_MODEL), 1.0),
        'x_sample': nrm(ks[1], (DEC_BATCH, DEC_SEQ, D_MODEL), 1.0),
        'cache_k': nrm(ks[2], (DEPTH, DEC_BATCH, WINDOW, N_KV_HEADS, HEAD_DIM), 1.0),
        'cache_v': nrm(ks[3], (DEPTH, DEC_BATCH, WINDOW, N_KV_HEADS, HEAD_DIM), 1.0),
        'cache_conv': nrm(ks[4], (DEPTH, DEC_BATCH, CONV_W - 1, 2 * D_FF), 1.0),
        'c_prompt': nrm(ks[5], (BATCH, D_MODEL), 1.0),
        'c_sample': nrm(ks[6], (DEC_BATCH, D_MODEL), 1.0),
        'w_ada': nrm(ks[7], (DEPTH, D_MODEL, 6 * D_MODEL), 0.5 * D_MODEL ** -0.5),
        'b_ada': nrm(ks[8], (DEPTH, 6 * D_MODEL), 0.02),
        'g_attn': 1.0 + nrm(ks[9], (DEPTH, D_MODEL), 0.02),
        'w_in': nrm(ks[10], (DEPTH, D_MODEL, IN_WIDTH), D_MODEL ** -0.5),
        'g_q': 1.0 + nrm(ks[11], (DEPTH, HEAD_DIM), 0.02),
        'g_k': 1.0 + nrm(ks[12], (DEPTH, HEAD_DIM), 0.02),
        'sinks': nrm(ks[13], (DEPTH, N_HEADS), 1.0),
        'ln_g': 1.0 + nrm(ks[14], (DEPTH, GMLP_GROUPS, GMLP_GW), 0.02),
        'ln_b': nrm(ks[15], (DEPTH, GMLP_GROUPS, GMLP_GW), 0.02),
        'w_s': nrm(ks[16], (DEPTH, GMLP_GROUPS, CHUNK, CHUNK), CHUNK ** -0.5),
        'b_s': 1.0 + nrm(ks[17], (DEPTH, GMLP_GROUPS, CHUNK), 0.1),
        'w_out': nrm(ks[18], (DEPTH, MIX_WIDTH, D_MODEL), MIX_WIDTH ** -0.5),
        'g_ffn': 1.0 + nrm(ks[19], (DEPTH, D_MODEL), 0.02),
        'w_ffn_in': nrm(ks[20], (DEPTH, D_MODEL, 2 * D_FF), D_MODEL ** -0.5),
        'conv_w': nrm(ks[21], (DEPTH, CONV_W, 2 * D_FF), CONV_W ** -0.5),
        'conv_b': nrm(ks[22], (DEPTH, 2 * D_FF), 0.02),
        'w_ffn_out': nrm(ks[23], (DEPTH, D_FF, D_MODEL), D_FF ** -0.5),
    }


def reference(x_prompt, x_sample, cache_k, cache_v, cache_conv, c_prompt, c_sample,
              w_ada, b_ada, g_attn, w_in, g_q, g_k, sinks, ln_g, ln_b, w_s, b_s, w_out,
              g_ffn, w_ffn_in, conv_w, conv_b, w_ffn_out):
    pos_p = jnp.arange(x_prompt.shape[1], dtype=jnp.int32)
    pos_s = PAST_LEN + jnp.arange(x_sample.shape[1], dtype=jnp.int32)
    xp, xs = x_prompt, x_sample
    kp_l, vp_l, cp_l, ks_l, vs_l, gs_l, cs_l = [], [], [], [], [], [], []
    for l in range(DEPTH):
        p = {'w_ada': w_ada[l], 'b_ada': b_ada[l], 'g_attn': g_attn[l], 'w_in': w_in[l],
             'g_q': g_q[l], 'g_k': g_k[l], 'sinks': sinks[l], 'ln_g': ln_g[l], 'ln_b': ln_b[l],
             'w_s': w_s[l], 'b_s': b_s[l], 'w_out': w_out[l], 'g_ffn': g_ffn[l],
             'w_ffn_in': w_ffn_in[l], 'conv_w': conv_w[l], 'conv_b': conv_b[l],
             'w_ffn_out': w_ffn_out[l]}
        zero_conv = jnp.zeros((xp.shape[0], CONV_W - 1, 2 * D_FF), xp.dtype)
        xp, kp, vp, _, cp = _layer(xp, c_prompt, pos_p, _swa_prompt, zero_conv, p)
        kp_l.append(kp[:, -WINDOW:])
        vp_l.append(vp[:, -WINDOW:])
        cp_l.append(cp)
        attend_s = functools.partial(_swa_sample, k_cache=cache_k[l], v_cache=cache_v[l])
        xs, ks_, vs_, gs_, cs_ = _layer(xs, c_sample, pos_s, attend_s, cache_conv[l], p)
        ks_l.append(ks_)
        vs_l.append(vs_)
        gs_l.append(gs_)
        cs_l.append(cs_)
    new_k_prompt = jnp.stack(kp_l)
    new_v_prompt = jnp.stack(vp_l)
    new_conv_prompt = jnp.stack(cp_l)
    new_k_sample = jnp.stack(ks_l)
    new_v_sample = jnp.stack(vs_l)
    new_gmlp_v_sample = jnp.stack(gs_l)
    new_conv_sample = jnp.stack(cs_l)
    return (xp, xs, new_k_prompt, new_v_prompt, new_conv_prompt,
            new_k_sample, new_v_sample, new_gmlp_v_sample, new_conv_sample)
```

```cpp
#include <hip/hip_runtime.h>
#include <hip/hip_cooperative_groups.h>
#include <cstdio>
#include <cmath>
namespace cg = cooperative_groups;

#define LAS __attribute__((address_space(3)))
typedef unsigned short bf16_t;
typedef short bf16x8 __attribute__((ext_vector_type(8)));
typedef float f32x4 __attribute__((ext_vector_type(4)));
typedef float f32x2 __attribute__((ext_vector_type(2)));
typedef unsigned u32x4 __attribute__((ext_vector_type(4)));
typedef unsigned u32x2 __attribute__((ext_vector_type(2)));

#ifndef ONE_LAUNCH
#define ONE_LAUNCH 1
#endif

constexpr int NPR = 16384, NSM = 1024, MT = 17408;
constexpr int NPH = 18;
constexpr size_t O_Y = 0;
constexpr size_t O_NKP = 17825792, O_NVP = 17956864, O_NCP = 18087936, O_NKS = 18178048, O_NVS = 18440192, O_NGS = 18702336, O_NCS = 19750912;
constexpr size_t W_ADA = 0;
constexpr size_t W_IN = W_ADA + 12288ull * 1024 * 2;
constexpr size_t W_OUT = W_IN + 2ull * 1792 * 1024 * 2;
constexpr size_t W_FIN = W_OUT + 2ull * 1024 * 1024 * 2;
constexpr size_t W_FOUT = W_FIN + 2ull * 5632 * 1024 * 2;
constexpr size_t W_CS = W_FOUT + 2ull * 1024 * 2816 * 2;
constexpr size_t W_MOD = W_CS + 256ull * 1024 * 2;
constexpr size_t W_ROPE = W_MOD + 132ull * 12288 * 4;
constexpr size_t W_WS = W_ROPE + 4104ull * 16 * 4;
constexpr size_t W_H = W_WS + 2ull * 4 * 128 * 128 * 2;
constexpr size_t W_R = W_H + (size_t)MT * 1024 * 2;
constexpr size_t W_Q = W_R;
constexpr size_t W_KB = W_Q + (size_t)MT * 512 * 2;
constexpr size_t W_VB = W_KB + (size_t)MT * 128 * 2;
constexpr size_t W_U = W_VB + (size_t)MT * 128 * 2;
constexpr size_t W_VG = W_U + (size_t)MT * 512 * 2;
constexpr size_t W_MIX = W_VG + (size_t)MT * 512 * 2;
constexpr size_t W_HALO = W_R + (size_t)MT * 2816 * 2;
constexpr size_t W_XB = W_HALO + 256ull * 4 * 5632 * 2;
constexpr size_t W_BAR = W_XB + (size_t)MT * 1024 * 2;
constexpr size_t W_END = W_BAR + 32768;

constexpr int LDS_STAGE = 131072, LDS_MISC = LDS_STAGE + 8192, LDS_BYTES = LDS_MISC + 16;

struct Params {
    const float* in[24];
    float* out;
    unsigned char* ws;
    double inv[8];
    int ph_lo, ph_hi;
};

__device__ __forceinline__ unsigned cvt_pk_bf16(float lo, float hi) { unsigned r; asm volatile("v_cvt_pk_bf16_f32 %0, %1, %2" : "=v"(r) : "v"(lo), "v"(hi)); return r; }
__device__ __forceinline__ unsigned cvt_pk_bf16_mfma(float lo, float hi) { unsigned r; asm volatile("s_nop 7\n\ts_nop 7\n\tv_cvt_pk_bf16_f32 %0, %1, %2" : "=v"(r) : "v"(lo), "v"(hi)); return r; }
__device__ __forceinline__ float bf2f(bf16_t b) { return __uint_as_float(((unsigned)b) << 16); }
__device__ __forceinline__ float fast_exp(float x) { return __builtin_amdgcn_exp2f(x * 1.4426950408889634f); }
__device__ __forceinline__ float silu_f(float x) { return x * __builtin_amdgcn_rcpf(1.0f + fast_exp(-x)); }
__device__ __forceinline__ float gelu_f(float x) { const float u = 1.5957691216057308f * (x + 0.044715f * x * x * x); return x * __builtin_amdgcn_rcpf(1.0f + fast_exp(-u)); }
template <int CTRL> __device__ __forceinline__ float dppf(float x) { return __builtin_bit_cast(float, __builtin_amdgcn_update_dpp(0, __builtin_bit_cast(int, x), CTRL, 0xf, 0xf, false)); }
template <int N> __device__ __forceinline__ f32x4 ror4(f32x4 v) { f32x4 r; r[0] = dppf<0x120 + N>(v[0]); r[1] = dppf<0x120 + N>(v[1]); r[2] = dppf<0x120 + N>(v[2]); r[3] = dppf<0x120 + N>(v[3]); return r; }
__device__ __forceinline__ float xsum_fq(float v) { v += __shfl_xor(v, 16); v += __shfl_xor(v, 32); return v; }
__device__ __forceinline__ float xmax_fq(float v) { v = fmaxf(v, __shfl_xor(v, 16)); v = fmaxf(v, __shfl_xor(v, 32)); return v; }
__device__ __forceinline__ u32x2 pack4(f32x4 v) { u32x2 w; w.x = cvt_pk_bf16(v[0], v[1]); w.y = cvt_pk_bf16(v[2], v[3]); return w; }
__device__ __forceinline__ u32x2 pack4_mfma(f32x4 v) { u32x2 w; w.x = cvt_pk_bf16_mfma(v[0], v[1]); w.y = cvt_pk_bf16(v[2], v[3]); return w; }
__device__ __forceinline__ u32x4 pack8(f32x4 a, f32x4 b) { u32x4 w; w.x = cvt_pk_bf16(a[0], a[1]); w.y = cvt_pk_bf16(a[2], a[3]); w.z = cvt_pk_bf16(b[0], b[1]); w.w = cvt_pk_bf16(b[2], b[3]); return w; }

__device__ __forceinline__ int tid_opaque() { int t = threadIdx.x; asm volatile("" : "+v"(t)); return t; }

namespace pg8 {
constexpr int BM = 256, BK = 64, HALF = 128, HTB = HALF * BK * 2, NXCD = 8, WGM = 8;
__device__ __forceinline__ int lds_byte(int r, int c) { const int st = (r >> 4) * 2 + (c >> 5), rr = r & 15, cc = c & 31, ob = rr * 64 + cc * 2; return st * 1024 + (ob ^ (((ob >> 9) & 1) << 5)); }
__device__ __forceinline__ void stage_rc(int b, int& R, int& C) { const int st = b / 1024, sb = b % 1024, swz = sb ^ (((sb >> 9) & 1) << 5); R = (st >> 1) * 16 + swz / 64; C = (st & 1) * 32 + (swz % 64) / 2; }
__device__ __forceinline__ int perm32(int rho) { const int n = rho >> 4, i = rho & 15; return 8 * (i >> 2) + 4 * n + (i & 3); }
struct Unit { int pm, pn, k0, nk, split, tl, S; };
struct Gemm { const bf16_t* A; const bf16_t* Bt; int M, N, K; };
struct StaticOrder {
    int nM, nN, nwg, G, c, R, Lf, S, nt, heavy_first, reverse;
    __device__ __forceinline__ void init(int M, int N, int K, int G_, int c_, bool allow_split) {
        nM = M / BM; nN = N / BM; nwg = nM * nN; G = G_; c = c_; nt = K / BK; heavy_first = 0; reverse = 0;
        R = nwg / G; Lf = nwg - R * G; S = 1;
        if (allow_split && Lf > 0 && Lf * 2 <= G) { int smax = G / Lf; int s = nt / 4; while (s > 1 && (s > smax || nt % (2 * s) != 0)) --s; S = s; }
    }
    __device__ __forceinline__ void tile_pmpn(int L, Unit& u) const {
        int wgid = L; if (reverse) { const int xq = L % NXCD, xo = L / NXCD; const int cnt = nwg / NXCD + (xq < nwg % NXCD ? 1 : 0); wgid = xq + (cnt - 1 - xo) * NXCD; }
        { const int q = nwg / NXCD, r = nwg % NXCD, xcd = wgid % NXCD, off = wgid / NXCD; wgid = (xcd < r ? xcd * (q + 1) : r * (q + 1) + (xcd - r) * q) + off; }
        const int nig = WGM * nN, gid = wgid / nig, fm = gid * WGM, gsz = (nM - fm) < WGM ? (nM - fm) : WGM;
        u.pm = fm + ((wgid % nig) % gsz); u.pn = (wgid % nig) / gsz;
        if (heavy_first) { const int q = u.pn; u.pn = q < 2 ? 5 + q : (q < 4 ? 1 + q : q - 4); }
    }
    __device__ __forceinline__ bool next(int i, Unit& u) const {
        int L = 0, k0 = 0, nk = nt, split = 0, tl = 0; bool ok = false;
        if (i < R) { L = i * G + c; ok = true; }
        else if (i == R && S == 1) { L = R * G + c; ok = c < Lf; }
        else if (i == R) { tl = c % Lf; L = R * G + tl; nk = nt / S; k0 = (c / Lf) * nk; split = 1; ok = c < Lf * S; }
        if (!ok) L = 0;
        Unit t; tile_pmpn(L, t);
        u.pm = t.pm; u.pn = t.pn; u.k0 = k0; u.nk = nk; u.split = split; u.tl = tl; u.S = S;
        return ok;
    }
};

template <class Epi>
__device__ __forceinline__ void gemm_phase(LAS unsigned char* lds, const Gemm g, const StaticOrder& S, const Epi& E) {
    const int tid = tid_opaque(), wid = __builtin_amdgcn_readfirstlane(tid >> 6), lane = tid & 63, wr = wid >> 2, wc = wid & 3, fr = lane & 15, fq = lane >> 4;
    const int K = g.K;
    unsigned voffA[2], voffB[2];
#pragma unroll
    for (int i = 0; i < 2; ++i) { int R, C; stage_rc(tid * 16 + i * 8192, R, C); const int Rb = Epi::PERM ? ((R & ~31) + perm32(R & 31)) : R;
        const int Ra = Epi::APERM ? ((R & 64) | ((R & 15) << 2) | ((R >> 4) & 3)) : R;
        voffA[i] = (unsigned)(Ra * K + C) * 2u; voffB[i] = (unsigned)(Rb * K + C) * 2u; }
    const size_t kstep = (size_t)(BK * 2);
    const size_t hstep = (size_t)HALF * K * 2;
    const size_t tstep = 2 * hstep;
    const unsigned ldsw = (unsigned)wid * 1024u;
    const int aoff = lds_byte(wr * 64 + fr, fq * 8), boff = lds_byte(wc * 32 + fr, fq * 8);
#define PG8_SA(b, h) (((b) * 2 + (h)) * HTB)
#define PG8_SB(b, h) ((4 + (b) * 2 + (h)) * HTB)
#define PG8_STAGE(bufoff, gbase, voff) do { _Pragma("unroll") for (int _i = 0; _i < 2; ++_i) \
        __builtin_amdgcn_global_load_lds((const unsigned*)((const char*)(gbase) + (voff)[_i]), (LAS unsigned*)(lds + (bufoff) + ldsw + _i * 8192), 16, 0, 0); } while (0)
#define PG8_LDA(dst, b, h) do { _Pragma("unroll") for (int m = 0; m < 4; ++m) _Pragma("unroll") for (int k = 0; k < 2; ++k) dst[m][k] = *(const LAS bf16x8*)(lds + PG8_SA(b, h) + aoff + m * 2048 + k * 1024); } while (0)
#define PG8_LDB(dst, b, h) do { _Pragma("unroll") for (int n = 0; n < 2; ++n) _Pragma("unroll") for (int k = 0; k < 2; ++k) dst[n][k] = *(const LAS bf16x8*)(lds + PG8_SB(b, h) + boff + n * 2048 + k * 1024); } while (0)
#define PG8_MMA(ai, bj, At, Bt) do { __builtin_amdgcn_s_setprio(1); _Pragma("unroll") for (int m = 0; m < 4; ++m) _Pragma("unroll") for (int n = 0; n < 2; ++n) _Pragma("unroll") for (int k = 0; k < 2; ++k) \
        acc[ai][bj][m][n] = __builtin_amdgcn_mfma_f32_16x16x32_bf16(Bt[n][k], At[m][k], acc[ai][bj][m][n], 0, 0, 0); __builtin_amdgcn_s_setprio(0); } while (0)
#define PG8_WAIT_V(n) asm volatile("s_waitcnt vmcnt(" #n ")" ::: "memory")
#define PG8_WAIT_L(n) asm volatile("s_waitcnt lgkmcnt(" #n ")" ::: "memory")
#define PG8_BAR __builtin_amdgcn_s_barrier()
#define PG8_SCHED __builtin_amdgcn_sched_barrier(0)
    Unit cur, nxt; int ui = 0;
    if (!S.next(0, cur)) return;
    f32x4 acc[2][2][4][2];
#pragma unroll
    for (int a = 0; a < 2; ++a)
#pragma unroll
        for (int b = 0; b < 2; ++b)
#pragma unroll
            for (int m = 0; m < 4; ++m)
#pragma unroll
                for (int n = 0; n < 2; ++n) acc[a][b][m][n] = (f32x4){0.f, 0.f, 0.f, 0.f};
    bf16x8 At[4][2], B0[2][2], B1[2][2];
    const char* cA = (const char*)g.A + (size_t)cur.pm * tstep + (size_t)cur.k0 * kstep; const char* cB = (const char*)g.Bt + (size_t)cur.pn * tstep + (size_t)cur.k0 * kstep;
    PG8_STAGE(PG8_SB(0, 0), cB, voffB); PG8_STAGE(PG8_SB(0, 1), cB + hstep, voffB); PG8_STAGE(PG8_SA(0, 0), cA, voffA); PG8_STAGE(PG8_SA(0, 1), cA + hstep, voffA);
    if (wr == 1) PG8_BAR;
    PG8_WAIT_V(2); PG8_BAR;
    PG8_STAGE(PG8_SB(1, 0), cB + kstep, voffB); PG8_STAGE(PG8_SA(1, 0), cA + kstep, voffA); PG8_STAGE(PG8_SB(1, 1), cB + hstep + kstep, voffB);
    PG8_WAIT_V(6); PG8_BAR;
    for (;;) {
        const bool has_next = S.next(ui + 1, nxt);
        const char* nA = has_next ? (const char*)g.A + (size_t)nxt.pm * tstep + (size_t)nxt.k0 * kstep : cA; const char* nB = has_next ? (const char*)g.Bt + (size_t)nxt.pn * tstep + (size_t)nxt.k0 * kstep : cB;
        const int nt = cur.nk;
        for (int t = 0; t < nt; t += 2) {
            const bool last = (t == nt - 2);
            const char* a1 = cA + (size_t)(t + 1) * kstep;
            const char* a2 = last ? nA : cA + (size_t)(t + 2) * kstep; const char* b2 = last ? nB : cB + (size_t)(t + 2) * kstep;
            const char* a3 = a2 + kstep; const char* b3 = b2 + kstep;
            PG8_LDB(B0, 0, 0); PG8_LDB(B1, 0, 1); PG8_SCHED; PG8_LDA(At, 0, 0); PG8_STAGE(PG8_SA(1, 1), a1 + hstep, voffA);
            PG8_WAIT_V(8); PG8_WAIT_L(0); PG8_BAR; PG8_MMA(0, 0, At, B0); PG8_MMA(0, 1, At, B1); PG8_BAR; PG8_SCHED;
            PG8_LDA(At, 0, 1); PG8_STAGE(PG8_SB(0, 0), b2, voffB); PG8_STAGE(PG8_SB(0, 1), b2 + hstep, voffB); PG8_STAGE(PG8_SA(0, 0), a2, voffA);
            PG8_WAIT_V(8); PG8_WAIT_L(0); PG8_BAR; PG8_MMA(1, 0, At, B0); PG8_MMA(1, 1, At, B1); PG8_BAR; PG8_SCHED;
            PG8_LDB(B0, 1, 0); PG8_LDB(B1, 1, 1); PG8_SCHED; PG8_LDA(At, 1, 0); PG8_STAGE(PG8_SA(0, 1), a2 + hstep, voffA);
            PG8_WAIT_V(8); PG8_WAIT_L(0); PG8_BAR; PG8_MMA(0, 0, At, B0); PG8_MMA(0, 1, At, B1); PG8_BAR; PG8_SCHED;
            PG8_LDA(At, 1, 1); PG8_STAGE(PG8_SB(1, 0), b3, voffB); PG8_STAGE(PG8_SB(1, 1), b3 + hstep, voffB); PG8_STAGE(PG8_SA(1, 0), a3, voffA);
            PG8_WAIT_V(8); PG8_WAIT_L(0); PG8_BAR; PG8_MMA(1, 0, At, B0); PG8_MMA(1, 1, At, B1); PG8_BAR; PG8_SCHED;
        }
        if (wr == 0) PG8_BAR;
        if (!(Epi::CAN_SPLIT && cur.split)) E(acc, cur, wr, wc, fr, fq, lds + LDS_STAGE, wid);
        if (!has_next) break;
#pragma unroll
        for (int a = 0; a < 2; ++a)
#pragma unroll
            for (int b = 0; b < 2; ++b)
#pragma unroll
                for (int m = 0; m < 4; ++m)
#pragma unroll
                    for (int n = 0; n < 2; ++n) acc[a][b][m][n] = (f32x4){0.f, 0.f, 0.f, 0.f};
        cur = nxt; cA = nA; cB = nB; ++ui;
        if (wr == 1) PG8_BAR;
    }
    PG8_WAIT_V(0);
    PG8_BAR;
    if (Epi::CAN_SPLIT && cur.split) E(acc, cur, wr, wc, fr, fq, lds + LDS_STAGE, wid);
#undef PG8_SA
#undef PG8_SB
#undef PG8_STAGE
#undef PG8_LDA
#undef PG8_LDB
#undef PG8_MMA
#undef PG8_WAIT_V
#undef PG8_WAIT_L
#undef PG8_BAR
#undef PG8_SCHED
}
}
using pg8::Unit;

struct EpiMod {
    static constexpr bool PERM = false, CAN_SPLIT = false, APERM = false;
    float* MOD; const float* bias;
    __device__ __forceinline__ void operator()(const f32x4 (&acc)[2][2][4][2], const Unit& u, int wr, int wc, int fr, int fq, LAS unsigned char*, int) const {
        const int col0 = u.pn * 256 + wc * 32 + 4 * fq;
#pragma unroll
        for (int ai = 0; ai < 2; ++ai)
#pragma unroll
            for (int m = 0; m < 4; ++m) {
                const int r = ai * 128 + wr * 64 + m * 16 + fr;
                if (r < 132) {
#pragma unroll
                    for (int bj = 0; bj < 2; ++bj)
#pragma unroll
                        for (int n = 0; n < 2; ++n) { const int c = col0 + bj * 128 + n * 16; *(f32x4*)(MOD + (size_t)r * 12288 + c) = acc[ai][bj][m][n] + *(const f32x4*)(bias + c); }
                }
            }
    }
};

__device__ __forceinline__ f32x4 unpack4(u32x2 w) { f32x4 v; v[0] = __uint_as_float(w.x << 16); v[1] = __uint_as_float(w.x & 0xffff0000u); v[2] = __uint_as_float(w.y << 16); v[3] = __uint_as_float(w.y & 0xffff0000u); return v; }
template <bool INB, bool OUTB>
struct EpiRes {
    static constexpr bool PERM = false, CAN_SPLIT = true, APERM = false;
    const float* xin_p; const float* xin_s; const bf16_t* xin_b; float* xo_f; bf16_t* xo_b; const float* gate;
    unsigned char* ws; unsigned* ticket;
    __device__ __forceinline__ float* slab(int idx) const { return (float*)(idx < 136 ? ws + W_H + (size_t)idx * 262144 : ws + W_ADA + (size_t)(idx - 136) * 262144); }
    __device__ __forceinline__ f32x4 ldx(int r, int c) const {
        if (INB) return unpack4(*(const u32x2*)(xin_b + (size_t)r * 1024 + c));
        return *(const f32x4*)((r < NPR ? xin_p + (size_t)r * 1024 : xin_s + (size_t)(r - NPR) * 1024) + c);
    }
    __device__ __forceinline__ void stx(int r, int c, f32x4 v) const {
        if (OUTB) *(u32x2*)(xo_b + (size_t)r * 1024 + c) = pack4(v); else *(f32x4*)(xo_f + (size_t)r * 1024 + c) = v;
    }
    __device__ __forceinline__ void operator()(const f32x4 (&acc)[2][2][4][2], const Unit& u, int wr, int wc, int fr, int fq, LAS unsigned char*, int wid) const {
        const bool prompt = u.pm < 64;
        const int col0 = u.pn * 256 + wc * 32 + 4 * fq;
        if (!u.split) {
            f32x4 gu[2][2];
            if (prompt) {
#pragma unroll
                for (int bj = 0; bj < 2; ++bj)
#pragma unroll
                    for (int n = 0; n < 2; ++n) gu[bj][n] = *(const f32x4*)(gate + (size_t)(u.pm >> 4) * 12288 + col0 + bj * 128 + n * 16);
            }
            if (INB && prompt) {
                u32x2 xr[2][4][2][2];
#pragma unroll
                for (int ai = 0; ai < 2; ++ai)
#pragma unroll
                    for (int m = 0; m < 4; ++m) { const int r = u.pm * 256 + ai * 128 + wr * 64 + m * 16 + fr;
#pragma unroll
                        for (int bj = 0; bj < 2; ++bj)
#pragma unroll
                            for (int n = 0; n < 2; ++n) xr[ai][m][bj][n] = *(const u32x2*)(xin_b + (size_t)r * 1024 + col0 + bj * 128 + n * 16); }
#pragma unroll
                for (int ai = 0; ai < 2; ++ai)
#pragma unroll
                    for (int m = 0; m < 4; ++m) { const int r = u.pm * 256 + ai * 128 + wr * 64 + m * 16 + fr;
#pragma unroll
                        for (int bj = 0; bj < 2; ++bj)
#pragma unroll
                            for (int n = 0; n < 2; ++n) stx(r, col0 + bj * 128 + n * 16, unpack4(xr[ai][m][bj][n]) + gu[bj][n] * acc[ai][bj][m][n]); }
            } else {
            constexpr int MB = 2;
#pragma unroll
            for (int ai = 0; ai < 2; ++ai)
#pragma unroll
                for (int mb = 0; mb < 4; mb += MB) {
                    u32x2 xr[MB][2][2]; f32x4 xf[INB ? 1 : MB][2][2];
#pragma unroll
                    for (int m = 0; m < MB; ++m) { const int r = u.pm * 256 + ai * 128 + wr * 64 + (mb + m) * 16 + fr;
#pragma unroll
                        for (int bj = 0; bj < 2; ++bj)
#pragma unroll
                            for (int n = 0; n < 2; ++n) { const int c = col0 + bj * 128 + n * 16;
                                if (INB) xr[m][bj][n] = *(const u32x2*)(xin_b + (size_t)r * 1024 + c);
                                else xf[INB ? 0 : m][bj][n] = *(const f32x4*)((r < NPR ? xin_p + (size_t)r * 1024 : xin_s + (size_t)(r - NPR) * 1024) + c); } }
                    f32x4 gs[MB][2][2];
                    if (!prompt) {
#pragma unroll
                        for (int m = 0; m < MB; ++m) { const int r = u.pm * 256 + ai * 128 + wr * 64 + (mb + m) * 16 + fr; const float* gp = gate + (size_t)(4 + ((r - NPR) >> 3)) * 12288;
#pragma unroll
                            for (int bj = 0; bj < 2; ++bj)
#pragma unroll
                                for (int n = 0; n < 2; ++n) gs[m][bj][n] = *(const f32x4*)(gp + col0 + bj * 128 + n * 16); }
                    }
#pragma unroll
                    for (int m = 0; m < MB; ++m) { const int r = u.pm * 256 + ai * 128 + wr * 64 + (mb + m) * 16 + fr;
#pragma unroll
                        for (int bj = 0; bj < 2; ++bj)
#pragma unroll
                            for (int n = 0; n < 2; ++n) { const f32x4 x0 = INB ? unpack4(xr[m][bj][n]) : xf[INB ? 0 : m][bj][n];
                                const f32x4 gg = prompt ? gu[bj][n] : gs[m][bj][n];
                                stx(r, col0 + bj * 128 + n * 16, x0 + gg * acc[ai][bj][mb + m][n]); } }
                }
            }
        } else {
            __amdgpu_buffer_rsrc_t srs = __builtin_amdgcn_make_buffer_rsrc((void*)slab(u.tl * u.S + u.k0 / u.nk), 0, 262144, 0x00020000);
            const unsigned soff = (unsigned)(wc * 32 + 4 * fq) * 4u;
#pragma unroll
            for (int ai = 0; ai < 2; ++ai)
#pragma unroll
                for (int m = 0; m < 4; ++m) {
                    const int rl = ai * 128 + wr * 64 + m * 16 + fr;
                    const int r = u.pm * 256 + rl;
                    const int mrow = prompt ? (r >> 12) : 4 + ((r - NPR) >> 3);
                    const float* gp = gate + (size_t)mrow * 12288;
#pragma unroll
                    for (int bj = 0; bj < 2; ++bj)
#pragma unroll
                        for (int n = 0; n < 2; ++n) { const int c = col0 + bj * 128 + n * 16;
                            const f32x4 d = *(const f32x4*)(gp + c) * acc[ai][bj][m][n];
                            __builtin_amdgcn_raw_buffer_store_b128(__builtin_bit_cast(u32x4, d), srs, soff + (unsigned)(rl * 256 + bj * 128 + n * 16) * 4u, 0, 16); }
                }
        }
        if (u.split) {
            const int lane = fq * 16 + fr;
            asm volatile("s_waitcnt vmcnt(0)" ::: "memory");
            __syncthreads();
            if (threadIdx.x == 0) {
                unsigned* tk = ticket + u.tl;
                const unsigned need = (unsigned)u.S;
                __hip_atomic_fetch_add(tk, 1u, __ATOMIC_RELAXED, __HIP_MEMORY_SCOPE_AGENT);
                unsigned sp = 0;
                while (__hip_atomic_load(tk, __ATOMIC_RELAXED, __HIP_MEMORY_SCOPE_AGENT) < need) { __builtin_amdgcn_s_sleep(2); if (++sp > (1u << 19)) break; }
                __builtin_amdgcn_fence(__ATOMIC_ACQUIRE, "agent");
                asm volatile("s_waitcnt vmcnt(0)" ::: "memory");
            }
            __syncthreads();
            const int w = (u.k0 / u.nk) * 8 + wid, nw = 8 * u.S;
            for (int vb = w * 64 + lane; vb < 16384; vb += 8 * nw * 64) {
                f32x4 tot[8];
#pragma unroll
                for (int k = 0; k < 8; ++k) {
                    const int v = vb + k * nw * 64;
                    if (v < 16384) {
                        const int r = u.pm * 256 + (v >> 6), c = u.pn * 256 + (v & 63) * 4;
                        f32x4 s0 = ldx(r, c), s1 = (f32x4){0.f, 0.f, 0.f, 0.f}, s2 = s1, s3 = s1;
                        int q = 0;
                        for (; q + 8 <= u.S; q += 8) {
                            f32x4 a[8];
#pragma unroll
                            for (int j2 = 0; j2 < 8; ++j2) a[j2] = *(const f32x4*)(slab(u.tl * u.S + q + j2) + (size_t)v * 4);
                            s0 += a[0]; s1 += a[1]; s2 += a[2]; s3 += a[3]; s0 += a[4]; s1 += a[5]; s2 += a[6]; s3 += a[7]; }
                        for (; q + 4 <= u.S; q += 4) {
                            const f32x4 a0 = *(const f32x4*)(slab(u.tl * u.S + q) + (size_t)v * 4), a1 = *(const f32x4*)(slab(u.tl * u.S + q + 1) + (size_t)v * 4);
                            const f32x4 a2 = *(const f32x4*)(slab(u.tl * u.S + q + 2) + (size_t)v * 4), a3 = *(const f32x4*)(slab(u.tl * u.S + q + 3) + (size_t)v * 4);
                            s0 += a0; s1 += a1; s2 += a2; s3 += a3; }
                        for (; q < u.S; ++q) s1 += *(const f32x4*)(slab(u.tl * u.S + q) + (size_t)v * 4);
                        tot[k] = (s0 + s1) + (s2 + s3);
                    }
                }
#pragma unroll
                for (int k = 0; k < 8; ++k) {
                    const int v = vb + k * nw * 64;
                    if (v < 16384) stx(u.pm * 256 + (v >> 6), u.pn * 256 + (v & 63) * 4, tot[k]);
                }
            }
        }
    }
};

struct EpiIn {
    static constexpr bool PERM = true, CAN_SPLIT = false, APERM = false;
    int layer;
    const float* gq; const float* gk; const float* lng; const float* lnb; const float* rope;
    bf16_t* Q; bf16_t* KB; bf16_t* VB; bf16_t* U; bf16_t* VG; float* out;
    __device__ __forceinline__ void operator()(const f32x4 (&acc)[2][2][4][2], const Unit& u, int wr, int wc, int fr, int fq, LAS unsigned char* ex, int wid) const {
        const int pn = u.pn;
        const bool prompt = u.pm < 64;
        const int rbase = u.pm * 256 + wr * 64 + fr;
        const int dq = 8 * fq;
        if (false) {}
#ifndef NOQK
        else if (pn < 2 || (pn == 2 && wc < 2)) {
            const bool isk = (pn == 2);
            const float* g = isk ? gk : gq;
            f32x4 gv[2][2];
#pragma unroll
            for (int bj = 0; bj < 2; ++bj)
#pragma unroll
                for (int n = 0; n < 2; ++n) gv[bj][n] = *(const f32x4*)(g + bj * 32 + dq + 4 * n);
#pragma unroll
            for (int ai = 0; ai < 2; ++ai)
#pragma unroll
              for (int mb = 0; mb < 4; mb += 4) {
                f32x4 rcs[4][2], rsn[4][2];
#pragma unroll
                for (int mm = 0; mm < 4; ++mm) { const int r = rbase + ai * 128 + (mb + mm) * 16; const float* rp = rope + (prompt ? (r & 4095) : 4096 + (r & 7)) * 16;
#pragma unroll
                    for (int n = 0; n < 2; ++n) { rcs[mm][n] = *(const f32x4*)(rp + 4 * n); rsn[mm][n] = *(const f32x4*)(rp + 8 + 4 * n); } }
#pragma unroll
                for (int mm = 0; mm < 4; ++mm) {
                    const int m = mb + mm;
                    const int r = rbase + ai * 128 + m * 16;
                    float ss = 0.f;
#pragma unroll
                    for (int bj = 0; bj < 2; ++bj)
#pragma unroll
                        for (int n = 0; n < 2; ++n) { const f32x4 v = acc[ai][bj][m][n]; ss += v[0] * v[0] + v[1] * v[1] + v[2] * v[2] + v[3] * v[3]; }
                    ss = xsum_fq(ss);
                    const float rs = rsqrtf(ss * (1.0f / 64.0f) + 1e-6f);
                    f32x4 y[2][2];
#pragma unroll
                    for (int bj = 0; bj < 2; ++bj)
#pragma unroll
                        for (int n = 0; n < 2; ++n) y[bj][n] = acc[ai][bj][m][n] * rs * gv[bj][n];
#pragma unroll
                    for (int n = 0; n < 2; ++n) {
                        const f32x4 cs = rcs[mm][n], sn = rsn[mm][n];
#pragma unroll
                        for (int e = 0; e < 4; ++e) {
                            const float own = y[0][n][e];
                            const float oth = __shfl_xor(own, 16);
                            const float rot = (fq == 0) ? own * cs[e] - oth * sn[e] : own * cs[e] + oth * sn[e];
                            y[0][n][e] = (fq < 2) ? rot : own;
                        }
                    }
                    if (!isk) {
                        bf16_t* qp = Q + (size_t)r * 512 + (pn * 4 + wc) * 64 + dq;
                        *(u32x4*)(qp) = pack8(y[0][0], y[0][1]); *(u32x4*)(qp + 32) = pack8(y[1][0], y[1][1]);
                    } else {
                        bf16_t* kp = KB + (size_t)r * 128 + wc * 64 + dq;
                        *(u32x4*)(kp) = pack8(y[0][0], y[0][1]); *(u32x4*)(kp + 32) = pack8(y[1][0], y[1][1]);
                        float* op = nullptr;
                        if (!prompt) op = out + O_NKS + ((size_t)layer * 1024 + (r - NPR)) * 128;
                        else if ((r & 4095) >= 3968) op = out + O_NKP + (((size_t)layer * 4 + (r >> 12)) * 128 + ((r & 4095) - 3968)) * 128;
                        if (op) { op += wc * 64 + dq;
                            *(f32x4*)(op) = y[0][0]; *(f32x4*)(op + 4) = y[0][1]; *(f32x4*)(op + 32) = y[1][0]; *(f32x4*)(op + 36) = y[1][1]; }
                    }
                }
            }
        }
#endif
#ifndef NOV
        else if (pn == 2) {
#pragma unroll
            for (int ai = 0; ai < 2; ++ai)
#pragma unroll
                for (int m = 0; m < 4; ++m) {
                    const int r = rbase + ai * 128 + m * 16;
                    bf16_t* vp = VB + (size_t)r * 128 + (wc - 2) * 64 + dq;
                    *(u32x4*)(vp) = pack8(acc[ai][0][m][0], acc[ai][0][m][1]); *(u32x4*)(vp + 32) = pack8(acc[ai][1][m][0], acc[ai][1][m][1]);
                    float* op = nullptr;
                    if (!prompt) op = out + O_NVS + ((size_t)layer * 1024 + (r - NPR)) * 128;
                    else if ((r & 4095) >= 3968) op = out + O_NVP + (((size_t)layer * 4 + (r >> 12)) * 128 + ((r & 4095) - 3968)) * 128;
                    if (op) { op += (wc - 2) * 64 + dq;
                        *(f32x4*)(op) = acc[ai][0][m][0]; *(f32x4*)(op + 4) = acc[ai][0][m][1]; *(f32x4*)(op + 32) = acc[ai][1][m][0]; *(f32x4*)(op + 36) = acc[ai][1][m][1]; }
                }
        }
#endif
#ifndef NOU
        else if (pn < 5) {
#pragma unroll
            for (int ai = 0; ai < 2; ++ai)
#pragma unroll
                for (int m = 0; m < 4; ++m) {
                    const int r = rbase + ai * 128 + m * 16;
                    f32x4 y[2][2];
#pragma unroll
                    for (int bj = 0; bj < 2; ++bj)
#pragma unroll
                        for (int n = 0; n < 2; ++n)
#pragma unroll
                            for (int e = 0; e < 4; ++e) y[bj][n][e] = gelu_f(acc[ai][bj][m][n][e]);
                    bf16_t* up = U + (size_t)r * 512 + (pn - 3) * 256 + wc * 64 + dq;
                    *(u32x4*)(up) = pack8(y[0][0], y[0][1]); *(u32x4*)(up + 32) = pack8(y[1][0], y[1][1]);
                }
        }
#endif
#ifndef NOLN
        else {
            LAS f32x2* exo = (LAS f32x2*)ex + wid * 128 + fr;
            LAS f32x2* exp_ = (LAS f32x2*)ex + (wid ^ 1) * 128 + fr;
#pragma unroll
            for (int ai = 0; ai < 2; ++ai)
#pragma unroll
                for (int m = 0; m < 4; ++m) {
                    float a = 0.f, b = 0.f;
#pragma unroll
                    for (int bj = 0; bj < 2; ++bj)
#pragma unroll
                        for (int n = 0; n < 2; ++n)
#pragma unroll
                            for (int e = 0; e < 4; ++e) { const float gl = gelu_f(acc[ai][bj][m][n][e]); a += gl; b += gl * gl; }
                    a = xsum_fq(a); b = xsum_fq(b);
                    if (fq == 0) exo[(ai * 4 + m) * 16] = (f32x2){a, b};
                }
            asm volatile("s_waitcnt lgkmcnt(0)" ::: "memory");
            __builtin_amdgcn_s_barrier();
            asm volatile("" ::: "memory");
            const int grp = (pn - 5) * 2 + (wc >> 1);
            const int w0 = (wc & 1) * 64 + dq;
            f32x4 lgv[2][2], lbv[2][2];
#pragma unroll
            for (int bj = 0; bj < 2; ++bj)
#pragma unroll
                for (int n = 0; n < 2; ++n) { lgv[bj][n] = *(const f32x4*)(lng + grp * 128 + w0 + bj * 32 + 4 * n); lbv[bj][n] = *(const f32x4*)(lnb + grp * 128 + w0 + bj * 32 + 4 * n); }
#pragma unroll
            for (int ai = 0; ai < 2; ++ai)
#pragma unroll
                for (int m = 0; m < 4; ++m) {
                    const int r = rbase + ai * 128 + m * 16;
                    const f32x2 o0 = exo[(ai * 4 + m) * 16];
                    const f32x2 o1 = exp_[(ai * 4 + m) * 16];
                    const float mean = (o0.x + o1.x) * (1.0f / 128.0f);
                    const float var = fmaxf((o0.y + o1.y) * (1.0f / 128.0f) - mean * mean, 0.f);
                    const float rstd = rsqrtf(var + 1e-6f);
                    bf16_t* vp = VG + (size_t)r * 512 + grp * 128 + w0;
                    float* op = out + O_NGS + ((size_t)layer * 1024 + (r - NPR)) * 512 + grp * 128 + w0;
#pragma unroll
                    for (int bj = 0; bj < 2; ++bj) {
                        f32x4 g0, g1;
#pragma unroll
                        for (int e = 0; e < 4; ++e) { float x0 = acc[ai][bj][m][0][e], x1 = acc[ai][bj][m][1][e]; asm volatile("" : "+v"(x0), "+v"(x1)); g0[e] = gelu_f(x0); g1[e] = gelu_f(x1); }
                        const f32x4 y0 = (g0 - mean) * rstd * lgv[bj][0] + lbv[bj][0];
                        const f32x4 y1 = (g1 - mean) * rstd * lgv[bj][1] + lbv[bj][1];
                        *(u32x4*)(vp + bj * 32) = pack8(y0, y1);
                        if (!prompt) { *(f32x4*)(op + bj * 32) = y0; *(f32x4*)(op + bj * 32 + 4) = y1; }
                    }
                    asm volatile("" ::: "memory");
                }
        }
#endif
    }
};

struct EpiFfnIn {
    static constexpr bool PERM = true, CAN_SPLIT = false, APERM = true;
    const float* cw; const float* cb; const float* cc;
    bf16_t* ACT; bf16_t* HALO; float* ncs; float* ncp;
    __device__ __forceinline__ static f32x4 shr1(f32x4 v) { f32x4 r; r[0] = dppf<0x111>(v[0]); r[1] = dppf<0x111>(v[1]); r[2] = dppf<0x111>(v[2]); r[3] = dppf<0x111>(v[3]); return r; }
    __device__ __forceinline__ static f32x4 act4(f32x4 g, f32x4 u) { f32x4 a; a[0] = silu_f(g[0]) * u[0]; a[1] = silu_f(g[1]) * u[1]; a[2] = silu_f(g[2]) * u[2]; a[3] = silu_f(g[3]) * u[3]; return a; }
    __device__ __forceinline__ void operator()(const f32x4 (&acc)[2][2][4][2], const Unit& u, int wr, int wc, int fr, int fq, LAS unsigned char*, int) const {
        const bool prompt = u.pm < 64;
        const int gc0 = u.pn * 128 + wc * 32 + 8 * fq;
        u32x2 res[2][2][4];
#pragma unroll
        for (int n = 0; n < 2; ++n) {
            const int gc = gc0 + 4 * n;
            const f32x4 w0g = *(const f32x4*)(cw + gc), w1g = *(const f32x4*)(cw + 5632 + gc), w2g = *(const f32x4*)(cw + 11264 + gc), bg = *(const f32x4*)(cb + gc);
            const f32x4 w0u = *(const f32x4*)(cw + 2816 + gc), w1u = *(const f32x4*)(cw + 5632 + 2816 + gc), w2u = *(const f32x4*)(cw + 11264 + 2816 + gc), bu = *(const f32x4*)(cb + 2816 + gc);
#pragma unroll
            for (int ai = 0; ai < 2; ++ai) {
                const int r0 = u.pm * 256 + ai * 128 + wr * 64 + 4 * fr;
                const f32x4 g0 = acc[ai][0][0][n], g1 = acc[ai][0][1][n], g2 = acc[ai][0][2][n], g3 = acc[ai][0][3][n];
                const f32x4 u0 = acc[ai][1][0][n], u1 = acc[ai][1][1][n], u2 = acc[ai][1][2][n], u3 = acc[ai][1][3][n];
                f32x4 pg2 = shr1(g2), pg3 = shr1(g3), pu2 = shr1(u2), pu3 = shr1(u3);
                if (!prompt && (fr & 1) == 0) { const float* cp = cc + (size_t)((r0 - NPR) >> 3) * 2 * 5632;
                    pg2 = *(const f32x4*)(cp + gc); pg3 = *(const f32x4*)(cp + 5632 + gc); pu2 = *(const f32x4*)(cp + 2816 + gc); pu3 = *(const f32x4*)(cp + 5632 + 2816 + gc); }
                res[n][ai][0] = pack4(act4(bg + w0g * pg2 + w1g * pg3 + w2g * g0, bu + w0u * pu2 + w1u * pu3 + w2u * u0));
                res[n][ai][1] = pack4(act4(bg + w0g * pg3 + w1g * g0 + w2g * g1, bu + w0u * pu3 + w1u * u0 + w2u * u1));
                res[n][ai][2] = pack4(act4(bg + w0g * g0 + w1g * g1 + w2g * g2, bu + w0u * u0 + w1u * u1 + w2u * u2));
                res[n][ai][3] = pack4(act4(bg + w0g * g1 + w1g * g2 + w2g * g3, bu + w0u * u1 + w1u * u2 + w2u * u3));
            }
        }
#pragma unroll
        for (int ai = 0; ai < 2; ++ai) {
            const int r0 = u.pm * 256 + ai * 128 + wr * 64 + 4 * fr;
            bf16_t* ap = ACT + (size_t)r0 * 2816 + gc0;
#pragma unroll
            for (int m = 0; m < 4; ++m) *(u32x4*)(ap + m * 2816) = (u32x4){res[0][ai][m].x, res[0][ai][m].y, res[1][ai][m].x, res[1][ai][m].y};
#pragma unroll
            for (int n = 0; n < 2; ++n) {
                const int gc = gc0 + 4 * n;
                const f32x4 g0 = acc[ai][0][0][n], g1 = acc[ai][0][1][n], g2 = acc[ai][0][2][n], g3 = acc[ai][0][3][n];
                const f32x4 u0 = acc[ai][1][0][n], u1 = acc[ai][1][1][n], u2 = acc[ai][1][2][n], u3 = acc[ai][1][3][n];
                if (prompt) {
                    if (fr == 0) { bf16_t* hp = HALO + (size_t)(r0 >> 6) * 4 * 5632;
                        *(u32x2*)(hp + gc) = pack4(g0); *(u32x2*)(hp + 2816 + gc) = pack4(u0); *(u32x2*)(hp + 5632 + gc) = pack4(g1); *(u32x2*)(hp + 5632 + 2816 + gc) = pack4(u1); }
                    if (fr == 15) { bf16_t* hp = HALO + ((size_t)(r0 >> 6) * 4 + 2) * 5632;
                        *(u32x2*)(hp + gc) = pack4(g2); *(u32x2*)(hp + 2816 + gc) = pack4(u2); *(u32x2*)(hp + 5632 + gc) = pack4(g3); *(u32x2*)(hp + 5632 + 2816 + gc) = pack4(u3);
                        if ((r0 & 4095) == 4092) { float* op = ncp + (size_t)(r0 >> 12) * 2 * 5632;
                            *(f32x4*)(op + gc) = g2; *(f32x4*)(op + 2816 + gc) = u2; *(f32x4*)(op + 5632 + gc) = g3; *(f32x4*)(op + 5632 + 2816 + gc) = u3; } }
                } else if (fr & 1) { float* op = ncs + (size_t)((r0 - NPR) >> 3) * 2 * 5632;
                    *(f32x4*)(op + gc) = g2; *(f32x4*)(op + 2816 + gc) = u2; *(f32x4*)(op + 5632 + gc) = g3; *(f32x4*)(op + 5632 + 2816 + gc) = u3; }
            }
        }
    }
};

__device__ __forceinline__ int perm_row(int nn, int ptype) {
    if (ptype == 1) { const int pn = nn >> 8, j = nn & 255; return pn * 256 + ((j >> 5) & 1) * 128 + (j >> 6) * 32 + (j & 31); }
    if (ptype == 2) { const int h = nn >= 2816 ? 1 : 0, jj = nn - h * 2816; return (jj >> 7) * 256 + h * 128 + (jj & 127); }
    return nn;
}
struct ConvJob { const float* src; bf16_t* dst; int N, K, k0, n0, ptype; };
__device__ __forceinline__ void conv_load(const ConvJob& jb, int tid, f32x4 (&v)[8]) {
#pragma unroll
    for (int i = 0; i < 8; ++i) { const int idx = tid + i * 512, kk = idx >> 6, c4 = idx & 63; v[i] = *(const f32x4*)(jb.src + (size_t)(jb.k0 + kk) * jb.N + jb.n0 + c4 * 4); }
}
__device__ __forceinline__ void conv_to_lds(int tid, const f32x4 (&v)[8], float* tl) {
#pragma unroll
    for (int i = 0; i < 8; ++i) { const int idx = tid + i * 512, kk = idx >> 6, c4 = idx & 63; float* t = tl + kk * 257 + c4 * 4; t[0] = v[i][0]; t[1] = v[i][1]; t[2] = v[i][2]; t[3] = v[i][3]; }
}
__device__ __forceinline__ void conv_store(const ConvJob& jb, int tid, const float* tl) {
#pragma unroll
    for (int i = 0; i < 4; ++i) {
        const int idx = tid + i * 512, kg = idx & 7, n = idx >> 3;
        const float* t = tl + (kg * 8) * 257 + n;
        u32x4 w; w.x = cvt_pk_bf16(t[0], t[257]); w.y = cvt_pk_bf16(t[2 * 257], t[3 * 257]); w.z = cvt_pk_bf16(t[4 * 257], t[5 * 257]); w.w = cvt_pk_bf16(t[6 * 257], t[7 * 257]);
        *(u32x4*)(jb.dst + (size_t)perm_row(jb.n0 + n, jb.ptype) * jb.K + jb.k0 + kg * 8) = w;
    }
}
__device__ __forceinline__ ConvJob conv_job_main(const Params& p, int j) {
    ConvJob jb; int l, t;
    if (j < 224) { l = j / 112; t = j % 112; jb.N = 1792; jb.K = 1024; jb.ptype = 1; jb.src = p.in[10] + (size_t)l * 1024 * 1792; jb.dst = (bf16_t*)(p.ws + W_IN) + (size_t)l * 1792 * 1024; }
    else if (j < 352) { j -= 224; l = j / 64; t = j % 64; jb.N = 1024; jb.K = 1024; jb.ptype = 0; jb.src = p.in[18] + (size_t)l * 1024 * 1024; jb.dst = (bf16_t*)(p.ws + W_OUT) + (size_t)l * 1024 * 1024; }
    else if (j < 1056) { j -= 352; l = j / 352; t = j % 352; jb.N = 5632; jb.K = 1024; jb.ptype = 2; jb.src = p.in[20] + (size_t)l * 1024 * 5632; jb.dst = (bf16_t*)(p.ws + W_FIN) + (size_t)l * 5632 * 1024; }
    else { j -= 1056; l = j / 176; t = j % 176; jb.N = 1024; jb.K = 2816; jb.ptype = 0; jb.src = p.in[23] + (size_t)l * 2816 * 1024; jb.dst = (bf16_t*)(p.ws + W_FOUT) + (size_t)l * 1024 * 2816; }
    const int nn = jb.N / 256; jb.k0 = (t / nn) * 64; jb.n0 = (t % nn) * 256;
    return jb;
}
__device__ __forceinline__ ConvJob conv_job_ada(const Params& p, int j) {
    ConvJob jb; const int l = j / 384, t = j % 384;
    jb.N = 6144; jb.K = 1024; jb.ptype = 0; jb.src = p.in[7] + (size_t)l * 1024 * 6144; jb.dst = (bf16_t*)(p.ws + W_ADA) + (size_t)l * 6144 * 1024; jb.k0 = (t / 24) * 64; jb.n0 = (t % 24) * 256;
    return jb;
}
template <bool ADA>
__device__ __forceinline__ void conv_run(const Params& p, int j0, int step, int njobs, float* tl) {
    const int tid = tid_opaque();
    if (j0 >= njobs) return;
    ConvJob cur = ADA ? conv_job_ada(p, j0) : conv_job_main(p, j0);
    f32x4 v[8];
    conv_load(cur, tid, v);
    for (int j = j0; j < njobs; j += step) {
        conv_to_lds(tid, v, tl);
        __syncthreads();
        const int jn = j + step; const bool hn = jn < njobs;
        ConvJob nxt = cur;
        if (hn) { nxt = ADA ? conv_job_ada(p, jn) : conv_job_main(p, jn); conv_load(nxt, tid, v); }
        conv_store(cur, tid, tl);
        __syncthreads();
        cur = nxt;
    }
}

__device__ __forceinline__ void phase_prep(const Params& p, unsigned char* shm) {
    float* tl = (float*)shm;
    const int nb = gridDim.x, bid = blockIdx.x, tid = tid_opaque();
    conv_run<true>(p, bid, nb, 768, tl);
    const int gtid = bid * 512 + tid, gn = nb * 512;
    bf16_t* CS = (bf16_t*)(p.ws + W_CS);
    for (int i = gtid; i < 256 * 1024 / 2; i += gn) { const int e = i * 2, row = e >> 10; float a = 0.f, b = 0.f;
        if (row < 4) { a = p.in[5][e]; b = p.in[5][e + 1]; } else if (row < 132) { a = p.in[6][e - 4096]; b = p.in[6][e - 4096 + 1]; }
        *(unsigned*)(CS + e) = cvt_pk_bf16(silu_f(a), silu_f(b)); }
    float* RT = (float*)(p.ws + W_ROPE);
    for (int i = gtid; i < 4104 * 8; i += gn) { const int pidx = i >> 3, a = i & 7; const int pos = pidx < 4096 ? pidx : 16384 + (pidx - 4096);
        const double ang = (double)pos * p.inv[a];
        const double kq = rint(ang * 0.63661977236758134308);
        double rr = fma(-kq, 1.5707963267948966192, ang); rr = fma(-kq, 6.123233995736766036e-17, rr);
        const double r2 = rr * rr;
        const double sn = rr * (1.0 + r2 * (-1.0 / 6 + r2 * (1.0 / 120 + r2 * (-1.0 / 5040 + r2 * (1.0 / 362880 + r2 * (-1.0 / 39916800))))));
        const double cs = 1.0 + r2 * (-0.5 + r2 * (1.0 / 24 + r2 * (-1.0 / 720 + r2 * (1.0 / 40320 + r2 * (-1.0 / 3628800 + r2 * (1.0 / 479001600))))));
        const int q = ((int)((long long)kq & 3));
        double c_, s_;
        if (q == 0) { c_ = cs; s_ = sn; } else if (q == 1) { c_ = -sn; s_ = cs; } else if (q == 2) { c_ = -cs; s_ = -sn; } else { c_ = sn; s_ = -cs; }
        RT[pidx * 16 + a] = (float)c_; RT[pidx * 16 + 8 + a] = (float)s_; }
    bf16_t* WSB = (bf16_t*)(p.ws + W_WS);
    for (int i = gtid; i < 2 * 4 * 128 * 128 / 2; i += gn) { const int e = i * 2, s = e & 127, t = (e >> 7) & 127;
        const float a = (s <= t) ? p.in[16][e] : 0.f, b = (s + 1 <= t) ? p.in[16][e + 1] : 0.f;
        *(unsigned*)(WSB + e) = cvt_pk_bf16(a, b); }
}

template <bool INB>
__device__ __forceinline__ void phase_norm(const float* xp, const float* xs, const bf16_t* xb, const float* gvec, const float* mod_sh, const float* mod_sc, bf16_t* H) {
    const int tid = tid_opaque(); const int wid = tid >> 6, lane = tid & 63;
    const int nw = gridDim.x * 8;
    f32x4 g[4];
#pragma unroll
    for (int i = 0; i < 4; ++i) g[i] = *(const f32x4*)(gvec + i * 256 + lane * 4);
    int r = blockIdx.x * 8 + wid;
    f32x4 v[4], sc[4], sh[4];
    auto load_row = [&](int rr, f32x4 (&vv)[4], f32x4 (&scc)[4], f32x4 (&shh)[4]) {
        const int mrow = rr < NPR ? (rr >> 12) : 4 + ((rr - NPR) >> 3);
#pragma unroll
        for (int i = 0; i < 4; ++i) { const int c = i * 256 + lane * 4;
            if (INB) vv[i] = unpack4(*(const u32x2*)(xb + (size_t)rr * 1024 + c));
            else vv[i] = *(const f32x4*)((rr < NPR ? xp + (size_t)rr * 1024 : xs + (size_t)(rr - NPR) * 1024) + c);
            scc[i] = *(const f32x4*)(mod_sc + (size_t)mrow * 12288 + c); shh[i] = *(const f32x4*)(mod_sh + (size_t)mrow * 12288 + c); }
    };
    if (r < MT) load_row(r, v, sc, sh);
    while (r < MT) {
        const int rn = r + nw; const int rnc = rn < MT ? rn : r;
        f32x4 v2[4], sc2[4], sh2[4];
        load_row(rnc, v2, sc2, sh2);
        float ss = 0.f;
#pragma unroll
        for (int i = 0; i < 4; ++i) ss += v[i][0] * v[i][0] + v[i][1] * v[i][1] + v[i][2] * v[i][2] + v[i][3] * v[i][3];
#pragma unroll
        for (int o = 32; o >= 1; o >>= 1) ss += __shfl_xor(ss, o);
        const float rs = rsqrtf(ss * (1.0f / 1024.0f) + 1e-6f);
#pragma unroll
        for (int i = 0; i < 4; ++i) *(u32x2*)(H + (size_t)r * 1024 + i * 256 + lane * 4) = pack4(v[i] * rs * g[i] * (sc[i] + 1.0f) + sh[i]);
#pragma unroll
        for (int i = 0; i < 4; ++i) { v[i] = v2[i]; sc[i] = sc2[i]; sh[i] = sh2[i]; }
        r = rn;
    }
}

__device__ __forceinline__ void attn_unit(const Params& p, int layer, bool sample, int b, int blk, int kvh, unsigned char* shm) {
    bf16_t* Ks = (bf16_t*)shm;
    bf16_t* Vt = Ks + 256 * 72;
    bf16_t* Pw = Vt + 64 * 280;
    const bf16_t* Q = (const bf16_t*)(p.ws + W_Q); const bf16_t* KB = (const bf16_t*)(p.ws + W_KB); const bf16_t* VB = (const bf16_t*)(p.ws + W_VB);
    bf16_t* MIX = (bf16_t*)(p.ws + W_MIX);
    const int tid = tid_opaque(), wid = tid >> 6, lane = tid & 63, fr = lane & 15, fq = lane >> 4;
    if (!sample) {
        const int row0 = b * 4096 + blk * 128 - 128;
#pragma unroll
        for (int i = 0; i < 4; ++i) { const int idx = tid + i * 512, j = idx >> 3, c8 = idx & 7; int gr = row0 + j; if (gr < b * 4096) gr += 128;
            *(u32x4*)(Ks + j * 72 + c8 * 8) = *(const u32x4*)(KB + (size_t)gr * 128 + kvh * 64 + c8 * 8); }
#pragma unroll
        for (int i = 0; i < 4; ++i) { const int idx = tid + i * 512, j = idx & 255, c8 = idx >> 8; int gr = row0 + j; if (gr < b * 4096) gr += 128;
            const u32x4 v = *(const u32x4*)(VB + (size_t)gr * 128 + kvh * 64 + c8 * 8);
            bf16_t* d = Vt + (c8 * 8) * 280 + j;
            d[0] = (bf16_t)(v.x & 0xffff); d[280] = (bf16_t)(v.x >> 16); d[2 * 280] = (bf16_t)(v.y & 0xffff); d[3 * 280] = (bf16_t)(v.y >> 16);
            d[4 * 280] = (bf16_t)(v.z & 0xffff); d[5 * 280] = (bf16_t)(v.z >> 16); d[6 * 280] = (bf16_t)(v.w & 0xffff); d[7 * 280] = (bf16_t)(v.w >> 16); }
        for (int i = tid; i < 64 * 24; i += 512) Vt[(i / 24) * 280 + 256 + (i % 24)] = 0;
    } else {
        const float* ck = p.in[2] + ((size_t)(layer * 128 + b) * 128) * 128 + kvh * 64;
        const float* cv = p.in[3] + ((size_t)(layer * 128 + b) * 128) * 128 + kvh * 64;
#pragma unroll
        for (int i = 0; i < 4; ++i) { const int idx = tid + i * 512, j = idx >> 4, c4 = idx & 15;
            const f32x4 v = *(const f32x4*)(ck + (size_t)j * 128 + c4 * 4); *(u32x2*)(Ks + j * 72 + c4 * 4) = pack4(v); }
#pragma unroll
        for (int i = 0; i < 4; ++i) { const int idx = tid + i * 512, j = idx & 127, c4 = idx >> 7;
            const f32x4 v = *(const f32x4*)(cv + (size_t)j * 128 + c4 * 4); const u32x2 w = pack4(v);
            bf16_t* d = Vt + (c4 * 4) * 280 + j;
            d[0] = (bf16_t)(w.x & 0xffff); d[280] = (bf16_t)(w.x >> 16); d[2 * 280] = (bf16_t)(w.y & 0xffff); d[3 * 280] = (bf16_t)(w.y >> 16); }
        if (tid < 128) { const int s = tid >> 3, c8 = tid & 7; u32x4 v = (u32x4){0u, 0u, 0u, 0u};
            if (s < 8) v = *(const u32x4*)(KB + (size_t)(NPR + b * 8 + s) * 128 + kvh * 64 + c8 * 8);
            *(u32x4*)(Ks + (128 + s) * 72 + c8 * 8) = v;
        } else if (tid < 256) { const int t2 = tid - 128, s = t2 & 15, c8 = t2 >> 4; u32x4 v = (u32x4){0u, 0u, 0u, 0u};
            if (s < 8) v = *(const u32x4*)(VB + (size_t)(NPR + b * 8 + s) * 128 + kvh * 64 + c8 * 8);
            bf16_t* d = Vt + (c8 * 8) * 280 + 128 + s;
            d[0] = (bf16_t)(v.x & 0xffff); d[280] = (bf16_t)(v.x >> 16); d[2 * 280] = (bf16_t)(v.y & 0xffff); d[3 * 280] = (bf16_t)(v.y >> 16);
            d[4 * 280] = (bf16_t)(v.z & 0xffff); d[5 * 280] = (bf16_t)(v.z >> 16); d[6 * 280] = (bf16_t)(v.w & 0xffff); d[7 * 280] = (bf16_t)(v.w >> 16);
        } else { const int t2 = tid - 256; for (int i = t2; i < 64 * 16; i += 256) Vt[(i >> 4) * 280 + 144 + (i & 15)] = 0; }
    }
    __syncthreads();
    const int hh = wid >> 1, half = wid & 1, head = kvh * 4 + hh;
    const int ntile = sample ? (half == 0 ? 1 : 0) : 4;
    const int kmin = sample ? 0 : (blk == 0 ? 128 : 0), kmax = sample ? 136 : 256;
    const float sink = p.in[13][layer * 8 + head];
    bf16_t* Pme = Pw + wid * 16 * 168;
    u32x2 ores[4][4];
    for (int rt = 0; rt < ntile; ++rt) {
        const int i0 = sample ? 0 : half * 64 + rt * 16;
        const int qi = sample ? (fr & 7) : i0 + fr;
        const size_t grow = sample ? (size_t)(NPR + b * 8 + qi) : (size_t)(b * 4096 + blk * 128 + qi);
        const bf16_t* qp = Q + grow * 512 + head * 64;
        bf16x8 qf[2]; qf[0] = *(const bf16x8*)(qp + fq * 8); qf[1] = *(const bf16x8*)(qp + 32 + fq * 8);
        f32x4 s[9];
#pragma unroll
        for (int kt = 0; kt < 9; ++kt) { s[kt] = (f32x4){0.f, 0.f, 0.f, 0.f};
#pragma unroll
            for (int ks = 0; ks < 2; ++ks) { const bf16x8 kf = *(const bf16x8*)(Ks + (i0 + 16 * kt + fr) * 72 + ks * 32 + fq * 8);
                s[kt] = __builtin_amdgcn_mfma_f32_16x16x32_bf16(kf, qf[ks], s[kt], 0, 0, 0); } }
        float mx = sink;
#pragma unroll
        for (int kt = 0; kt < 9; ++kt)
#pragma unroll
            for (int e = 0; e < 4; ++e) { const int kb = i0 + 16 * kt + 4 * fq + e;
                const bool valid = (!sample && kt >= 1 && kt <= 7) ? (i0 + 16 * kt >= kmin) : ((kb >= qi + 1) && (kb <= qi + 128) && (kb >= kmin) && (kb < kmax));
                const float sc = valid ? s[kt][e] * 0.125f : -1e30f; s[kt][e] = sc; mx = fmaxf(mx, sc); }
        mx = xmax_fq(mx);
        float sum = 0.f;
#pragma unroll
        for (int kt = 0; kt < 9; ++kt)
#pragma unroll
            for (int e = 0; e < 4; ++e) { const float pe = fast_exp(s[kt][e] - mx); s[kt][e] = pe; sum += pe; }
        sum = xsum_fq(sum) + fast_exp(sink - mx);
        const float inv = 1.0f / sum;
#pragma unroll
        for (int kt = 0; kt < 9; ++kt) *(u32x2*)(Pme + fr * 168 + 16 * kt + 4 * fq) = pack4(s[kt] * inv);
        *(u32x2*)(Pme + fr * 168 + 144 + 4 * fq) = (u32x2){0u, 0u};
        asm volatile("s_waitcnt lgkmcnt(0)" ::: "memory");
        f32x4 o[4];
#pragma unroll
        for (int dt = 0; dt < 4; ++dt) o[dt] = (f32x4){0.f, 0.f, 0.f, 0.f};
#pragma unroll
        for (int ks = 0; ks < 5; ++ks) { const bf16x8 pf = *(const bf16x8*)(Pme + fr * 168 + ks * 32 + fq * 8);
#pragma unroll
            for (int dt = 0; dt < 4; ++dt) { const bf16x8 vf = *(const bf16x8*)(Vt + (16 * dt + fr) * 280 + i0 + ks * 32 + fq * 8);
                o[dt] = __builtin_amdgcn_mfma_f32_16x16x32_bf16(vf, pf, o[dt], 0, 0, 0); } }
#pragma unroll
        for (int dt = 0; dt < 4; ++dt) {
            const u32x2 pk = pack4_mfma(o[dt]);
            if (rt == 0) ores[0][dt] = pk; else if (rt == 1) ores[1][dt] = pk; else if (rt == 2) ores[2][dt] = pk; else ores[3][dt] = pk; }
        asm volatile("s_waitcnt lgkmcnt(0)" ::: "memory");
    }
#pragma unroll
    for (int rt = 0; rt < 4; ++rt) {
        if (rt < ntile && (!sample || fr < 8)) {
            const int qi = sample ? (fr & 7) : half * 64 + rt * 16 + fr;
            const size_t grow = sample ? (size_t)(NPR + b * 8 + qi) : (size_t)(b * 4096 + blk * 128 + qi);
            bf16_t* mp = MIX + grow * 1024 + head * 64 + 4 * fq;
#pragma unroll
            for (int dt = 0; dt < 4; ++dt) *(u32x2*)(mp + 16 * dt) = ores[rt][dt];
        }
    }
    __syncthreads();
}

__device__ __forceinline__ void sg_unit(const Params& p, int layer, int b, int chunk, int g, unsigned char* shm) {
    bf16_t* VGt = (bf16_t*)shm;
    const bf16_t* U = (const bf16_t*)(p.ws + W_U); const bf16_t* VG = (const bf16_t*)(p.ws + W_VG); const bf16_t* WSB = (const bf16_t*)(p.ws + W_WS);
    bf16_t* MIX = (bf16_t*)(p.ws + W_MIX);
    const int tid = tid_opaque(), wid = tid >> 6, lane = tid & 63, fr = lane & 15, fq = lane >> 4;
    const int rb = b * 4096 + chunk * 128;
    const int t0 = 16 * wid, nks = (wid >> 1) + 1;
    const bf16_t* wp = WSB + ((size_t)(layer * 4 + g) * 128 + t0 + fr) * 128 + fq * 8;
    bf16x8 wfa[4];
#pragma unroll
    for (int ks = 0; ks < 4; ++ks) wfa[ks] = *(const bf16x8*)(wp + ks * 32);
    const float bs = p.in[17][(layer * 4 + g) * 128 + t0 + fr];
    const size_t row = (size_t)(rb + t0 + fr);
    u32x2 ua[8];
#pragma unroll
    for (int wt = 0; wt < 8; ++wt) ua[wt] = *(const u32x2*)(U + row * 512 + g * 128 + 16 * wt + 4 * fq);
#pragma unroll
    for (int i = 0; i < 4; ++i) { const int idx = tid + i * 512, s = idx & 127, c8 = idx >> 7;
        const u32x4 v = *(const u32x4*)(VG + (size_t)(rb + s) * 512 + g * 128 + c8 * 8);
        bf16_t* d = VGt + (c8 * 8) * 136 + s;
        d[0] = (bf16_t)(v.x & 0xffff); d[136] = (bf16_t)(v.x >> 16); d[2 * 136] = (bf16_t)(v.y & 0xffff); d[3 * 136] = (bf16_t)(v.y >> 16);
        d[4 * 136] = (bf16_t)(v.z & 0xffff); d[5 * 136] = (bf16_t)(v.z >> 16); d[6 * 136] = (bf16_t)(v.w & 0xffff); d[7 * 136] = (bf16_t)(v.w >> 16); }
    __syncthreads();
    f32x4 z[8];
#pragma unroll
    for (int wt = 0; wt < 8; ++wt) z[wt] = (f32x4){0.f, 0.f, 0.f, 0.f};
#pragma unroll
    for (int ks = 0; ks < 4; ++ks) { if (ks >= nks) break;
#pragma unroll
        for (int wt = 0; wt < 8; ++wt) { const bf16x8 vf = *(const bf16x8*)(VGt + (16 * wt + fr) * 136 + ks * 32 + fq * 8);
            z[wt] = __builtin_amdgcn_mfma_f32_16x16x32_bf16(vf, wfa[ks], z[wt], 0, 0, 0); } }
#pragma unroll
    for (int wt = 0; wt < 8; ++wt) { const int c = g * 128 + 16 * wt + 4 * fq;
        const u32x2 uu = ua[wt];
        f32x4 o; o[0] = __uint_as_float(uu.x << 16) * (z[wt][0] + bs); o[1] = __uint_as_float(uu.x & 0xffff0000u) * (z[wt][1] + bs);
        o[2] = __uint_as_float(uu.y << 16) * (z[wt][2] + bs); o[3] = __uint_as_float(uu.y & 0xffff0000u) * (z[wt][3] + bs);
        *(u32x2*)(MIX + row * 1024 + 512 + c) = pack4(o); }
    __syncthreads();
}

__device__ __forceinline__ void phase_mix(const Params& p, int layer, unsigned char* shm) {
    const int nb = gridDim.x, bid = blockIdx.x;
#ifndef NO_MIXA
    for (int u = bid; u < 256; u += nb) attn_unit(p, layer, false, u >> 6, (u >> 1) & 31, u & 1, shm);
#endif
#ifndef NO_MIXB
    for (int u = bid; u < 256; u += nb) attn_unit(p, layer, true, u >> 1, 0, u & 1, shm);
#endif
#ifndef NO_MIXC
    for (int u = bid; u < 512; u += nb) sg_unit(p, layer, u >> 7, (u >> 2) & 31, u & 3, shm);
#endif
    const bf16_t* U = (const bf16_t*)(p.ws + W_U); const bf16_t* VG = (const bf16_t*)(p.ws + W_VG); bf16_t* MIX = (bf16_t*)(p.ws + W_MIX);
    for (int idx = bid * 512 + tid_opaque(); idx < 1024 * 128; idx += nb * 512) {
        const int r = idx >> 7, c4 = (idx & 127) * 4, b = r >> 3, t = r & 7, g = c4 >> 7;
        const float* wrow = p.in[16] + ((size_t)(layer * 4 + g) * 128 + t) * 128;
        f32x4 z = (f32x4){0.f, 0.f, 0.f, 0.f};
        const f32x4 wa = *(const f32x4*)(wrow), wb = *(const f32x4*)(wrow + 4);
        u32x2 vv[8];
#pragma unroll
        for (int s = 0; s < 8; ++s) vv[s] = *(const u32x2*)(VG + (size_t)(NPR + b * 8 + s) * 512 + c4);
#pragma unroll
        for (int s = 0; s < 8; ++s) { const float w0 = s < 4 ? wa[s & 3] : wb[s & 3]; const float w = (s <= t) ? w0 : 0.f;
            z[0] += w * __uint_as_float(vv[s].x << 16); z[1] += w * __uint_as_float(vv[s].x & 0xffff0000u); z[2] += w * __uint_as_float(vv[s].y << 16); z[3] += w * __uint_as_float(vv[s].y & 0xffff0000u); }
        const float bs = p.in[17][(layer * 4 + g) * 128 + t];
        const u32x2 uu = *(const u32x2*)(U + (size_t)(NPR + r) * 512 + c4);
        f32x4 o; o[0] = __uint_as_float(uu.x << 16) * (z[0] + bs); o[1] = __uint_as_float(uu.x & 0xffff0000u) * (z[1] + bs);
        o[2] = __uint_as_float(uu.y << 16) * (z[2] + bs); o[3] = __uint_as_float(uu.y & 0xffff0000u) * (z[3] + bs);
        *(u32x2*)(MIX + (size_t)(NPR + r) * 1024 + 512 + c4) = pack4(o);
    }
}

__device__ __forceinline__ void phase_fix(const Params& p, int layer) {
    const bf16_t* HALO = (const bf16_t*)(p.ws + W_HALO); bf16_t* ACT = (bf16_t*)(p.ws + W_R);
    const float* cw = p.in[21] + (size_t)layer * 3 * 5632; const float* cb = p.in[22] + (size_t)layer * 5632;
    const int gtid = blockIdx.x * 512 + tid_opaque(), gn = gridDim.x * 512;
    for (int idx = gtid; idx < 256 * 704; idx += gn) {
        const int blk = idx / 704, c = (idx % 704) * 4;
        const bf16_t* own = HALO + (size_t)blk * 4 * 5632; const bf16_t* prv = own - 4 * 5632;
        const bool first = (blk & 63) == 0;
        f32x4 a0, a1;
        f32x4 cg[2], cu[2];
#pragma unroll
        for (int h = 0; h < 2; ++h) {
            const int cc = c + h * 2816;
            const f32x4 w0 = *(const f32x4*)(cw + cc), w1 = *(const f32x4*)(cw + 5632 + cc), w2 = *(const f32x4*)(cw + 11264 + cc), bb = *(const f32x4*)(cb + cc);
            const f32x4 zero = (f32x4){0.f, 0.f, 0.f, 0.f};
            const f32x4 m2 = first ? zero : unpack4(*(const u32x2*)(prv + 2 * 5632 + cc)), m1 = first ? zero : unpack4(*(const u32x2*)(prv + 3 * 5632 + cc));
            const f32x4 o0 = unpack4(*(const u32x2*)(own + cc)), o1 = unpack4(*(const u32x2*)(own + 5632 + cc));
            const f32x4 r0 = bb + w0 * m2 + w1 * m1 + w2 * o0, r1 = bb + w0 * m1 + w1 * o0 + w2 * o1;
            if (h == 0) { cg[0] = r0; cg[1] = r1; } else { cu[0] = r0; cu[1] = r1; }
        }
#pragma unroll
        for (int e = 0; e < 4; ++e) { a0[e] = silu_f(cg[0][e]) * cu[0][e]; a1[e] = silu_f(cg[1][e]) * cu[1][e]; }
        *(u32x2*)(ACT + (size_t)(blk * 64) * 2816 + c) = pack4(a0);
        *(u32x2*)(ACT + (size_t)(blk * 64 + 1) * 2816 + c) = pack4(a1);
    }
}

#define XB_TMO      128
#define XB_XCNT(j)  (256  + 64 * (j))
#define XB_XSUB(j)  (1280 + 64 * (j))
#define XB_XGEN(j)  (2304 + 64 * (j))
#define XB_TOP      3328
#define XB_TOPGEN   3392
#define XCD_BAR_WORDS 3456
#define XB_SPIN_CAP (1u << 18)
__device__ __forceinline__ unsigned xb_ld(unsigned* p)              { return __hip_atomic_load(p, __ATOMIC_RELAXED, __HIP_MEMORY_SCOPE_AGENT); }
__device__ __forceinline__ unsigned xb_add(unsigned* p, unsigned v) { return __hip_atomic_fetch_add(p, v, __ATOMIC_RELAXED, __HIP_MEMORY_SCOPE_AGENT); }
__device__ __forceinline__ unsigned xb_xcc_id() { return (unsigned)__builtin_amdgcn_s_getreg((3 << 11) | 20) & 0xFu; }
#define XB_SPIN(cond, bar) do { unsigned _sp = 0; while (cond) { __builtin_amdgcn_s_sleep(1); \
    if ((++_sp & 255u) == 0u) { if (xb_ld(&(bar)[XB_TMO])) break; if (_sp > XB_SPIN_CAP) { atomicAdd(&(bar)[XB_TMO], 1u); break; } } } } while (0)
struct XcdBarrier { unsigned* bar; unsigned x; volatile LAS unsigned* st; };
__device__ __forceinline__ XcdBarrier xcd_barrier_post(unsigned* bar, volatile LAS unsigned* st) {
    XcdBarrier b; b.bar = bar; b.x = xb_xcc_id(); b.st = st;
    if (threadIdx.x == 0) (void)xb_add(&bar[XB_XCNT(b.x)], 1u);
    return b;
}
__device__ __forceinline__ void xcd_barrier_complete(unsigned* bar, unsigned x, unsigned& nloc, unsigned& nx) {
    const unsigned G = gridDim.x * gridDim.y * gridDim.z;
    unsigned sum, cnt, mine, sp = 0u;
    for (;;) {
        sum = 0u; cnt = 0u; mine = 0u;
#pragma unroll
        for (unsigned j = 0; j < 16; ++j) { const unsigned c = xb_ld(&bar[XB_XCNT(j)]); sum += c; cnt += (c > 0u) ? 1u : 0u; mine = (j == x) ? c : mine; }
        if (sum == G) break;
        __builtin_amdgcn_s_sleep(1);
        if ((++sp & 255u) == 0u) { if (xb_ld(&bar[XB_TMO])) break; if (sp > XB_SPIN_CAP) { atomicAdd(&bar[XB_TMO], 1u); break; } }
    }
    nloc = mine > 0u ? mine : 1u; nx = cnt > 0u ? cnt : 1u;
}
__device__ __forceinline__ void xcd_barrier(const XcdBarrier& b) {
    asm volatile("s_waitcnt vmcnt(0)" ::: "memory");
    __syncthreads();
    if (threadIdx.x == 0) {
        unsigned* bar = b.bar;
        __builtin_amdgcn_s_waitcnt(0);
        unsigned nloc = b.st[0], nx = b.st[1];
        if (nloc == 0u) { xcd_barrier_complete(bar, b.x, nloc, nx); b.st[0] = nloc; b.st[1] = nx; }
        const unsigned old = xb_add(&bar[XB_XSUB(b.x)], 1u);
        const unsigned gen = old / nloc;
        if (old + 1u == (gen + 1u) * nloc) {
            __builtin_amdgcn_fence(__ATOMIC_RELEASE, "agent");
            asm volatile("s_waitcnt vmcnt(0)" ::: "memory");
            const unsigned og = xb_add(&bar[XB_TOP], 1u);
            const unsigned tg = og / nx;
            if (og + 1u == (tg + 1u) * nx) xb_add(&bar[XB_TOPGEN], 1u);
            else XB_SPIN(xb_ld(&bar[XB_TOPGEN]) == tg, bar);
            __builtin_amdgcn_fence(__ATOMIC_ACQUIRE, "agent");
            xb_add(&bar[XB_XGEN(b.x)], 1u);
            asm volatile("s_waitcnt vmcnt(0)" ::: "memory");
        } else {
            XB_SPIN(xb_ld(&bar[XB_XGEN(b.x)]) == gen, bar);
            __builtin_amdgcn_fence(__ATOMIC_ACQUIRE, "agent");
            asm volatile("s_waitcnt vmcnt(0)" ::: "memory");
        }
    }
    __syncthreads();
}

__device__ __forceinline__ void run_phase(const Params& p, int ph, unsigned char* shm) {
    LAS unsigned char* lds = (LAS unsigned char*)shm;
    float* MOD = (float*)(p.ws + W_MOD);
    const int nb = gridDim.x, bid = blockIdx.x;
    if (ph == 0) { phase_prep(p, shm); return; }
    if (ph == 1) {
        const int ng = nb > 96 ? 48 : 0;
        if (ng == 0 || bid < ng) {
            pg8::StaticOrder S; S.init(256, 12288, 1024, ng ? ng : nb, bid, false);
            pg8::Gemm g{(const bf16_t*)(p.ws + W_CS), (const bf16_t*)(p.ws + W_ADA), 256, 12288, 1024};
            EpiMod E{MOD, p.in[8]};
            pg8::gemm_phase(lds, g, S, E);
        }
        if (ng == 0 || bid >= ng) {
            const int nc = ng ? nb - ng : nb, c0 = ng ? bid - ng : bid;
            conv_run<false>(p, c0, nc, 1408, (float*)shm);
        }
        return;
    }
    const int layer = (ph - 2) >> 3, sub = (ph - 2) & 7;
    const float* modl = MOD + layer * 6144;
    bf16_t* XB = (bf16_t*)(p.ws + W_XB);
    unsigned* tick = (unsigned*)(p.ws + W_BAR + 16384);
    pg8::StaticOrder S;
    switch (sub) {
    case 0: if (layer == 0) phase_norm<false>(p.in[0], p.in[1], nullptr, p.in[9], modl + 0, modl + 1024, (bf16_t*)(p.ws + W_H));
            else phase_norm<true>(nullptr, nullptr, XB, p.in[9] + layer * 1024, modl + 0, modl + 1024, (bf16_t*)(p.ws + W_H));
            break;
    case 1: { S.init(MT, 1792, 1024, nb, bid, false); S.reverse = 1;
        pg8::Gemm g{(const bf16_t*)(p.ws + W_H), (const bf16_t*)(p.ws + W_IN) + (size_t)layer * 1792 * 1024, MT, 1792, 1024};
        EpiIn E{layer, p.in[11] + layer * 64, p.in[12] + layer * 64, p.in[14] + layer * 512, p.in[15] + layer * 512, (const float*)(p.ws + W_ROPE),
                (bf16_t*)(p.ws + W_Q), (bf16_t*)(p.ws + W_KB), (bf16_t*)(p.ws + W_VB), (bf16_t*)(p.ws + W_U), (bf16_t*)(p.ws + W_VG), p.out};
        pg8::gemm_phase(lds, g, S, E); } break;
    case 2: phase_mix(p, layer, shm); break;
    case 3: { S.init(MT, 1024, 1024, nb, bid, true);
        pg8::Gemm g{(const bf16_t*)(p.ws + W_MIX), (const bf16_t*)(p.ws + W_OUT) + (size_t)layer * 1024 * 1024, MT, 1024, 1024};
        if (layer == 0) { EpiRes<false, true> E{p.in[0], p.in[1], nullptr, nullptr, XB, modl + 2048, p.ws, tick + (layer * 2 + 0) * 128}; pg8::gemm_phase(lds, g, S, E); }
        else { EpiRes<true, true> E{nullptr, nullptr, XB, nullptr, XB, modl + 2048, p.ws, tick + (layer * 2 + 0) * 128}; pg8::gemm_phase(lds, g, S, E); }
        } break;
    case 4: phase_norm<true>(nullptr, nullptr, XB, p.in[19] + layer * 1024, modl + 3072, modl + 4096, (bf16_t*)(p.ws + W_H)); break;
    case 5: { S.init(MT, 5632, 1024, nb, bid, false); S.reverse = 1;
        pg8::Gemm g{(const bf16_t*)(p.ws + W_H), (const bf16_t*)(p.ws + W_FIN) + (size_t)layer * 5632 * 1024, MT, 5632, 1024};
        EpiFfnIn E{p.in[21] + (size_t)layer * 3 * 5632, p.in[22] + (size_t)layer * 5632, p.in[4] + (size_t)layer * 128 * 2 * 5632,
                   (bf16_t*)(p.ws + W_R), (bf16_t*)(p.ws + W_HALO), p.out + O_NCS + (size_t)layer * 128 * 2 * 5632, p.out + O_NCP + (size_t)layer * 4 * 2 * 5632};
        pg8::gemm_phase(lds, g, S, E); } break;
    case 6: phase_fix(p, layer); break;
    case 7: { S.init(MT, 1024, 2816, nb, bid, true);
        pg8::Gemm g{(const bf16_t*)(p.ws + W_R), (const bf16_t*)(p.ws + W_FOUT) + (size_t)layer * 1024 * 2816, MT, 1024, 2816};
        if (layer == 0) { EpiRes<true, true> E{nullptr, nullptr, XB, nullptr, XB, modl + 5120, p.ws, tick + (layer * 2 + 1) * 128}; pg8::gemm_phase(lds, g, S, E); }
        else { EpiRes<true, false> E{nullptr, nullptr, XB, p.out, nullptr, modl + 5120, p.ws, tick + (layer * 2 + 1) * 128}; pg8::gemm_phase(lds, g, S, E); }
        } break;
    }
}

__global__ __launch_bounds__(512, 2) void mega_fwd(Params p) {
    extern __shared__ __attribute__((aligned(16))) unsigned char shm[];
    cg::grid_group grid = cg::this_grid();
    const int lo = p.ph_lo, hi = p.ph_hi;
    if (lo < 0) grid.sync();
    volatile LAS unsigned* st = (volatile LAS unsigned*)((LAS unsigned char*)shm + LDS_MISC);
    if (threadIdx.x < 4) st[threadIdx.x] = 0u;
    __syncthreads();
    XcdBarrier xb; xb.bar = (unsigned*)(p.ws + W_BAR); xb.x = 0; xb.st = st;
    if (hi - lo > 1) xb = xcd_barrier_post((unsigned*)(p.ws + W_BAR), st);
#ifndef PROBE_DUP
#define PROBE_DUP -1
#endif
#define PHASE(k) do { if (lo <= (k) && (k) < hi) run_phase(p, (k), shm); if (lo <= (k) && (k) + 1 < hi) xcd_barrier(xb); \
        if ((k) == PROBE_DUP) { run_phase(p, (k), shm); xcd_barrier(xb); } } while (0)
    PHASE(0); PHASE(1); PHASE(2); PHASE(3); PHASE(4); PHASE(5); PHASE(6); PHASE(7); PHASE(8); PHASE(9);
    PHASE(10); PHASE(11); PHASE(12); PHASE(13); PHASE(14); PHASE(15); PHASE(16); PHASE(17);
#undef PHASE
}

extern "C" void kernel_launch(void* const* d_in, const int* in_sizes, int n_in, void* d_out, int out_size, void* d_ws, size_t ws_size, hipStream_t stream) {
    static int grid = 0;
    if (grid == 0) {
        if (n_in != 24 || ws_size < W_END) { fprintf(stderr, "kernel_launch: unexpected n_in %d / ws %zu (need %zu)\n", n_in, ws_size, (size_t)W_END); grid = -1; return; }
        int dev = 0, cus = 0, per_cu = 0;
        hipGetDevice(&dev); hipDeviceGetAttribute(&cus, hipDeviceAttributeMultiprocessorCount, dev);
        if (hipFuncSetAttribute((const void*)mega_fwd, hipFuncAttributeMaxDynamicSharedMemorySize, LDS_BYTES) != hipSuccess) { fprintf(stderr, "kernel_launch: hipFuncSetAttribute failed\n"); grid = -1; return; }
        if (hipOccupancyMaxActiveBlocksPerMultiprocessor(&per_cu, (const void*)mega_fwd, 512, LDS_BYTES) != hipSuccess || per_cu < 1) { fprintf(stderr, "kernel_launch: occupancy query says %d\n", per_cu); per_cu = 1; }
        (void)hipGetLastError();
        grid = cus * 1;
        if (grid > 256) grid = 256;
    }
    if (grid < 0) return;
    Params p{};
    for (int i = 0; i < 24; ++i) p.in[i] = (const float*)d_in[i];
    p.out = (float*)d_out; p.ws = (unsigned char*)d_ws;
    for (int a = 0; a < 8; ++a) p.inv[a] = std::pow(500000.0, -(double)a / 8.0);
#if ONE_LAUNCH
    (void)hipMemsetAsync((char*)d_ws + W_BAR, 0, 32768, stream);
    p.ph_lo = 0; p.ph_hi = NPH;
    void* args[] = {&p};
    hipError_t e = hipLaunchCooperativeKernel((const void*)mega_fwd, dim3(grid), dim3(512), args, LDS_BYTES, stream);
    if (e != hipSuccess) fprintf(stderr, "cooperative launch failed: %s (grid %d)\n", hipGetErrorString(e), grid);
#else
    for (int ph = 0; ph < NPH; ++ph) {
        p.ph_lo = ph; p.ph_hi = ph + 1;
        hipLaunchKernelGGL(mega_fwd, dim3(grid), dim3(512), LDS_BYTES, stream, p);
    }
#endif
}
#ifdef TESTK
__global__ __launch_bounds__(512, 2) void tk(const bf16_t* A, const bf16_t* B, float* MOD, const float* bias) {
    extern __shared__ __attribute__((aligned(16))) unsigned char shm2[];
    pg8::StaticOrder S; S.init(256, 12288, 1024, gridDim.x, blockIdx.x, true);
    pg8::Gemm g{A, B, 256, 12288, 1024}; EpiMod E{MOD, bias};
    pg8::gemm_phase((LAS unsigned char*)shm2, g, S, E);
}
#endif
```

```cpp
#include <hip/hip_runtime.h>
#include <hip/hip_cooperative_groups.h>
#include <cstdio>
#include <cmath>
namespace cg = cooperative_groups;

#define LAS __attribute__((address_space(3)))
typedef unsigned short bf16_t;
typedef short bf16x8 __attribute__((ext_vector_type(8)));
typedef float f32x4 __attribute__((ext_vector_type(4)));
typedef float f32x2 __attribute__((ext_vector_type(2)));
typedef unsigned u32x4 __attribute__((ext_vector_type(4)));
typedef unsigned u32x2 __attribute__((ext_vector_type(2)));

#ifndef ONE_LAUNCH
#define ONE_LAUNCH 1
#endif

constexpr int NPR = 16384, NSM = 1024, MT = 17408;
constexpr int NPH = 18;
constexpr size_t O_Y = 0;
constexpr size_t O_NKP = 17825792, O_NVP = 17956864, O_NCP = 18087936, O_NKS = 18178048, O_NVS = 18440192, O_NGS = 18702336, O_NCS = 19750912;
constexpr size_t W_ADA = 0;
constexpr size_t W_IN = W_ADA + 12288ull * 1024 * 2;
constexpr size_t W_OUT = W_IN + 2ull * 1792 * 1024 * 2;
constexpr size_t W_FIN = W_OUT + 2ull * 1024 * 1024 * 2;
constexpr size_t W_FOUT = W_FIN + 2ull * 5632 * 1024 * 2;
constexpr size_t W_CS = W_FOUT + 2ull * 1024 * 2816 * 2;
constexpr size_t W_MOD = W_CS + 256ull * 1024 * 2;
constexpr size_t W_ROPE = W_MOD + 132ull * 12288 * 4;
constexpr size_t W_WS = W_ROPE + 4104ull * 16 * 4;
constexpr size_t W_H = W_WS + 2ull * 4 * 128 * 128 * 2;
constexpr size_t W_R = W_H + (size_t)MT * 1024 * 2;
constexpr size_t W_Q = W_R;
constexpr size_t W_KB = W_Q + (size_t)MT * 512 * 2;
constexpr size_t W_VB = W_KB + (size_t)MT * 128 * 2;
constexpr size_t W_U = W_VB + (size_t)MT * 128 * 2;
constexpr size_t W_VG = W_U + (size_t)MT * 512 * 2;
constexpr size_t W_MIX = W_VG + (size_t)MT * 512 * 2;
constexpr size_t W_HALO = W_R + (size_t)MT * 2816 * 2;
constexpr size_t W_XB = W_HALO + 256ull * 4 * 5632 * 2;
constexpr size_t W_BAR = W_XB + (size_t)MT * 1024 * 2;
constexpr size_t W_END = W_BAR + 32768;

constexpr int LDS_STAGE = 131072, LDS_MISC = LDS_STAGE + 8192, LDS_BYTES = LDS_MISC + 16;

struct Params {
    const float* in[24];
    float* out;
    unsigned char* ws;
    double inv[8];
    int ph_lo, ph_hi;
};

__device__ __forceinline__ unsigned cvt_pk_bf16(float lo, float hi) { unsigned r; asm volatile("v_cvt_pk_bf16_f32 %0, %1, %2" : "=v"(r) : "v"(lo), "v"(hi)); return r; }
__device__ __forceinline__ unsigned cvt_pk_bf16_mfma(float lo, float hi) { unsigned r; asm volatile("s_nop 7\n\ts_nop 7\n\tv_cvt_pk_bf16_f32 %0, %1, %2" : "=v"(r) : "v"(lo), "v"(hi)); return r; }
__device__ __forceinline__ float bf2f(bf16_t b) { return __uint_as_float(((unsigned)b) << 16); }
__device__ __forceinline__ float fast_exp(float x) { return __builtin_amdgcn_exp2f(x * 1.4426950408889634f); }
__device__ __forceinline__ float silu_f(float x) { return x * __builtin_amdgcn_rcpf(1.0f + fast_exp(-x)); }
__device__ __forceinline__ float gelu_f(float x) { const float u = 1.5957691216057308f * (x + 0.044715f * x * x * x); return x * __builtin_amdgcn_rcpf(1.0f + fast_exp(-u)); }
template <int CTRL> __device__ __forceinline__ float dppf(float x) { return __builtin_bit_cast(float, __builtin_amdgcn_update_dpp(0, __builtin_bit_cast(int, x), CTRL, 0xf, 0xf, false)); }
template <int N> __device__ __forceinline__ f32x4 ror4(f32x4 v) { f32x4 r; r[0] = dppf<0x120 + N>(v[0]); r[1] = dppf<0x120 + N>(v[1]); r[2] = dppf<0x120 + N>(v[2]); r[3] = dppf<0x120 + N>(v[3]); return r; }
__device__ __forceinline__ float xsum_fq(float v) { v += __shfl_xor(v, 16); v += __shfl_xor(v, 32); return v; }
__device__ __forceinline__ float xmax_fq(float v) { v = fmaxf(v, __shfl_xor(v, 16)); v = fmaxf(v, __shfl_xor(v, 32)); return v; }
__device__ __forceinline__ u32x2 pack4(f32x4 v) { u32x2 w; w.x = cvt_pk_bf16(v[0], v[1]); w.y = cvt_pk_bf16(v[2], v[3]); return w; }
__device__ __forceinline__ u32x2 pack4_mfma(f32x4 v) { u32x2 w; w.x = cvt_pk_bf16_mfma(v[0], v[1]); w.y = cvt_pk_bf16(v[2], v[3]); return w; }
__device__ __forceinline__ u32x4 pack8(f32x4 a, f32x4 b) { u32x4 w; w.x = cvt_pk_bf16(a[0], a[1]); w.y = cvt_pk_bf16(a[2], a[3]); w.z = cvt_pk_bf16(b[0], b[1]); w.w = cvt_pk_bf16(b[2], b[3]); return w; }

__device__ __forceinline__ int tid_opaque() { int t = threadIdx.x; asm volatile("" : "+v"(t)); return t; }

namespace pg8 {
constexpr int BM = 256, BK = 64, HALF = 128, HTB = HALF * BK * 2, NXCD = 8, WGM = 8;
__device__ __forceinline__ int lds_byte(int r, int c) { const int st = (r >> 4) * 2 + (c >> 5), rr = r & 15, cc = c & 31, ob = rr * 64 + cc * 2; return st * 1024 + (ob ^ (((ob >> 9) & 1) << 5)); }
__device__ __forceinline__ void stage_rc(int b, int& R, int& C) { const int st = b / 1024, sb = b % 1024, swz = sb ^ (((sb >> 9) & 1) << 5); R = (st >> 1) * 16 + swz / 64; C = (st & 1) * 32 + (swz % 64) / 2; }
__device__ __forceinline__ int perm32(int rho) { const int n = rho >> 4, i = rho & 15; return 8 * (i >> 2) + 4 * n + (i & 3); }
struct Unit { int pm, pn, k0, nk, split, tl, S; };
struct Gemm { const bf16_t* A; const bf16_t* Bt; int M, N, K; };
struct StaticOrder {
    int nM, nN, nwg, G, c, R, Lf, S, nt, heavy_first, reverse;
    __device__ __forceinline__ void init(int M, int N, int K, int G_, int c_, bool allow_split) {
        nM = M / BM; nN = N / BM; nwg = nM * nN; G = G_; c = c_; nt = K / BK; heavy_first = 0; reverse = 0;
        R = nwg / G; Lf = nwg - R * G; S = 1;
        if (allow_split && Lf > 0 && Lf * 2 <= G) { int smax = G / Lf; int s = nt / 4; while (s > 1 && (s > smax || nt % (2 * s) != 0)) --s; S = s; }
    }
    __device__ __forceinline__ void tile_pmpn(int L, Unit& u) const {
        int wgid = L; if (reverse) { const int xq = L % NXCD, xo = L / NXCD; const int cnt = nwg / NXCD + (xq < nwg % NXCD ? 1 : 0); wgid = xq + (cnt - 1 - xo) * NXCD; }
        { const int q = nwg / NXCD, r = nwg % NXCD, xcd = wgid % NXCD, off = wgid / NXCD; wgid = (xcd < r ? xcd * (q + 1) : r * (q + 1) + (xcd - r) * q) + off; }
        const int nig = WGM * nN, gid = wgid / nig, fm = gid * WGM, gsz = (nM - fm) < WGM ? (nM - fm) : WGM;
        u.pm = fm + ((wgid % nig) % gsz); u.pn = (wgid % nig) / gsz;
        if (heavy_first) { const int q = u.pn; u.pn = q < 2 ? 5 + q : (q < 4 ? 1 + q : q - 4); }
    }
    __device__ __forceinline__ bool next(int i, Unit& u) const {
        int L = 0, k0 = 0, nk = nt, split = 0, tl = 0; bool ok = false;
        if (i < R) { L = i * G + c; ok = true; }
        else if (i == R && S == 1) { L = R * G + c; ok = c < Lf; }
        else if (i == R) { tl = c % Lf; L = R * G + tl; nk = nt / S; k0 = (c / Lf) * nk; split = 1; ok = c < Lf * S; }
        if (!ok) L = 0;
        Unit t; tile_pmpn(L, t);
        u.pm = t.pm; u.pn = t.pn; u.k0 = k0; u.nk = nk; u.split = split; u.tl = tl; u.S = S;
        return ok;
    }
};

template <class Epi>
__device__ __forceinline__ void gemm_phase(LAS unsigned char* lds, const Gemm g, const StaticOrder& S, const Epi& E) {
    const int tid = tid_opaque(), wid = __builtin_amdgcn_readfirstlane(tid >> 6), lane = tid & 63, wr = wid >> 2, wc = wid & 3, fr = lane & 15, fq = lane >> 4;
    const int K = g.K;
    unsigned voffA[2], voffB[2];
#pragma unroll
    for (int i = 0; i < 2; ++i) { int R, C; stage_rc(tid * 16 + i * 8192, R, C); const int Rb = Epi::PERM ? ((R & ~31) + perm32(R & 31)) : R;
        const int Ra = Epi::APERM ? ((R & 64) | ((R & 15) << 2) | ((R >> 4) & 3)) : R;
        voffA[i] = (unsigned)(Ra * K + C) * 2u; voffB[i] = (unsigned)(Rb * K + C) * 2u; }
    const size_t kstep = (size_t)(BK * 2);
    const size_t hstep = (size_t)HALF * K * 2;
    const size_t tstep = 2 * hstep;
    const unsigned ldsw = (unsigned)wid * 1024u;
    const int aoff = lds_byte(wr * 64 + fr, fq * 8), boff = lds_byte(wc * 32 + fr, fq * 8);
#define PG8_SA(b, h) (((b) * 2 + (h)) * HTB)
#define PG8_SB(b, h) ((4 + (b) * 2 + (h)) * HTB)
#define PG8_STAGE(bufoff, gbase, voff) do { _Pragma("unroll") for (int _i = 0; _i < 2; ++_i) \
        __builtin_amdgcn_global_load_lds((const unsigned*)((const char*)(gbase) + (voff)[_i]), (LAS unsigned*)(lds + (bufoff) + ldsw + _i * 8192), 16, 0, 0); } while (0)
#define PG8_LDA(dst, b, h) do { _Pragma("unroll") for (int m = 0; m < 4; ++m) _Pragma("unroll") for (int k = 0; k < 2; ++k) dst[m][k] = *(const LAS bf16x8*)(lds + PG8_SA(b, h) + aoff + m * 2048 + k * 1024); } while (0)
#define PG8_LDB(dst, b, h) do { _Pragma("unroll") for (int n = 0; n < 2; ++n) _Pragma("unroll") for (int k = 0; k < 2; ++k) dst[n][k] = *(const LAS bf16x8*)(lds + PG8_SB(b, h) + boff + n * 2048 + k * 1024); } while (0)
#define PG8_MMA(ai, bj, At, Bt) do { __builtin_amdgcn_s_setprio(1); _Pragma("unroll") for (int m = 0; m < 4; ++m) _Pragma("unroll") for (int n = 0; n < 2; ++n) _Pragma("unroll") for (int k = 0; k < 2; ++k) \
        acc[ai][bj][m][n] = __builtin_amdgcn_mfma_f32_16x16x32_bf16(Bt[n][k], At[m][k], acc[ai][bj][m][n], 0, 0, 0); __builtin_amdgcn_s_setprio(0); } while (0)
#define PG8_WAIT_V(n) asm volatile("s_waitcnt vmcnt(" #n ")" ::: "memory")
#define PG8_WAIT_L(n) asm volatile("s_waitcnt lgkmcnt(" #n ")" ::: "memory")
#define PG8_BAR __builtin_amdgcn_s_barrier()
#define PG8_SCHED __builtin_amdgcn_sched_barrier(0)
    Unit cur, nxt; int ui = 0;
    if (!S.next(0, cur)) return;
    f32x4 acc[2][2][4][2];
#pragma unroll
    for (int a = 0; a < 2; ++a)
#pragma unroll
        for (int b = 0; b < 2; ++b)
#pragma unroll
            for (int m = 0; m < 4; ++m)
#pragma unroll
                for (int n = 0; n < 2; ++n) acc[a][b][m][n] = (f32x4){0.f, 0.f, 0.f, 0.f};
    bf16x8 At[4][2], B0[2][2], B1[2][2];
    const char* cA = (const char*)g.A + (size_t)cur.pm * tstep + (size_t)cur.k0 * kstep; const char* cB = (const char*)g.Bt + (size_t)cur.pn * tstep + (size_t)cur.k0 * kstep;
    PG8_STAGE(PG8_SB(0, 0), cB, voffB); PG8_STAGE(PG8_SB(0, 1), cB + hstep, voffB); PG8_STAGE(PG8_SA(0, 0), cA, voffA); PG8_STAGE(PG8_SA(0, 1), cA + hstep, voffA);
    if (wr == 1) PG8_BAR;
    PG8_WAIT_V(2); PG8_BAR;
    PG8_STAGE(PG8_SB(1, 0), cB + kstep, voffB); PG8_STAGE(PG8_SA(1, 0), cA + kstep, voffA); PG8_STAGE(PG8_SB(1, 1), cB + hstep + kstep, voffB);
    PG8_WAIT_V(6); PG8_BAR;
    for (;;) {
        const bool has_next = S.next(ui + 1, nxt);
        const char* nA = has_next ? (const char*)g.A + (size_t)nxt.pm * tstep + (size_t)nxt.k0 * kstep : cA; const char* nB = has_next ? (const char*)g.Bt + (size_t)nxt.pn * tstep + (size_t)nxt.k0 * kstep : cB;
        const int nt = cur.nk;
        for (int t = 0; t < nt; t += 2) {
            const bool last = (t == nt - 2);
            const char* a1 = cA + (size_t)(t + 1) * kstep;
            const char* a2 = last ? nA : cA + (size_t)(t + 2) * kstep; const char* b2 = last ? nB : cB + (size_t)(t + 2) * kstep;
            const char* a3 = a2 + kstep; const char* b3 = b2 + kstep;
            PG8_LDB(B0, 0, 0); PG8_LDB(B1, 0, 1); PG8_SCHED; PG8_LDA(At, 0, 0); PG8_STAGE(PG8_SA(1, 1), a1 + hstep, voffA);
            PG8_WAIT_V(8); PG8_WAIT_L(0); PG8_BAR; PG8_MMA(0, 0, At, B0); PG8_MMA(0, 1, At, B1); PG8_BAR; PG8_SCHED;
            PG8_LDA(At, 0, 1); PG8_STAGE(PG8_SB(0, 0), b2, voffB); PG8_STAGE(PG8_SB(0, 1), b2 + hstep, voffB); PG8_STAGE(PG8_SA(0, 0), a2, voffA);
            PG8_WAIT_V(8); PG8_WAIT_L(0); PG8_BAR; PG8_MMA(1, 0, At, B0); PG8_MMA(1, 1, At, B1); PG8_BAR; PG8_SCHED;
            PG8_LDB(B0, 1, 0); PG8_LDB(B1, 1, 1); PG8_SCHED; PG8_LDA(At, 1, 0); PG8_STAGE(PG8_SA(0, 1), a2 + hstep, voffA);
            PG8_WAIT_V(8); PG8_WAIT_L(0); PG8_BAR; PG8_MMA(0, 0, At, B0); PG8_MMA(0, 1, At, B1); PG8_BAR; PG8_SCHED;
            PG8_LDA(At, 1, 1); PG8_STAGE(PG8_SB(1, 0), b3, voffB); PG8_STAGE(PG8_SB(1, 1), b3 + hstep, voffB); PG8_STAGE(PG8_SA(1, 0), a3, voffA);
            PG8_WAIT_V(8); PG8_WAIT_L(0); PG8_BAR; PG8_MMA(1, 0, At, B0); PG8_MMA(1, 1, At, B1); PG8_BAR; PG8_SCHED;
        }
        if (wr == 0) PG8_BAR;
        if (!(Epi::CAN_SPLIT && cur.split)) E(acc, cur, wr, wc, fr, fq, lds + LDS_STAGE, wid);
        if (!has_next) break;
#pragma unroll
        for (int a = 0; a < 2; ++a)
#pragma unroll
            for (int b = 0; b < 2; ++b)
#pragma unroll
                for (int m = 0; m < 4; ++m)
#pragma unroll
                    for (int n = 0; n < 2; ++n) acc[a][b][m][n] = (f32x4){0.f, 0.f, 0.f, 0.f};
        cur = nxt; cA = nA; cB = nB; ++ui;
        if (wr == 1) PG8_BAR;
    }
    PG8_WAIT_V(0);
    PG8_BAR;
    if (Epi::CAN_SPLIT && cur.split) E(acc, cur, wr, wc, fr, fq, lds + LDS_STAGE, wid);
#undef PG8_SA
#undef PG8_SB
#undef PG8_STAGE
#undef PG8_LDA
#undef PG8_LDB
#undef PG8_MMA
#undef PG8_WAIT_V
#undef PG8_WAIT_L
#undef PG8_BAR
#undef PG8_SCHED
}
}
using pg8::Unit;

struct EpiMod {
    static constexpr bool PERM = false, CAN_SPLIT = false, APERM = false;
    float* MOD; const float* bias;
    __device__ __forceinline__ void operator()(const f32x4 (&acc)[2][2][4][2], const Unit& u, int wr, int wc, int fr, int fq, LAS unsigned char*, int) const {
        const int col0 = u.pn * 256 + wc * 32 + 4 * fq;
#pragma unroll
        for (int ai = 0; ai < 2; ++ai)
#pragma unroll
            for (int m = 0; m < 4; ++m) {
                const int r = ai * 128 + wr * 64 + m * 16 + fr;
                if (r < 132) {
#pragma unroll
                    for (int bj = 0; bj < 2; ++bj)
#pragma unroll
                        for (int n = 0; n < 2; ++n) { const int c = col0 + bj * 128 + n * 16; *(f32x4*)(MOD + (size_t)r * 12288 + c) = acc[ai][bj][m][n] + *(const f32x4*)(bias + c); }
                }
            }
    }
};

__device__ __forceinline__ f32x4 unpack4(u32x2 w) { f32x4 v; v[0] = __uint_as_float(w.x << 16); v[1] = __uint_as_float(w.x & 0xffff0000u); v[2] = __uint_as_float(w.y << 16); v[3] = __uint_as_float(w.y & 0xffff0000u); return v; }
template <bool INB, bool OUTB>
struct EpiRes {
    static constexpr bool PERM = false, CAN_SPLIT = true, APERM = false;
    const float* xin_p; const float* xin_s; const bf16_t* xin_b; float* xo_f; bf16_t* xo_b; const float* gate;
    unsigned char* ws; unsigned* ticket;
    __device__ __forceinline__ float* slab(int idx) const { return (float*)(idx < 136 ? ws + W_H + (size_t)idx * 262144 : ws + W_ADA + (size_t)(idx - 136) * 262144); }
    __device__ __forceinline__ f32x4 ldx(int r, int c) const {
        if (INB) return unpack4(*(const u32x2*)(xin_b + (size_t)r * 1024 + c));
        return *(const f32x4*)((r < NPR ? xin_p + (size_t)r * 1024 : xin_s + (size_t)(r - NPR) * 1024) + c);
    }
    __device__ __forceinline__ void stx(int r, int c, f32x4 v) const {
        if (OUTB) *(u32x2*)(xo_b + (size_t)r * 1024 + c) = pack4(v); else *(f32x4*)(xo_f + (size_t)r * 1024 + c) = v;
    }
    __device__ __forceinline__ void operator()(const f32x4 (&acc)[2][2][4][2], const Unit& u, int wr, int wc, int fr, int fq, LAS unsigned char*, int wid) const {
        const bool prompt = u.pm < 64;
        const int col0 = u.pn * 256 + wc * 32 + 4 * fq;
        if (!u.split) {
            f32x4 gu[2][2];
            if (prompt) {
#pragma unroll
                for (int bj = 0; bj < 2; ++bj)
#pragma unroll
                    for (int n = 0; n < 2; ++n) gu[bj][n] = *(const f32x4*)(gate + (size_t)(u.pm >> 4) * 12288 + col0 + bj * 128 + n * 16);
            }
            if (INB && prompt) {
                u32x2 xr[2][4][2][2];
#pragma unroll
                for (int ai = 0; ai < 2; ++ai)
#pragma unroll
                    for (int m = 0; m < 4; ++m) { const int r = u.pm * 256 + ai * 128 + wr * 64 + m * 16 + fr;
#pragma unroll
                        for (int bj = 0; bj < 2; ++bj)
#pragma unroll
                            for (int n = 0; n < 2; ++n) xr[ai][m][bj][n] = *(const u32x2*)(xin_b + (size_t)r * 1024 + col0 + bj * 128 + n * 16); }
#pragma unroll
                for (int ai = 0; ai < 2; ++ai)
#pragma unroll
                    for (int m = 0; m < 4; ++m) { const int r = u.pm * 256 + ai * 128 + wr * 64 + m * 16 + fr;
#pragma unroll
                        for (int bj = 0; bj < 2; ++bj)
#pragma unroll
                            for (int n = 0; n < 2; ++n) stx(r, col0 + bj * 128 + n * 16, unpack4(xr[ai][m][bj][n]) + gu[bj][n] * acc[ai][bj][m][n]); }
            } else {
            constexpr int MB = 2;
#pragma unroll
            for (int ai = 0; ai < 2; ++ai)
#pragma unroll
                for (int mb = 0; mb < 4; mb += MB) {
                    u32x2 xr[MB][2][2]; f32x4 xf[INB ? 1 : MB][2][2];
#pragma unroll
                    for (int m = 0; m < MB; ++m) { const int r = u.pm * 256 + ai * 128 + wr * 64 + (mb + m) * 16 + fr;
#pragma unroll
                        for (int bj = 0; bj < 2; ++bj)
#pragma unroll
                            for (int n = 0; n < 2; ++n) { const int c = col0 + bj * 128 + n * 16;
                                if (INB) xr[m][bj][n] = *(const u32x2*)(xin_b + (size_t)r * 1024 + c);
                                else xf[INB ? 0 : m][bj][n] = *(const f32x4*)((r < NPR ? xin_p + (size_t)r * 1024 : xin_s + (size_t)(r - NPR) * 1024) + c); } }
                    f32x4 gs[MB][2][2];
                    if (!prompt) {
#pragma unroll
                        for (int m = 0; m < MB; ++m) { const int r = u.pm * 256 + ai * 128 + wr * 64 + (mb + m) * 16 + fr; const float* gp = gate + (size_t)(4 + ((r - NPR) >> 3)) * 12288;
#pragma unroll
                            for (int bj = 0; bj < 2; ++bj)
#pragma unroll
                                for (int n = 0; n < 2; ++n) gs[m][bj][n] = *(const f32x4*)(gp + col0 + bj * 128 + n * 16); }
                    }
#pragma unroll
                    for (int m = 0; m < MB; ++m) { const int r = u.pm * 256 + ai * 128 + wr * 64 + (mb + m) * 16 + fr;
#pragma unroll
                        for (int bj = 0; bj < 2; ++bj)
#pragma unroll
                            for (int n = 0; n < 2; ++n) { const f32x4 x0 = INB ? unpack4(xr[m][bj][n]) : xf[INB ? 0 : m][bj][n];
                                const f32x4 gg = prompt ? gu[bj][n] : gs[m][bj][n];
                                stx(r, col0 + bj * 128 + n * 16, x0 + gg * acc[ai][bj][mb + m][n]); } }
                }
            }
        } else {
            __amdgpu_buffer_rsrc_t srs = __builtin_amdgcn_make_buffer_rsrc((void*)slab(u.tl * u.S + u.k0 / u.nk), 0, 262144, 0x00020000);
            const unsigned soff = (unsigned)(wc * 32 + 4 * fq) * 4u;
#pragma unroll
            for (int ai = 0; ai < 2; ++ai)
#pragma unroll
                for (int m = 0; m < 4; ++m) {
                    const int rl = ai * 128 + wr * 64 + m * 16 + fr;
                    const int r = u.pm * 256 + rl;
                    const int mrow = prompt ? (r >> 12) : 4 + ((r - NPR) >> 3);
                    const float* gp = gate + (size_t)mrow * 12288;
#pragma unroll
                    for (int bj = 0; bj < 2; ++bj)
#pragma unroll
                        for (int n = 0; n < 2; ++n) { const int c = col0 + bj * 128 + n * 16;
                            const f32x4 d = *(const f32x4*)(gp + c) * acc[ai][bj][m][n];
                            __builtin_amdgcn_raw_buffer_store_b128(__builtin_bit_cast(u32x4, d), srs, soff + (unsigned)(rl * 256 + bj * 128 + n * 16) * 4u, 0, 16); }
                }
        }
        if (u.split) {
            const int lane = fq * 16 + fr;
            asm volatile("s_waitcnt vmcnt(0)" ::: "memory");
            __syncthreads();
            if (threadIdx.x == 0) {
                unsigned* tk = ticket + u.tl;
                const unsigned need = (unsigned)u.S;
                __hip_atomic_fetch_add(tk, 1u, __ATOMIC_RELAXED, __HIP_MEMORY_SCOPE_AGENT);
                unsigned sp = 0;
                while (__hip_atomic_load(tk, __ATOMIC_RELAXED, __HIP_MEMORY_SCOPE_AGENT) < need) { __builtin_amdgcn_s_sleep(2); if (++sp > (1u << 19)) break; }
                __builtin_amdgcn_fence(__ATOMIC_ACQUIRE, "agent");
                asm volatile("s_waitcnt vmcnt(0)" ::: "memory");
            }
            __syncthreads();
            const int w = (u.k0 / u.nk) * 8 + wid, nw = 8 * u.S;
            for (int vb = w * 64 + lane; vb < 16384; vb += 8 * nw * 64) {
                f32x4 tot[8];
#pragma unroll
                for (int k = 0; k < 8; ++k) {
                    const int v = vb + k * nw * 64;
                    if (v < 16384) {
                        const int r = u.pm * 256 + (v >> 6), c = u.pn * 256 + (v & 63) * 4;
                        f32x4 s0 = ldx(r, c), s1 = (f32x4){0.f, 0.f, 0.f, 0.f}, s2 = s1, s3 = s1;
                        int q = 0;
                        for (; q + 4 <= u.S; q += 4) {
                            const f32x4 a0 = *(const f32x4*)(slab(u.tl * u.S + q) + (size_t)v * 4), a1 = *(const f32x4*)(slab(u.tl * u.S + q + 1) + (size_t)v * 4);
                            const f32x4 a2 = *(const f32x4*)(slab(u.tl * u.S + q + 2) + (size_t)v * 4), a3 = *(const f32x4*)(slab(u.tl * u.S + q + 3) + (size_t)v * 4);
                            s0 += a0; s1 += a1; s2 += a2; s3 += a3; }
                        for (; q < u.S; ++q) s1 += *(const f32x4*)(slab(u.tl * u.S + q) + (size_t)v * 4);
                        tot[k] = (s0 + s1) + (s2 + s3);
                    }
                }
#pragma unroll
                for (int k = 0; k < 8; ++k) {
                    const int v = vb + k * nw * 64;
                    if (v < 16384) stx(u.pm * 256 + (v >> 6), u.pn * 256 + (v & 63) * 4, tot[k]);
                }
            }
        }
    }
};

struct EpiIn {
    static constexpr bool PERM = true, CAN_SPLIT = false, APERM = false;
    int layer;
    const float* gq; const float* gk; const float* lng; const float* lnb; const float* rope;
    bf16_t* Q; bf16_t* KB; bf16_t* VB; bf16_t* U; bf16_t* VG; float* out;
    __device__ __forceinline__ void operator()(const f32x4 (&acc)[2][2][4][2], const Unit& u, int wr, int wc, int fr, int fq, LAS unsigned char* ex, int wid) const {
        const int pn = u.pn;
        const bool prompt = u.pm < 64;
        const int rbase = u.pm * 256 + wr * 64 + fr;
        const int dq = 8 * fq;
        if (false) {}
#ifndef NOQK
        else if (pn < 2 || (pn == 2 && wc < 2)) {
            const bool isk = (pn == 2);
            const float* g = isk ? gk : gq;
            f32x4 gv[2][2];
#pragma unroll
            for (int bj = 0; bj < 2; ++bj)
#pragma unroll
                for (int n = 0; n < 2; ++n) gv[bj][n] = *(const f32x4*)(g + bj * 32 + dq + 4 * n);
#pragma unroll
            for (int ai = 0; ai < 2; ++ai)
#pragma unroll
              for (int mb = 0; mb < 4; mb += 4) {
                f32x4 rcs[4][2], rsn[4][2];
#pragma unroll
                for (int mm = 0; mm < 4; ++mm) { const int r = rbase + ai * 128 + (mb + mm) * 16; const float* rp = rope + (prompt ? (r & 4095) : 4096 + (r & 7)) * 16;
#pragma unroll
                    for (int n = 0; n < 2; ++n) { rcs[mm][n] = *(const f32x4*)(rp + 4 * n); rsn[mm][n] = *(const f32x4*)(rp + 8 + 4 * n); } }
#pragma unroll
                for (int mm = 0; mm < 4; ++mm) {
                    const int m = mb + mm;
                    const int r = rbase + ai * 128 + m * 16;
                    float ss = 0.f;
#pragma unroll
                    for (int bj = 0; bj < 2; ++bj)
#pragma unroll
                        for (int n = 0; n < 2; ++n) { const f32x4 v = acc[ai][bj][m][n]; ss += v[0] * v[0] + v[1] * v[1] + v[2] * v[2] + v[3] * v[3]; }
                    ss = xsum_fq(ss);
                    const float rs = rsqrtf(ss * (1.0f / 64.0f) + 1e-6f);
                    f32x4 y[2][2];
#pragma unroll
                    for (int bj = 0; bj < 2; ++bj)
#pragma unroll
                        for (int n = 0; n < 2; ++n) y[bj][n] = acc[ai][bj][m][n] * rs * gv[bj][n];
#pragma unroll
                    for (int n = 0; n < 2; ++n) {
                        const f32x4 cs = rcs[mm][n], sn = rsn[mm][n];
#pragma unroll
                        for (int e = 0; e < 4; ++e) {
                            const float own = y[0][n][e];
                            const float oth = __shfl_xor(own, 16);
                            const float rot = (fq == 0) ? own * cs[e] - oth * sn[e] : own * cs[e] + oth * sn[e];
                            y[0][n][e] = (fq < 2) ? rot : own;
                        }
                    }
                    if (!isk) {
                        bf16_t* qp = Q + (size_t)r * 512 + (pn * 4 + wc) * 64 + dq;
                        *(u32x4*)(qp) = pack8(y[0][0], y[0][1]); *(u32x4*)(qp + 32) = pack8(y[1][0], y[1][1]);
                    } else {
                        bf16_t* kp = KB + (size_t)r * 128 + wc * 64 + dq;
                        *(u32x4*)(kp) = pack8(y[0][0], y[0][1]); *(u32x4*)(kp + 32) = pack8(y[1][0], y[1][1]);
                        float* op = nullptr;
                        if (!prompt) op = out + O_NKS + ((size_t)layer * 1024 + (r - NPR)) * 128;
                        else if ((r & 4095) >= 3968) op = out + O_NKP + (((size_t)layer * 4 + (r >> 12)) * 128 + ((r & 4095) - 3968)) * 128;
                        if (op) { op += wc * 64 + dq;
                            *(f32x4*)(op) = y[0][0]; *(f32x4*)(op + 4) = y[0][1]; *(f32x4*)(op + 32) = y[1][0]; *(f32x4*)(op + 36) = y[1][1]; }
                    }
                }
            }
        }
#endif
#ifndef NOV
        else if (pn == 2) {
#pragma unroll
            for (int ai = 0; ai < 2; ++ai)
#pragma unroll
                for (int m = 0; m < 4; ++m) {
                    const int r = rbase + ai * 128 + m * 16;
                    bf16_t* vp = VB + (size_t)r * 128 + (wc - 2) * 64 + dq;
                    *(u32x4*)(vp) = pack8(acc[ai][0][m][0], acc[ai][0][m][1]); *(u32x4*)(vp + 32) = pack8(acc[ai][1][m][0], acc[ai][1][m][1]);
                    float* op = nullptr;
                    if (!prompt) op = out + O_NVS + ((size_t)layer * 1024 + (r - NPR)) * 128;
                    else if ((r & 4095) >= 3968) op = out + O_NVP + (((size_t)layer * 4 + (r >> 12)) * 128 + ((r & 4095) - 3968)) * 128;
                    if (op) { op += (wc - 2) * 64 + dq;
                        *(f32x4*)(op) = acc[ai][0][m][0]; *(f32x4*)(op + 4) = acc[ai][0][m][1]; *(f32x4*)(op + 32) = acc[ai][1][m][0]; *(f32x4*)(op + 36) = acc[ai][1][m][1]; }
                }
        }
#endif
#ifndef NOU
        else if (pn < 5) {
#pragma unroll
            for (int ai = 0; ai < 2; ++ai)
#pragma unroll
                for (int m = 0; m < 4; ++m) {
                    const int r = rbase + ai * 128 + m * 16;
                    f32x4 y[2][2];
#pragma unroll
                    for (int bj = 0; bj < 2; ++bj)
#pragma unroll
                        for (int n = 0; n < 2; ++n)
#pragma unroll
                            for (int e = 0; e < 4; ++e) y[bj][n][e] = gelu_f(acc[ai][bj][m][n][e]);
                    bf16_t* up = U + (size_t)r * 512 + (pn - 3) * 256 + wc * 64 + dq;
                    *(u32x4*)(up) = pack8(y[0][0], y[0][1]); *(u32x4*)(up + 32) = pack8(y[1][0], y[1][1]);
                }
        }
#endif
#ifndef NOLN
        else {
            LAS f32x2* exo = (LAS f32x2*)ex + wid * 128 + fr;
            LAS f32x2* exp_ = (LAS f32x2*)ex + (wid ^ 1) * 128 + fr;
#pragma unroll
            for (int ai = 0; ai < 2; ++ai)
#pragma unroll
                for (int m = 0; m < 4; ++m) {
                    float a = 0.f, b = 0.f;
#pragma unroll
                    for (int bj = 0; bj < 2; ++bj)
#pragma unroll
                        for (int n = 0; n < 2; ++n)
#pragma unroll
                            for (int e = 0; e < 4; ++e) { const float gl = gelu_f(acc[ai][bj][m][n][e]); a += gl; b += gl * gl; }
                    a = xsum_fq(a); b = xsum_fq(b);
                    if (fq == 0) exo[(ai * 4 + m) * 16] = (f32x2){a, b};
                }
            asm volatile("s_waitcnt lgkmcnt(0)" ::: "memory");
            __builtin_amdgcn_s_barrier();
            asm volatile("" ::: "memory");
            const int grp = (pn - 5) * 2 + (wc >> 1);
            const int w0 = (wc & 1) * 64 + dq;
            f32x4 lgv[2][2], lbv[2][2];
#pragma unroll
            for (int bj = 0; bj < 2; ++bj)
#pragma unroll
                for (int n = 0; n < 2; ++n) { lgv[bj][n] = *(const f32x4*)(lng + grp * 128 + w0 + bj * 32 + 4 * n); lbv[bj][n] = *(const f32x4*)(lnb + grp * 128 + w0 + bj * 32 + 4 * n); }
#pragma unroll
            for (int ai = 0; ai < 2; ++ai)
#pragma unroll
                for (int m = 0; m < 4; ++m) {
                    const int r = rbase + ai * 128 + m * 16;
                    const f32x2 o0 = exo[(ai * 4 + m) * 16];
                    const f32x2 o1 = exp_[(ai * 4 + m) * 16];
                    const float mean = (o0.x + o1.x) * (1.0f / 128.0f);
                    const float var = fmaxf((o0.y + o1.y) * (1.0f / 128.0f) - mean * mean, 0.f);
                    const float rstd = rsqrtf(var + 1e-6f);
                    bf16_t* vp = VG + (size_t)r * 512 + grp * 128 + w0;
                    float* op = out + O_NGS + ((size_t)layer * 1024 + (r - NPR)) * 512 + grp * 128 + w0;
#pragma unroll
                    for (int bj = 0; bj < 2; ++bj) {
                        f32x4 g0, g1;
#pragma unroll
                        for (int e = 0; e < 4; ++e) { float x0 = acc[ai][bj][m][0][e], x1 = acc[ai][bj][m][1][e]; asm volatile("" : "+v"(x0), "+v"(x1)); g0[e] = gelu_f(x0); g1[e] = gelu_f(x1); }
                        const f32x4 y0 = (g0 - mean) * rstd * lgv[bj][0] + lbv[bj][0];
                        const f32x4 y1 = (g1 - mean) * rstd * lgv[bj][1] + lbv[bj][1];
                        *(u32x4*)(vp + bj * 32) = pack8(y0, y1);
                        if (!prompt) { *(f32x4*)(op + bj * 32) = y0; *(f32x4*)(op + bj * 32 + 4) = y1; }
                    }
                    asm volatile("" ::: "memory");
                }
        }
#endif
    }
};

struct EpiFfnIn {
    static constexpr bool PERM = true, CAN_SPLIT = false, APERM = true;
    const float* cw; const float* cb; const float* cc;
    bf16_t* ACT; bf16_t* HALO; float* ncs; float* ncp;
    __device__ __forceinline__ static f32x4 shr1(f32x4 v) { f32x4 r; r[0] = dppf<0x111>(v[0]); r[1] = dppf<0x111>(v[1]); r[2] = dppf<0x111>(v[2]); r[3] = dppf<0x111>(v[3]); return r; }
    __device__ __forceinline__ static f32x4 act4(f32x4 g, f32x4 u) { f32x4 a; a[0] = silu_f(g[0]) * u[0]; a[1] = silu_f(g[1]) * u[1]; a[2] = silu_f(g[2]) * u[2]; a[3] = silu_f(g[3]) * u[3]; return a; }
    __device__ __forceinline__ void operator()(const f32x4 (&acc)[2][2][4][2], const Unit& u, int wr, int wc, int fr, int fq, LAS unsigned char*, int) const {
        const bool prompt = u.pm < 64;
        const int gc0 = u.pn * 128 + wc * 32 + 8 * fq;
        u32x2 res[2][2][4];
#pragma unroll
        for (int n = 0; n < 2; ++n) {
            const int gc = gc0 + 4 * n;
            const f32x4 w0g = *(const f32x4*)(cw + gc), w1g = *(const f32x4*)(cw + 5632 + gc), w2g = *(const f32x4*)(cw + 11264 + gc), bg = *(const f32x4*)(cb + gc);
            const f32x4 w0u = *(const f32x4*)(cw + 2816 + gc), w1u = *(const f32x4*)(cw + 5632 + 2816 + gc), w2u = *(const f32x4*)(cw + 11264 + 2816 + gc), bu = *(const f32x4*)(cb + 2816 + gc);
#pragma unroll
            for (int ai = 0; ai < 2; ++ai) {
                const int r0 = u.pm * 256 + ai * 128 + wr * 64 + 4 * fr;
                const f32x4 g0 = acc[ai][0][0][n], g1 = acc[ai][0][1][n], g2 = acc[ai][0][2][n], g3 = acc[ai][0][3][n];
                const f32x4 u0 = acc[ai][1][0][n], u1 = acc[ai][1][1][n], u2 = acc[ai][1][2][n], u3 = acc[ai][1][3][n];
                f32x4 pg2 = shr1(g2), pg3 = shr1(g3), pu2 = shr1(u2), pu3 = shr1(u3);
                if (!prompt && (fr & 1) == 0) { const float* cp = cc + (size_t)((r0 - NPR) >> 3) * 2 * 5632;
                    pg2 = *(const f32x4*)(cp + gc); pg3 = *(const f32x4*)(cp + 5632 + gc); pu2 = *(const f32x4*)(cp + 2816 + gc); pu3 = *(const f32x4*)(cp + 5632 + 2816 + gc); }
                res[n][ai][0] = pack4(act4(bg + w0g * pg2 + w1g * pg3 + w2g * g0, bu + w0u * pu2 + w1u * pu3 + w2u * u0));
                res[n][ai][1] = pack4(act4(bg + w0g * pg3 + w1g * g0 + w2g * g1, bu + w0u * pu3 + w1u * u0 + w2u * u1));
                res[n][ai][2] = pack4(act4(bg + w0g * g0 + w1g * g1 + w2g * g2, bu + w0u * u0 + w1u * u1 + w2u * u2));
                res[n][ai][3] = pack4(act4(bg + w0g * g1 + w1g * g2 + w2g * g3, bu + w0u * u1 + w1u * u2 + w2u * u3));
            }
        }
#pragma unroll
        for (int ai = 0; ai < 2; ++ai) {
            const int r0 = u.pm * 256 + ai * 128 + wr * 64 + 4 * fr;
            bf16_t* ap = ACT + (size_t)r0 * 2816 + gc0;
#pragma unroll
            for (int m = 0; m < 4; ++m) *(u32x4*)(ap + m * 2816) = (u32x4){res[0][ai][m].x, res[0][ai][m].y, res[1][ai][m].x, res[1][ai][m].y};
#pragma unroll
            for (int n = 0; n < 2; ++n) {
                const int gc = gc0 + 4 * n;
                const f32x4 g0 = acc[ai][0][0][n], g1 = acc[ai][0][1][n], g2 = acc[ai][0][2][n], g3 = acc[ai][0][3][n];
                const f32x4 u0 = acc[ai][1][0][n], u1 = acc[ai][1][1][n], u2 = acc[ai][1][2][n], u3 = acc[ai][1][3][n];
                if (prompt) {
                    if (fr == 0) { bf16_t* hp = HALO + (size_t)(r0 >> 6) * 4 * 5632;
                        *(u32x2*)(hp + gc) = pack4(g0); *(u32x2*)(hp + 2816 + gc) = pack4(u0); *(u32x2*)(hp + 5632 + gc) = pack4(g1); *(u32x2*)(hp + 5632 + 2816 + gc) = pack4(u1); }
                    if (fr == 15) { bf16_t* hp = HALO + ((size_t)(r0 >> 6) * 4 + 2) * 5632;
                        *(u32x2*)(hp + gc) = pack4(g2); *(u32x2*)(hp + 2816 + gc) = pack4(u2); *(u32x2*)(hp + 5632 + gc) = pack4(g3); *(u32x2*)(hp + 5632 + 2816 + gc) = pack4(u3);
                        if ((r0 & 4095) == 4092) { float* op = ncp + (size_t)(r0 >> 12) * 2 * 5632;
                            *(f32x4*)(op + gc) = g2; *(f32x4*)(op + 2816 + gc) = u2; *(f32x4*)(op + 5632 + gc) = g3; *(f32x4*)(op + 5632 + 2816 + gc) = u3; } }
                } else if (fr & 1) { float* op = ncs + (size_t)((r0 - NPR) >> 3) * 2 * 5632;
                    *(f32x4*)(op + gc) = g2; *(f32x4*)(op + 2816 + gc) = u2; *(f32x4*)(op + 5632 + gc) = g3; *(f32x4*)(op + 5632 + 2816 + gc) = u3; }
            }
        }
    }
};

__device__ __forceinline__ int perm_row(int nn, int ptype) {
    if (ptype == 1) { const int pn = nn >> 8, j = nn & 255; return pn * 256 + ((j >> 5) & 1) * 128 + (j >> 6) * 32 + (j & 31); }
    if (ptype == 2) { const int h = nn >= 2816 ? 1 : 0, jj = nn - h * 2816; return (jj >> 7) * 256 + h * 128 + (jj & 127); }
    return nn;
}
struct ConvJob { const float* src; bf16_t* dst; int N, K, k0, n0, ptype; };
__device__ __forceinline__ void conv_load(const ConvJob& jb, int tid, f32x4 (&v)[8]) {
#pragma unroll
    for (int i = 0; i < 8; ++i) { const int idx = tid + i * 512, kk = idx >> 6, c4 = idx & 63; v[i] = *(const f32x4*)(jb.src + (size_t)(jb.k0 + kk) * jb.N + jb.n0 + c4 * 4); }
}
__device__ __forceinline__ void conv_to_lds(int tid, const f32x4 (&v)[8], float* tl) {
#pragma unroll
    for (int i = 0; i < 8; ++i) { const int idx = tid + i * 512, kk = idx >> 6, c4 = idx & 63; float* t = tl + kk * 257 + c4 * 4; t[0] = v[i][0]; t[1] = v[i][1]; t[2] = v[i][2]; t[3] = v[i][3]; }
}
__device__ __forceinline__ void conv_store(const ConvJob& jb, int tid, const float* tl) {
#pragma unroll
    for (int i = 0; i < 4; ++i) {
        const int idx = tid + i * 512, kg = idx & 7, n = idx >> 3;
        const float* t = tl + (kg * 8) * 257 + n;
        u32x4 w; w.x = cvt_pk_bf16(t[0], t[257]); w.y = cvt_pk_bf16(t[2 * 257], t[3 * 257]); w.z = cvt_pk_bf16(t[4 * 257], t[5 * 257]); w.w = cvt_pk_bf16(t[6 * 257], t[7 * 257]);
        *(u32x4*)(jb.dst + (size_t)perm_row(jb.n0 + n, jb.ptype) * jb.K + jb.k0 + kg * 8) = w;
    }
}
__device__ __forceinline__ ConvJob conv_job_main(const Params& p, int j) {
    ConvJob jb; int l, t;
    if (j < 224) { l = j / 112; t = j % 112; jb.N = 1792; jb.K = 1024; jb.ptype = 1; jb.src = p.in[10] + (size_t)l * 1024 * 1792; jb.dst = (bf16_t*)(p.ws + W_IN) + (size_t)l * 1792 * 1024; }
    else if (j < 352) { j -= 224; l = j / 64; t = j % 64; jb.N = 1024; jb.K = 1024; jb.ptype = 0; jb.src = p.in[18] + (size_t)l * 1024 * 1024; jb.dst = (bf16_t*)(p.ws + W_OUT) + (size_t)l * 1024 * 1024; }
    else if (j < 1056) { j -= 352; l = j / 352; t = j % 352; jb.N = 5632; jb.K = 1024; jb.ptype = 2; jb.src = p.in[20] + (size_t)l * 1024 * 5632; jb.dst = (bf16_t*)(p.ws + W_FIN) + (size_t)l * 5632 * 1024; }
    else { j -= 1056; l = j / 176; t = j % 176; jb.N = 1024; jb.K = 2816; jb.ptype = 0; jb.src = p.in[23] + (size_t)l * 2816 * 1024; jb.dst = (bf16_t*)(p.ws + W_FOUT) + (size_t)l * 1024 * 2816; }
    const int nn = jb.N / 256; jb.k0 = (t / nn) * 64; jb.n0 = (t % nn) * 256;
    return jb;
}
__device__ __forceinline__ ConvJob conv_job_ada(const Params& p, int j) {
    ConvJob jb; const int l = j / 384, t = j % 384;
    jb.N = 6144; jb.K = 1024; jb.ptype = 0; jb.src = p.in[7] + (size_t)l * 1024 * 6144; jb.dst = (bf16_t*)(p.ws + W_ADA) + (size_t)l * 6144 * 1024; jb.k0 = (t / 24) * 64; jb.n0 = (t % 24) * 256;
    return jb;
}
template <bool ADA>
__device__ __forceinline__ void conv_run(const Params& p, int j0, int step, int njobs, float* tl) {
    const int tid = tid_opaque();
    if (j0 >= njobs) return;
    ConvJob cur = ADA ? conv_job_ada(p, j0) : conv_job_main(p, j0);
    f32x4 v[8];
    conv_load(cur, tid, v);
    for (int j = j0; j < njobs; j += step) {
        conv_to_lds(tid, v, tl);
        __syncthreads();
        const int jn = j + step; const bool hn = jn < njobs;
        ConvJob nxt = cur;
        if (hn) { nxt = ADA ? conv_job_ada(p, jn) : conv_job_main(p, jn); conv_load(nxt, tid, v); }
        conv_store(cur, tid, tl);
        __syncthreads();
        cur = nxt;
    }
}

__device__ __forceinline__ void phase_prep(const Params& p, unsigned char* shm) {
    float* tl = (float*)shm;
    const int nb = gridDim.x, bid = blockIdx.x, tid = tid_opaque();
    conv_run<true>(p, bid, nb, 768, tl);
    const int gtid = bid * 512 + tid, gn = nb * 512;
    bf16_t* CS = (bf16_t*)(p.ws + W_CS);
    for (int i = gtid; i < 256 * 1024 / 2; i += gn) { const int e = i * 2, row = e >> 10; float a = 0.f, b = 0.f;
        if (row < 4) { a = p.in[5][e]; b = p.in[5][e + 1]; } else if (row < 132) { a = p.in[6][e - 4096]; b = p.in[6][e - 4096 + 1]; }
        *(unsigned*)(CS + e) = cvt_pk_bf16(silu_f(a), silu_f(b)); }
    float* RT = (float*)(p.ws + W_ROPE);
    for (int i = gtid; i < 4104 * 8; i += gn) { const int pidx = i >> 3, a = i & 7; const int pos = pidx < 4096 ? pidx : 16384 + (pidx - 4096);
        const double ang = (double)pos * p.inv[a];
        const double kq = rint(ang * 0.63661977236758134308);
        double rr = fma(-kq, 1.5707963267948966192, ang); rr = fma(-kq, 6.123233995736766036e-17, rr);
        const double r2 = rr * rr;
        const double sn = rr * (1.0 + r2 * (-1.0 / 6 + r2 * (1.0 / 120 + r2 * (-1.0 / 5040 + r2 * (1.0 / 362880 + r2 * (-1.0 / 39916800))))));
        const double cs = 1.0 + r2 * (-0.5 + r2 * (1.0 / 24 + r2 * (-1.0 / 720 + r2 * (1.0 / 40320 + r2 * (-1.0 / 3628800 + r2 * (1.0 / 479001600))))));
        const int q = ((int)((long long)kq & 3));
        double c_, s_;
        if (q == 0) { c_ = cs; s_ = sn; } else if (q == 1) { c_ = -sn; s_ = cs; } else if (q == 2) { c_ = -cs; s_ = -sn; } else { c_ = sn; s_ = -cs; }
        RT[pidx * 16 + a] = (float)c_; RT[pidx * 16 + 8 + a] = (float)s_; }
    bf16_t* WSB = (bf16_t*)(p.ws + W_WS);
    for (int i = gtid; i < 2 * 4 * 128 * 128 / 2; i += gn) { const int e = i * 2, s = e & 127, t = (e >> 7) & 127;
        const float a = (s <= t) ? p.in[16][e] : 0.f, b = (s + 1 <= t) ? p.in[16][e + 1] : 0.f;
        *(unsigned*)(WSB + e) = cvt_pk_bf16(a, b); }
}

template <bool INB>
__device__ __forceinline__ void phase_norm(const float* xp, const float* xs, const bf16_t* xb, const float* gvec, const float* mod_sh, const float* mod_sc, bf16_t* H) {
    const int tid = tid_opaque(); const int wid = tid >> 6, lane = tid & 63;
    const int nw = gridDim.x * 8;
    f32x4 g[4];
#pragma unroll
    for (int i = 0; i < 4; ++i) g[i] = *(const f32x4*)(gvec + i * 256 + lane * 4);
    int r = blockIdx.x * 8 + wid;
    f32x4 v[4], sc[4], sh[4];
    auto load_row = [&](int rr, f32x4 (&vv)[4], f32x4 (&scc)[4], f32x4 (&shh)[4]) {
        const int mrow = rr < NPR ? (rr >> 12) : 4 + ((rr - NPR) >> 3);
#pragma unroll
        for (int i = 0; i < 4; ++i) { const int c = i * 256 + lane * 4;
            if (INB) vv[i] = unpack4(*(const u32x2*)(xb + (size_t)rr * 1024 + c));
            else vv[i] = *(const f32x4*)((rr < NPR ? xp + (size_t)rr * 1024 : xs + (size_t)(rr - NPR) * 1024) + c);
            scc[i] = *(const f32x4*)(mod_sc + (size_t)mrow * 12288 + c); shh[i] = *(const f32x4*)(mod_sh + (size_t)mrow * 12288 + c); }
    };
    if (r < MT) load_row(r, v, sc, sh);
    while (r < MT) {
        const int rn = r + nw; const int rnc = rn < MT ? rn : r;
        f32x4 v2[4], sc2[4], sh2[4];
        load_row(rnc, v2, sc2, sh2);
        float ss = 0.f;
#pragma unroll
        for (int i = 0; i < 4; ++i) ss += v[i][0] * v[i][0] + v[i][1] * v[i][1] + v[i][2] * v[i][2] + v[i][3] * v[i][3];
#pragma unroll
        for (int o = 32; o >= 1; o >>= 1) ss += __shfl_xor(ss, o);
        const float rs = rsqrtf(ss * (1.0f / 1024.0f) + 1e-6f);
#pragma unroll
        for (int i = 0; i < 4; ++i) *(u32x2*)(H + (size_t)r * 1024 + i * 256 + lane * 4) = pack4(v[i] * rs * g[i] * (sc[i] + 1.0f) + sh[i]);
#pragma unroll
        for (int i = 0; i < 4; ++i) { v[i] = v2[i]; sc[i] = sc2[i]; sh[i] = sh2[i]; }
        r = rn;
    }
}

__device__ __forceinline__ void attn_unit(const Params& p, int layer, bool sample, int b, int blk, int kvh, unsigned char* shm) {
    bf16_t* Ks = (bf16_t*)shm;
    bf16_t* Vt = Ks + 256 * 72;
    bf16_t* Pw = Vt + 64 * 280;
    const bf16_t* Q = (const bf16_t*)(p.ws + W_Q); const bf16_t* KB = (const bf16_t*)(p.ws + W_KB); const bf16_t* VB = (const bf16_t*)(p.ws + W_VB);
    bf16_t* MIX = (bf16_t*)(p.ws + W_MIX);
    const int tid = tid_opaque(), wid = tid >> 6, lane = tid & 63, fr = lane & 15, fq = lane >> 4;
    if (!sample) {
        const int row0 = b * 4096 + blk * 128 - 128;
#pragma unroll
        for (int i = 0; i < 4; ++i) { const int idx = tid + i * 512, j = idx >> 3, c8 = idx & 7; int gr = row0 + j; if (gr < b * 4096) gr += 128;
            *(u32x4*)(Ks + j * 72 + c8 * 8) = *(const u32x4*)(KB + (size_t)gr * 128 + kvh * 64 + c8 * 8); }
#pragma unroll
        for (int i = 0; i < 4; ++i) { const int idx = tid + i * 512, j = idx & 255, c8 = idx >> 8; int gr = row0 + j; if (gr < b * 4096) gr += 128;
            const u32x4 v = *(const u32x4*)(VB + (size_t)gr * 128 + kvh * 64 + c8 * 8);
            bf16_t* d = Vt + (c8 * 8) * 280 + j;
            d[0] = (bf16_t)(v.x & 0xffff); d[280] = (bf16_t)(v.x >> 16); d[2 * 280] = (bf16_t)(v.y & 0xffff); d[3 * 280] = (bf16_t)(v.y >> 16);
            d[4 * 280] = (bf16_t)(v.z & 0xffff); d[5 * 280] = (bf16_t)(v.z >> 16); d[6 * 280] = (bf16_t)(v.w & 0xffff); d[7 * 280] = (bf16_t)(v.w >> 16); }
        for (int i = tid; i < 64 * 24; i += 512) Vt[(i / 24) * 280 + 256 + (i % 24)] = 0;
    } else {
        const float* ck = p.in[2] + ((size_t)(layer * 128 + b) * 128) * 128 + kvh * 64;
        const float* cv = p.in[3] + ((size_t)(layer * 128 + b) * 128) * 128 + kvh * 64;
#pragma unroll
        for (int i = 0; i < 4; ++i) { const int idx = tid + i * 512, j = idx >> 4, c4 = idx & 15;
            const f32x4 v = __builtin_nontemporal_load((const f32x4*)(ck + (size_t)j * 128 + c4 * 4)); *(u32x2*)(Ks + j * 72 + c4 * 4) = pack4(v); }
#pragma unroll
        for (int i = 0; i < 4; ++i) { const int idx = tid + i * 512, j = idx & 127, c4 = idx >> 7;
            const f32x4 v = __builtin_nontemporal_load((const f32x4*)(cv + (size_t)j * 128 + c4 * 4)); const u32x2 w = pack4(v);
            bf16_t* d = Vt + (c4 * 4) * 280 + j;
            d[0] = (bf16_t)(w.x & 0xffff); d[280] = (bf16_t)(w.x >> 16); d[2 * 280] = (bf16_t)(w.y & 0xffff); d[3 * 280] = (bf16_t)(w.y >> 16); }
        if (tid < 128) { const int s = tid >> 3, c8 = tid & 7; u32x4 v = (u32x4){0u, 0u, 0u, 0u};
            if (s < 8) v = *(const u32x4*)(KB + (size_t)(NPR + b * 8 + s) * 128 + kvh * 64 + c8 * 8);
            *(u32x4*)(Ks + (128 + s) * 72 + c8 * 8) = v;
        } else if (tid < 256) { const int t2 = tid - 128, s = t2 & 15, c8 = t2 >> 4; u32x4 v = (u32x4){0u, 0u, 0u, 0u};
            if (s < 8) v = *(const u32x4*)(VB + (size_t)(NPR + b * 8 + s) * 128 + kvh * 64 + c8 * 8);
            bf16_t* d = Vt + (c8 * 8) * 280 + 128 + s;
            d[0] = (bf16_t)(v.x & 0xffff); d[280] = (bf16_t)(v.x >> 16); d[2 * 280] = (bf16_t)(v.y & 0xffff); d[3 * 280] = (bf16_t)(v.y >> 16);
            d[4 * 280] = (bf16_t)(v.z & 0xffff); d[5 * 280] = (bf16_t)(v.z >> 16); d[6 * 280] = (bf16_t)(v.w & 0xffff); d[7 * 280] = (bf16_t)(v.w >> 16);
        } else { const int t2 = tid - 256; for (int i = t2; i < 64 * 16; i += 256) Vt[(i >> 4) * 280 + 144 + (i & 15)] = 0; }
    }
    __syncthreads();
    const int hh = wid >> 1, half = wid & 1, head = kvh * 4 + hh;
    const int ntile = sample ? (half == 0 ? 1 : 0) : 4;
    const int kmin = sample ? 0 : (blk == 0 ? 128 : 0), kmax = sample ? 136 : 256;
    const float sink = p.in[13][layer * 8 + head];
    bf16_t* Pme = Pw + wid * 16 * 168;
    u32x2 ores[4][4];
    for (int rt = 0; rt < ntile; ++rt) {
        const int i0 = sample ? 0 : half * 64 + rt * 16;
        const int qi = sample ? (fr & 7) : i0 + fr;
        const size_t grow = sample ? (size_t)(NPR + b * 8 + qi) : (size_t)(b * 4096 + blk * 128 + qi);
        const bf16_t* qp = Q + grow * 512 + head * 64;
        bf16x8 qf[2]; qf[0] = *(const bf16x8*)(qp + fq * 8); qf[1] = *(const bf16x8*)(qp + 32 + fq * 8);
        f32x4 s[9];
#pragma unroll
        for (int kt = 0; kt < 9; ++kt) { s[kt] = (f32x4){0.f, 0.f, 0.f, 0.f};
#pragma unroll
            for (int ks = 0; ks < 2; ++ks) { const bf16x8 kf = *(const bf16x8*)(Ks + (i0 + 16 * kt + fr) * 72 + ks * 32 + fq * 8);
                s[kt] = __builtin_amdgcn_mfma_f32_16x16x32_bf16(kf, qf[ks], s[kt], 0, 0, 0); } }
        float mx = sink;
#pragma unroll
        for (int kt = 0; kt < 9; ++kt)
#pragma unroll
            for (int e = 0; e < 4; ++e) { const int kb = i0 + 16 * kt + 4 * fq + e;
                const bool valid = (!sample && kt >= 1 && kt <= 7) ? (i0 + 16 * kt >= kmin) : ((kb >= qi + 1) && (kb <= qi + 128) && (kb >= kmin) && (kb < kmax));
                const float sc = valid ? s[kt][e] * 0.125f : -1e30f; s[kt][e] = sc; mx = fmaxf(mx, sc); }
        mx = xmax_fq(mx);
        float sum = 0.f;
#pragma unroll
        for (int kt = 0; kt < 9; ++kt)
#pragma unroll
            for (int e = 0; e < 4; ++e) { const float pe = fast_exp(s[kt][e] - mx); s[kt][e] = pe; sum += pe; }
        sum = xsum_fq(sum) + fast_exp(sink - mx);
        const float inv = 1.0f / sum;
#pragma unroll
        for (int kt = 0; kt < 9; ++kt) *(u32x2*)(Pme + fr * 168 + 16 * kt + 4 * fq) = pack4(s[kt] * inv);
        *(u32x2*)(Pme + fr * 168 + 144 + 4 * fq) = (u32x2){0u, 0u};
        asm volatile("s_waitcnt lgkmcnt(0)" ::: "memory");
        f32x4 o[4];
#pragma unroll
        for (int dt = 0; dt < 4; ++dt) o[dt] = (f32x4){0.f, 0.f, 0.f, 0.f};
#pragma unroll
        for (int ks = 0; ks < 5; ++ks) { const bf16x8 pf = *(const bf16x8*)(Pme + fr * 168 + ks * 32 + fq * 8);
#pragma unroll
            for (int dt = 0; dt < 4; ++dt) { const bf16x8 vf = *(const bf16x8*)(Vt + (16 * dt + fr) * 280 + i0 + ks * 32 + fq * 8);
                o[dt] = __builtin_amdgcn_mfma_f32_16x16x32_bf16(vf, pf, o[dt], 0, 0, 0); } }
#pragma unroll
        for (int dt = 0; dt < 4; ++dt) {
            const u32x2 pk = pack4_mfma(o[dt]);
            if (rt == 0) ores[0][dt] = pk; else if (rt == 1) ores[1][dt] = pk; else if (rt == 2) ores[2][dt] = pk; else ores[3][dt] = pk; }
        asm volatile("s_waitcnt lgkmcnt(0)" ::: "memory");
    }
#pragma unroll
    for (int rt = 0; rt < 4; ++rt) {
        if (rt < ntile && (!sample || fr < 8)) {
            const int qi = sample ? (fr & 7) : half * 64 + rt * 16 + fr;
            const size_t grow = sample ? (size_t)(NPR + b * 8 + qi) : (size_t)(b * 4096 + blk * 128 + qi);
            bf16_t* mp = MIX + grow * 1024 + head * 64 + 4 * fq;
#pragma unroll
            for (int dt = 0; dt < 4; ++dt) *(u32x2*)(mp + 16 * dt) = ores[rt][dt];
        }
    }
    __syncthreads();
}

__device__ __forceinline__ void sg_unit(const Params& p, int layer, int b, int chunk, int g, unsigned char* shm) {
    bf16_t* VGt = (bf16_t*)shm;
    const bf16_t* U = (const bf16_t*)(p.ws + W_U); const bf16_t* VG = (const bf16_t*)(p.ws + W_VG); const bf16_t* WSB = (const bf16_t*)(p.ws + W_WS);
    bf16_t* MIX = (bf16_t*)(p.ws + W_MIX);
    const int tid = tid_opaque(), wid = tid >> 6, lane = tid & 63, fr = lane & 15, fq = lane >> 4;
    const int rb = b * 4096 + chunk * 128;
    const int t0 = 16 * wid, nks = (wid >> 1) + 1;
    const bf16_t* wp = WSB + ((size_t)(layer * 4 + g) * 128 + t0 + fr) * 128 + fq * 8;
    bf16x8 wfa[4];
#pragma unroll
    for (int ks = 0; ks < 4; ++ks) wfa[ks] = *(const bf16x8*)(wp + ks * 32);
    const float bs = p.in[17][(layer * 4 + g) * 128 + t0 + fr];
    const size_t row = (size_t)(rb + t0 + fr);
    u32x2 ua[8];
#pragma unroll
    for (int wt = 0; wt < 8; ++wt) ua[wt] = *(const u32x2*)(U + row * 512 + g * 128 + 16 * wt + 4 * fq);
#pragma unroll
    for (int i = 0; i < 4; ++i) { const int idx = tid + i * 512, s = idx & 127, c8 = idx >> 7;
        const u32x4 v = *(const u32x4*)(VG + (size_t)(rb + s) * 512 + g * 128 + c8 * 8);
        bf16_t* d = VGt + (c8 * 8) * 136 + s;
        d[0] = (bf16_t)(v.x & 0xffff); d[136] = (bf16_t)(v.x >> 16); d[2 * 136] = (bf16_t)(v.y & 0xffff); d[3 * 136] = (bf16_t)(v.y >> 16);
        d[4 * 136] = (bf16_t)(v.z & 0xffff); d[5 * 136] = (bf16_t)(v.z >> 16); d[6 * 136] = (bf16_t)(v.w & 0xffff); d[7 * 136] = (bf16_t)(v.w >> 16); }
    __syncthreads();
    f32x4 z[8];
#pragma unroll
    for (int wt = 0; wt < 8; ++wt) z[wt] = (f32x4){0.f, 0.f, 0.f, 0.f};
#pragma unroll
    for (int ks = 0; ks < 4; ++ks) { if (ks >= nks) break;
#pragma unroll
        for (int wt = 0; wt < 8; ++wt) { const bf16x8 vf = *(const bf16x8*)(VGt + (16 * wt + fr) * 136 + ks * 32 + fq * 8);
            z[wt] = __builtin_amdgcn_mfma_f32_16x16x32_bf16(vf, wfa[ks], z[wt], 0, 0, 0); } }
#pragma unroll
    for (int wt = 0; wt < 8; ++wt) { const int c = g * 128 + 16 * wt + 4 * fq;
        const u32x2 uu = ua[wt];
        f32x4 o; o[0] = __uint_as_float(uu.x << 16) * (z[wt][0] + bs); o[1] = __uint_as_float(uu.x & 0xffff0000u) * (z[wt][1] + bs);
        o[2] = __uint_as_float(uu.y << 16) * (z[wt][2] + bs); o[3] = __uint_as_float(uu.y & 0xffff0000u) * (z[wt][3] + bs);
        *(u32x2*)(MIX + row * 1024 + 512 + c) = pack4(o); }
    __syncthreads();
}

__device__ __forceinline__ void phase_mix(const Params& p, int layer, unsigned char* shm) {
    const int nb = gridDim.x, bid = blockIdx.x;
#ifndef NO_MIXA
    for (int u = bid; u < 256; u += nb) attn_unit(p, layer, false, u >> 6, (u >> 1) & 31, u & 1, shm);
#endif
#ifndef NO_MIXB
    for (int u = bid; u < 256; u += nb) attn_unit(p, layer, true, u >> 1, 0, u & 1, shm);
#endif
#ifndef NO_MIXC
    for (int u = bid; u < 512; u += nb) sg_unit(p, layer, u >> 7, (u >> 2) & 31, u & 3, shm);
#endif
    const bf16_t* U = (const bf16_t*)(p.ws + W_U); const bf16_t* VG = (const bf16_t*)(p.ws + W_VG); bf16_t* MIX = (bf16_t*)(p.ws + W_MIX);
    for (int idx = bid * 512 + tid_opaque(); idx < 1024 * 128; idx += nb * 512) {
        const int r = idx >> 7, c4 = (idx & 127) * 4, b = r >> 3, t = r & 7, g = c4 >> 7;
        const float* wrow = p.in[16] + ((size_t)(layer * 4 + g) * 128 + t) * 128;
        f32x4 z = (f32x4){0.f, 0.f, 0.f, 0.f};
        const f32x4 wa = *(const f32x4*)(wrow), wb = *(const f32x4*)(wrow + 4);
        u32x2 vv[8];
#pragma unroll
        for (int s = 0; s < 8; ++s) vv[s] = *(const u32x2*)(VG + (size_t)(NPR + b * 8 + s) * 512 + c4);
#pragma unroll
        for (int s = 0; s < 8; ++s) { const float w0 = s < 4 ? wa[s & 3] : wb[s & 3]; const float w = (s <= t) ? w0 : 0.f;
            z[0] += w * __uint_as_float(vv[s].x << 16); z[1] += w * __uint_as_float(vv[s].x & 0xffff0000u); z[2] += w * __uint_as_float(vv[s].y << 16); z[3] += w * __uint_as_float(vv[s].y & 0xffff0000u); }
        const float bs = p.in[17][(layer * 4 + g) * 128 + t];
        const u32x2 uu = *(const u32x2*)(U + (size_t)(NPR + r) * 512 + c4);
        f32x4 o; o[0] = __uint_as_float(uu.x << 16) * (z[0] + bs); o[1] = __uint_as_float(uu.x & 0xffff0000u) * (z[1] + bs);
        o[2] = __uint_as_float(uu.y << 16) * (z[2] + bs); o[3] = __uint_as_float(uu.y & 0xffff0000u) * (z[3] + bs);
        *(u32x2*)(MIX + (size_t)(NPR + r) * 1024 + 512 + c4) = pack4(o);
    }
}

__device__ __forceinline__ void phase_fix(const Params& p, int layer) {
    const bf16_t* HALO = (const bf16_t*)(p.ws + W_HALO); bf16_t* ACT = (bf16_t*)(p.ws + W_R);
    const float* cw = p.in[21] + (size_t)layer * 3 * 5632; const float* cb = p.in[22] + (size_t)layer * 5632;
    const int gtid = blockIdx.x * 512 + tid_opaque(), gn = gridDim.x * 512;
    for (int idx = gtid; idx < 256 * 704; idx += gn) {
        const int blk = idx / 704, c = (idx % 704) * 4;
        const bf16_t* own = HALO + (size_t)blk * 4 * 5632; const bf16_t* prv = own - 4 * 5632;
        const bool first = (blk & 63) == 0;
        f32x4 a0, a1;
        f32x4 cg[2], cu[2];
#pragma unroll
        for (int h = 0; h < 2; ++h) {
            const int cc = c + h * 2816;
            const f32x4 w0 = *(const f32x4*)(cw + cc), w1 = *(const f32x4*)(cw + 5632 + cc), w2 = *(const f32x4*)(cw + 11264 + cc), bb = *(const f32x4*)(cb + cc);
            const f32x4 zero = (f32x4){0.f, 0.f, 0.f, 0.f};
            const f32x4 m2 = first ? zero : unpack4(*(const u32x2*)(prv + 2 * 5632 + cc)), m1 = first ? zero : unpack4(*(const u32x2*)(prv + 3 * 5632 + cc));
            const f32x4 o0 = unpack4(*(const u32x2*)(own + cc)), o1 = unpack4(*(const u32x2*)(own + 5632 + cc));
            const f32x4 r0 = bb + w0 * m2 + w1 * m1 + w2 * o0, r1 = bb + w0 * m1 + w1 * o0 + w2 * o1;
            if (h == 0) { cg[0] = r0; cg[1] = r1; } else { cu[0] = r0; cu[1] = r1; }
        }
#pragma unroll
        for (int e = 0; e < 4; ++e) { a0[e] = silu_f(cg[0][e]) * cu[0][e]; a1[e] = silu_f(cg[1][e]) * cu[1][e]; }
        *(u32x2*)(ACT + (size_t)(blk * 64) * 2816 + c) = pack4(a0);
        *(u32x2*)(ACT + (size_t)(blk * 64 + 1) * 2816 + c) = pack4(a1);
    }
}

#define XB_TMO      128
#define XB_XCNT(j)  (256  + 64 * (j))
#define XB_XSUB(j)  (1280 + 64 * (j))
#define XB_XGEN(j)  (2304 + 64 * (j))
#define XB_TOP      3328
#define XB_TOPGEN   3392
#define XCD_BAR_WORDS 3456
#define XB_SPIN_CAP (1u << 18)
__device__ __forceinline__ unsigned xb_ld(unsigned* p)              { return __hip_atomic_load(p, __ATOMIC_RELAXED, __HIP_MEMORY_SCOPE_AGENT); }
__device__ __forceinline__ unsigned xb_add(unsigned* p, unsigned v) { return __hip_atomic_fetch_add(p, v, __ATOMIC_RELAXED, __HIP_MEMORY_SCOPE_AGENT); }
__device__ __forceinline__ unsigned xb_xcc_id() { return (unsigned)__builtin_amdgcn_s_getreg((3 << 11) | 20) & 0xFu; }
#define XB_SPIN(cond, bar) do { unsigned _sp = 0; while (cond) { __builtin_amdgcn_s_sleep(1); \
    if ((++_sp & 255u) == 0u) { if (xb_ld(&(bar)[XB_TMO])) break; if (_sp > XB_SPIN_CAP) { atomicAdd(&(bar)[XB_TMO], 1u); break; } } } } while (0)
struct XcdBarrier { unsigned* bar; unsigned x; volatile LAS unsigned* st; };
__device__ __forceinline__ XcdBarrier xcd_barrier_post(unsigned* bar, volatile LAS unsigned* st) {
    XcdBarrier b; b.bar = bar; b.x = xb_xcc_id(); b.st = st;
    if (threadIdx.x == 0) (void)xb_add(&bar[XB_XCNT(b.x)], 1u);
    return b;
}
__device__ __forceinline__ void xcd_barrier_complete(unsigned* bar, unsigned x, unsigned& nloc, unsigned& nx) {
    const unsigned G = gridDim.x * gridDim.y * gridDim.z;
    unsigned sum, cnt, mine, sp = 0u;
    for (;;) {
        sum = 0u; cnt = 0u; mine = 0u;
#pragma unroll
        for (unsigned j = 0; j < 16; ++j) { const unsigned c = xb_ld(&bar[XB_XCNT(j)]); sum += c; cnt += (c > 0u) ? 1u : 0u; mine = (j == x) ? c : mine; }
        if (sum == G) break;
        __builtin_amdgcn_s_sleep(1);
        if ((++sp & 255u) == 0u) { if (xb_ld(&bar[XB_TMO])) break; if (sp > XB_SPIN_CAP) { atomicAdd(&bar[XB_TMO], 1u); break; } }
    }
    nloc = mine > 0u ? mine : 1u; nx = cnt > 0u ? cnt : 1u;
}
__device__ __forceinline__ void xcd_barrier(const XcdBarrier& b) {
    asm volatile("s_waitcnt vmcnt(0)" ::: "memory");
    __syncthreads();
    if (threadIdx.x == 0) {
        unsigned* bar = b.bar;
        __builtin_amdgcn_s_waitcnt(0);
        unsigned nloc = b.st[0], nx = b.st[1];
        if (nloc == 0u) { xcd_barrier_complete(bar, b.x, nloc, nx); b.st[0] = nloc; b.st[1] = nx; }
        const unsigned old = xb_add(&bar[XB_XSUB(b.x)], 1u);
        const unsigned gen = old / nloc;
        if (old + 1u == (gen + 1u) * nloc) {
            __builtin_amdgcn_fence(__ATOMIC_RELEASE, "agent");
            asm volatile("s_waitcnt vmcnt(0)" ::: "memory");
            const unsigned og = xb_add(&bar[XB_TOP], 1u);
            const unsigned tg = og / nx;
            if (og + 1u == (tg + 1u) * nx) xb_add(&bar[XB_TOPGEN], 1u);
            else XB_SPIN(xb_ld(&bar[XB_TOPGEN]) == tg, bar);
            __builtin_amdgcn_fence(__ATOMIC_ACQUIRE, "agent");
            xb_add(&bar[XB_XGEN(b.x)], 1u);
            asm volatile("s_waitcnt vmcnt(0)" ::: "memory");
        } else {
            XB_SPIN(xb_ld(&bar[XB_XGEN(b.x)]) == gen, bar);
            __builtin_amdgcn_fence(__ATOMIC_ACQUIRE, "agent");
            asm volatile("s_waitcnt vmcnt(0)" ::: "memory");
        }
    }
    __syncthreads();
}

__device__ __forceinline__ void run_phase(const Params& p, int ph, unsigned char* shm) {
    LAS unsigned char* lds = (LAS unsigned char*)shm;
    float* MOD = (float*)(p.ws + W_MOD);
    const int nb = gridDim.x, bid = blockIdx.x;
    if (ph == 0) { phase_prep(p, shm); return; }
    if (ph == 1) {
        const int ng = nb > 96 ? 48 : 0;
        if (ng == 0 || bid < ng) {
            pg8::StaticOrder S; S.init(256, 12288, 1024, ng ? ng : nb, bid, false);
            pg8::Gemm g{(const bf16_t*)(p.ws + W_CS), (const bf16_t*)(p.ws + W_ADA), 256, 12288, 1024};
            EpiMod E{MOD, p.in[8]};
            pg8::gemm_phase(lds, g, S, E);
        }
        if (ng == 0 || bid >= ng) {
            const int nc = ng ? nb - ng : nb, c0 = ng ? bid - ng : bid;
            conv_run<false>(p, c0, nc, 1408, (float*)shm);
        }
        return;
    }
    const int layer = (ph - 2) >> 3, sub = (ph - 2) & 7;
    const float* modl = MOD + layer * 6144;
    bf16_t* XB = (bf16_t*)(p.ws + W_XB);
    unsigned* tick = (unsigned*)(p.ws + W_BAR + 16384);
    pg8::StaticOrder S;
    switch (sub) {
    case 0: if (layer == 0) phase_norm<false>(p.in[0], p.in[1], nullptr, p.in[9], modl + 0, modl + 1024, (bf16_t*)(p.ws + W_H));
            else phase_norm<true>(nullptr, nullptr, XB, p.in[9] + layer * 1024, modl + 0, modl + 1024, (bf16_t*)(p.ws + W_H));
            break;
    case 1: { S.init(MT, 1792, 1024, nb, bid, false); S.reverse = 1;
        pg8::Gemm g{(const bf16_t*)(p.ws + W_H), (const bf16_t*)(p.ws + W_IN) + (size_t)layer * 1792 * 1024, MT, 1792, 1024};
        EpiIn E{layer, p.in[11] + layer * 64, p.in[12] + layer * 64, p.in[14] + layer * 512, p.in[15] + layer * 512, (const float*)(p.ws + W_ROPE),
                (bf16_t*)(p.ws + W_Q), (bf16_t*)(p.ws + W_KB), (bf16_t*)(p.ws + W_VB), (bf16_t*)(p.ws + W_U), (bf16_t*)(p.ws + W_VG), p.out};
        pg8::gemm_phase(lds, g, S, E); } break;
    case 2: phase_mix(p, layer, shm); break;
    case 3: { S.init(MT, 1024, 1024, nb, bid, true);
        pg8::Gemm g{(const bf16_t*)(p.ws + W_MIX), (const bf16_t*)(p.ws + W_OUT) + (size_t)layer * 1024 * 1024, MT, 1024, 1024};
        if (layer == 0) { EpiRes<false, true> E{p.in[0], p.in[1], nullptr, nullptr, XB, modl + 2048, p.ws, tick + (layer * 2 + 0) * 128}; pg8::gemm_phase(lds, g, S, E); }
        else { EpiRes<true, true> E{nullptr, nullptr, XB, nullptr, XB, modl + 2048, p.ws, tick + (layer * 2 + 0) * 128}; pg8::gemm_phase(lds, g, S, E); }
        } break;
    case 4: phase_norm<true>(nullptr, nullptr, XB, p.in[19] + layer * 1024, modl + 3072, modl + 4096, (bf16_t*)(p.ws + W_H)); break;
    case 5: { S.init(MT, 5632, 1024, nb, bid, false); S.reverse = 1;
        pg8::Gemm g{(const bf16_t*)(p.ws + W_H), (const bf16_t*)(p.ws + W_FIN) + (size_t)layer * 5632 * 1024, MT, 5632, 1024};
        EpiFfnIn E{p.in[21] + (size_t)layer * 3 * 5632, p.in[22] + (size_t)layer * 5632, p.in[4] + (size_t)layer * 128 * 2 * 5632,
                   (bf16_t*)(p.ws + W_R), (bf16_t*)(p.ws + W_HALO), p.out + O_NCS + (size_t)layer * 128 * 2 * 5632, p.out + O_NCP + (size_t)layer * 4 * 2 * 5632};
        pg8::gemm_phase(lds, g, S, E); } break;
    case 6: phase_fix(p, layer); break;
    case 7: { S.init(MT, 1024, 2816, nb, bid, true);
        pg8::Gemm g{(const bf16_t*)(p.ws + W_R), (const bf16_t*)(p.ws + W_FOUT) + (size_t)layer * 1024 * 2816, MT, 1024, 2816};
        if (layer == 0) { EpiRes<true, true> E{nullptr, nullptr, XB, nullptr, XB, modl + 5120, p.ws, tick + (layer * 2 + 1) * 128}; pg8::gemm_phase(lds, g, S, E); }
        else { EpiRes<true, false> E{nullptr, nullptr, XB, p.out, nullptr, modl + 5120, p.ws, tick + (layer * 2 + 1) * 128}; pg8::gemm_phase(lds, g, S, E); }
        } break;
    }
}

__global__ __launch_bounds__(512, 2) void mega_fwd(Params p) {
    extern __shared__ __attribute__((aligned(16))) unsigned char shm[];
    cg::grid_group grid = cg::this_grid();
    const int lo = p.ph_lo, hi = p.ph_hi;
    if (lo < 0) grid.sync();
    volatile LAS unsigned* st = (volatile LAS unsigned*)((LAS unsigned char*)shm + LDS_MISC);
    if (threadIdx.x < 4) st[threadIdx.x] = 0u;
    __syncthreads();
    XcdBarrier xb; xb.bar = (unsigned*)(p.ws + W_BAR); xb.x = 0; xb.st = st;
    if (hi - lo > 1) xb = xcd_barrier_post((unsigned*)(p.ws + W_BAR), st);
#ifndef PROBE_DUP
#define PROBE_DUP -1
#endif
#define PHASE(k) do { if (lo <= (k) && (k) < hi) run_phase(p, (k), shm); if (lo <= (k) && (k) + 1 < hi) xcd_barrier(xb); \
        if ((k) == PROBE_DUP) { run_phase(p, (k), shm); xcd_barrier(xb); } } while (0)
    PHASE(0); PHASE(1); PHASE(2); PHASE(3); PHASE(4); PHASE(5); PHASE(6); PHASE(7); PHASE(8); PHASE(9);
    PHASE(10); PHASE(11); PHASE(12); PHASE(13); PHASE(14); PHASE(15); PHASE(16); PHASE(17);
#undef PHASE
}

extern "C" void kernel_launch(void* const* d_in, const int* in_sizes, int n_in, void* d_out, int out_size, void* d_ws, size_t ws_size, hipStream_t stream) {
    static int grid = 0;
    if (grid == 0) {
        if (n_in != 24 || ws_size < W_END) { fprintf(stderr, "kernel_launch: unexpected n_in %d / ws %zu (need %zu)\n", n_in, ws_size, (size_t)W_END); grid = -1; return; }
        int dev = 0, cus = 0, per_cu = 0;
        hipGetDevice(&dev); hipDeviceGetAttribute(&cus, hipDeviceAttributeMultiprocessorCount, dev);
        if (hipFuncSetAttribute((const void*)mega_fwd, hipFuncAttributeMaxDynamicSharedMemorySize, LDS_BYTES) != hipSuccess) { fprintf(stderr, "kernel_launch: hipFuncSetAttribute failed\n"); grid = -1; return; }
        if (hipOccupancyMaxActiveBlocksPerMultiprocessor(&per_cu, (const void*)mega_fwd, 512, LDS_BYTES) != hipSuccess || per_cu < 1) { fprintf(stderr, "kernel_launch: occupancy query says %d\n", per_cu); per_cu = 1; }
        (void)hipGetLastError();
        grid = cus * 1;
        if (grid > 256) grid = 256;
    }
    if (grid < 0) return;
    Params p{};
    for (int i = 0; i < 24; ++i) p.in[i] = (const float*)d_in[i];
    p.out = (float*)d_out; p.ws = (unsigned char*)d_ws;
    for (int a = 0; a < 8; ++a) p.inv[a] = std::pow(500000.0, -(double)a / 8.0);
#if ONE_LAUNCH
    (void)hipMemsetAsync((char*)d_ws + W_BAR, 0, 32768, stream);
    p.ph_lo = 0; p.ph_hi = NPH;
    void* args[] = {&p};
    hipError_t e = hipLaunchCooperativeKernel((const void*)mega_fwd, dim3(grid), dim3(512), args, LDS_BYTES, stream);
    if (e != hipSuccess) fprintf(stderr, "cooperative launch failed: %s (grid %d)\n", hipGetErrorString(e), grid);
#else
    for (int ph = 0; ph < NPH; ++ph) {
        p.ph_lo = ph; p.ph_hi = ph + 1;
        hipLaunchKernelGGL(mega_fwd, dim3(grid), dim3(512), LDS_BYTES, stream, p);
    }
#endif
}
#ifdef TESTK
__global__ __launch_bounds__(512, 2) void tk(const bf16_t* A, const bf16_t* B, float* MOD, const float* bias) {
    extern __shared__ __attribute__((aligned(16))) unsigned char shm2[];
    pg8::StaticOrder S; S.init(256, 12288, 1024, gridDim.x, blockIdx.x, true);
    pg8::Gemm g{A, B, 256, 12288, 1024}; EpiMod E{MOD, bias};
    pg8::gemm_phase((LAS unsigned char*)shm2, g, S, E);
}
#endif
```

```cpp
#include <hip/hip_runtime.h>
#include <hip/hip_cooperative_groups.h>
#include <cstdio>
#include <cmath>
namespace cg = cooperative_groups;

#define LAS __attribute__((address_space(3)))
typedef unsigned short bf16_t;
typedef short bf16x8 __attribute__((ext_vector_type(8)));
typedef float f32x4 __attribute__((ext_vector_type(4)));
typedef float f32x2 __attribute__((ext_vector_type(2)));
typedef unsigned u32x4 __attribute__((ext_vector_type(4)));
typedef unsigned u32x2 __attribute__((ext_vector_type(2)));

#ifndef ONE_LAUNCH
#define ONE_LAUNCH 1
#endif

constexpr int NPR = 16384, NSM = 1024, MT = 17408;
constexpr int NPH = 18;
constexpr size_t O_Y = 0;
constexpr size_t O_NKP = 17825792, O_NVP = 17956864, O_NCP = 18087936, O_NKS = 18178048, O_NVS = 18440192, O_NGS = 18702336, O_NCS = 19750912;
constexpr size_t W_ADA = 0;
constexpr size_t W_IN = W_ADA + 12288ull * 1024 * 2;
constexpr size_t W_OUT = W_IN + 2ull * 1792 * 1024 * 2;
constexpr size_t W_FIN = W_OUT + 2ull * 1024 * 1024 * 2;
constexpr size_t W_FOUT = W_FIN + 2ull * 5632 * 1024 * 2;
constexpr size_t W_CS = W_FOUT + 2ull * 1024 * 2816 * 2;
constexpr size_t W_MOD = W_CS + 256ull * 1024 * 2;
constexpr size_t W_ROPE = W_MOD + 132ull * 12288 * 4;
constexpr size_t W_WS = W_ROPE + 4104ull * 16 * 4;
constexpr size_t W_H = W_WS + 2ull * 4 * 128 * 128 * 2;
constexpr size_t W_R = W_H + (size_t)MT * 1024 * 2;
constexpr size_t W_Q = W_R;
constexpr size_t W_KB = W_Q + (size_t)MT * 512 * 2;
constexpr size_t W_VB = W_KB + (size_t)MT * 128 * 2;
constexpr size_t W_U = W_VB + (size_t)MT * 128 * 2;
constexpr size_t W_VG = W_U + (size_t)MT * 512 * 2;
constexpr size_t W_MIX = W_VG + (size_t)MT * 512 * 2;
constexpr size_t W_HALO = W_R + (size_t)MT * 2816 * 2;
constexpr size_t W_XB = W_HALO + 256ull * 4 * 5632 * 2;
constexpr size_t W_BAR = W_XB + (size_t)MT * 1024 * 2;
constexpr size_t W_END = W_BAR + 32768;

constexpr int LDS_STAGE = 131072, LDS_MISC = LDS_STAGE + 8192, LDS_BYTES = LDS_MISC + 16;

struct Params {
    const float* in[24];
    float* out;
    unsigned char* ws;
    double inv[8];
    int ph_lo, ph_hi;
};

__device__ __forceinline__ unsigned cvt_pk_bf16(float lo, float hi) { unsigned r; asm volatile("v_cvt_pk_bf16_f32 %0, %1, %2" : "=v"(r) : "v"(lo), "v"(hi)); return r; }
__device__ __forceinline__ unsigned cvt_pk_bf16_mfma(float lo, float hi) { unsigned r; asm volatile("s_nop 7\n\ts_nop 7\n\tv_cvt_pk_bf16_f32 %0, %1, %2" : "=v"(r) : "v"(lo), "v"(hi)); return r; }
__device__ __forceinline__ float bf2f(bf16_t b) { return __uint_as_float(((unsigned)b) << 16); }
__device__ __forceinline__ float fast_exp(float x) { return __builtin_amdgcn_exp2f(x * 1.4426950408889634f); }
__device__ __forceinline__ float silu_f(float x) { return x * __builtin_amdgcn_rcpf(1.0f + fast_exp(-x)); }
__device__ __forceinline__ float gelu_f(float x) { const float a = x * __builtin_fmaf(x * x, -0.10294324f, -2.3022082f); return x * __builtin_amdgcn_rcpf(1.0f + __builtin_amdgcn_exp2f(a)); }
template <int CTRL> __device__ __forceinline__ float dppf(float x) { return __builtin_bit_cast(float, __builtin_amdgcn_update_dpp(0, __builtin_bit_cast(int, x), CTRL, 0xf, 0xf, false)); }
template <int N> __device__ __forceinline__ f32x4 ror4(f32x4 v) { f32x4 r; r[0] = dppf<0x120 + N>(v[0]); r[1] = dppf<0x120 + N>(v[1]); r[2] = dppf<0x120 + N>(v[2]); r[3] = dppf<0x120 + N>(v[3]); return r; }
__device__ __forceinline__ float xsum_fq(float v) { v += __shfl_xor(v, 16); v += __shfl_xor(v, 32); return v; }
__device__ __forceinline__ float xmax_fq(float v) { v = fmaxf(v, __shfl_xor(v, 16)); v = fmaxf(v, __shfl_xor(v, 32)); return v; }
__device__ __forceinline__ u32x2 pack4(f32x4 v) { u32x2 w; w.x = cvt_pk_bf16(v[0], v[1]); w.y = cvt_pk_bf16(v[2], v[3]); return w; }
__device__ __forceinline__ u32x2 pack4_mfma(f32x4 v) { u32x2 w; w.x = cvt_pk_bf16_mfma(v[0], v[1]); w.y = cvt_pk_bf16(v[2], v[3]); return w; }
__device__ __forceinline__ u32x4 pack8(f32x4 a, f32x4 b) { u32x4 w; w.x = cvt_pk_bf16(a[0], a[1]); w.y = cvt_pk_bf16(a[2], a[3]); w.z = cvt_pk_bf16(b[0], b[1]); w.w = cvt_pk_bf16(b[2], b[3]); return w; }

__device__ __forceinline__ int tid_opaque() { int t = threadIdx.x; asm volatile("" : "+v"(t)); return t; }

namespace pg8 {
constexpr int BM = 256, BK = 64, HALF = 128, HTB = HALF * BK * 2, NXCD = 8, WGM = 8;
__device__ __forceinline__ int lds_byte(int r, int c) { const int st = (r >> 4) * 2 + (c >> 5), rr = r & 15, cc = c & 31, ob = rr * 64 + cc * 2; return st * 1024 + (ob ^ (((ob >> 9) & 1) << 5)); }
__device__ __forceinline__ void stage_rc(int b, int& R, int& C) { const int st = b / 1024, sb = b % 1024, swz = sb ^ (((sb >> 9) & 1) << 5); R = (st >> 1) * 16 + swz / 64; C = (st & 1) * 32 + (swz % 64) / 2; }
__device__ __forceinline__ int perm32(int rho) { const int n = rho >> 4, i = rho & 15; return 8 * (i >> 2) + 4 * n + (i & 3); }
struct Unit { int pm, pn, k0, nk, split, tl, S; };
struct Gemm { const bf16_t* A; const bf16_t* Bt; int M, N, K; };
struct StaticOrder {
    int nM, nN, nwg, G, c, R, Lf, S, nt, heavy_first, reverse;
    __device__ __forceinline__ void init(int M, int N, int K, int G_, int c_, bool allow_split) {
        nM = M / BM; nN = N / BM; nwg = nM * nN; G = G_; c = c_; nt = K / BK; heavy_first = 0; reverse = 0;
        R = nwg / G; Lf = nwg - R * G; S = 1;
        if (allow_split && Lf > 0 && Lf * 2 <= G) { int smax = G / Lf; int s = nt / 4; while (s > 1 && (s > smax || nt % (2 * s) != 0)) --s; S = s; }
    }
    __device__ __forceinline__ void tile_pmpn(int L, Unit& u) const {
        int wgid = L; if (reverse) { const int xq = L % NXCD, xo = L / NXCD; const int cnt = nwg / NXCD + (xq < nwg % NXCD ? 1 : 0); wgid = xq + (cnt - 1 - xo) * NXCD; }
        { const int q = nwg / NXCD, r = nwg % NXCD, xcd = wgid % NXCD, off = wgid / NXCD; wgid = (xcd < r ? xcd * (q + 1) : r * (q + 1) + (xcd - r) * q) + off; }
        const int nig = WGM * nN, gid = wgid / nig, fm = gid * WGM, gsz = (nM - fm) < WGM ? (nM - fm) : WGM;
        u.pm = fm + ((wgid % nig) % gsz); u.pn = (wgid % nig) / gsz;
        if (heavy_first) { const int q = u.pn; u.pn = q < 2 ? 5 + q : (q < 4 ? 1 + q : q - 4); }
    }
    __device__ __forceinline__ bool next(int i, Unit& u) const {
        int L = 0, k0 = 0, nk = nt, split = 0, tl = 0; bool ok = false;
        if (i < R) { L = i * G + c; ok = true; }
        else if (i == R && S == 1) { L = R * G + c; ok = c < Lf; }
        else if (i == R) { tl = c % Lf; L = R * G + tl; nk = nt / S; k0 = (c / Lf) * nk; split = 1; ok = c < Lf * S; }
        if (!ok) L = 0;
        Unit t; tile_pmpn(L, t);
        u.pm = t.pm; u.pn = t.pn; u.k0 = k0; u.nk = nk; u.split = split; u.tl = tl; u.S = S;
        return ok;
    }
};

template <class Epi>
__device__ __forceinline__ void gemm_phase(LAS unsigned char* lds, const Gemm g, const StaticOrder& S, const Epi& E) {
    const int tid = tid_opaque(), wid = __builtin_amdgcn_readfirstlane(tid >> 6), lane = tid & 63, wr = wid >> 2, wc = wid & 3, fr = lane & 15, fq = lane >> 4;
    const int K = g.K;
    unsigned voffA[2], voffB[2];
#pragma unroll
    for (int i = 0; i < 2; ++i) { int R, C; stage_rc(tid * 16 + i * 8192, R, C); const int Rb = Epi::PERM ? ((R & ~31) + perm32(R & 31)) : R;
        const int Ra = Epi::APERM ? ((R & 64) | ((R & 15) << 2) | ((R >> 4) & 3)) : R;
        voffA[i] = (unsigned)(Ra * K + C) * 2u; voffB[i] = (unsigned)(Rb * K + C) * 2u; }
    const size_t kstep = (size_t)(BK * 2);
    const size_t hstep = (size_t)HALF * K * 2;
    const size_t tstep = 2 * hstep;
    const unsigned ldsw = (unsigned)wid * 1024u;
    const int aoff = lds_byte(wr * 64 + fr, fq * 8), boff = lds_byte(wc * 32 + fr, fq * 8);
#define PG8_SA(b, h) (((b) * 2 + (h)) * HTB)
#define PG8_SB(b, h) ((4 + (b) * 2 + (h)) * HTB)
#define PG8_STAGE(bufoff, gbase, voff) do { _Pragma("unroll") for (int _i = 0; _i < 2; ++_i) \
        __builtin_amdgcn_global_load_lds((const unsigned*)((const char*)(gbase) + (voff)[_i]), (LAS unsigned*)(lds + (bufoff) + ldsw + _i * 8192), 16, 0, 0); } while (0)
#define PG8_LDA(dst, b, h) do { _Pragma("unroll") for (int m = 0; m < 4; ++m) _Pragma("unroll") for (int k = 0; k < 2; ++k) dst[m][k] = *(const LAS bf16x8*)(lds + PG8_SA(b, h) + aoff + m * 2048 + k * 1024); } while (0)
#define PG8_LDB(dst, b, h) do { _Pragma("unroll") for (int n = 0; n < 2; ++n) _Pragma("unroll") for (int k = 0; k < 2; ++k) dst[n][k] = *(const LAS bf16x8*)(lds + PG8_SB(b, h) + boff + n * 2048 + k * 1024); } while (0)
#define PG8_MMA(ai, bj, At, Bt) do { __builtin_amdgcn_s_setprio(1); _Pragma("unroll") for (int m = 0; m < 4; ++m) _Pragma("unroll") for (int n = 0; n < 2; ++n) _Pragma("unroll") for (int k = 0; k < 2; ++k) \
        acc[ai][bj][m][n] = __builtin_amdgcn_mfma_f32_16x16x32_bf16(Bt[n][k], At[m][k], acc[ai][bj][m][n], 0, 0, 0); __builtin_amdgcn_s_setprio(0); } while (0)
#define PG8_WAIT_V(n) asm volatile("s_waitcnt vmcnt(" #n ")" ::: "memory")
#define PG8_WAIT_L(n) asm volatile("s_waitcnt lgkmcnt(" #n ")" ::: "memory")
#define PG8_BAR __builtin_amdgcn_s_barrier()
#define PG8_SCHED __builtin_amdgcn_sched_barrier(0)
    Unit cur, nxt; int ui = 0;
    if (!S.next(0, cur)) return;
    f32x4 acc[2][2][4][2];
#pragma unroll
    for (int a = 0; a < 2; ++a)
#pragma unroll
        for (int b = 0; b < 2; ++b)
#pragma unroll
            for (int m = 0; m < 4; ++m)
#pragma unroll
                for (int n = 0; n < 2; ++n) acc[a][b][m][n] = (f32x4){0.f, 0.f, 0.f, 0.f};
    bf16x8 At[4][2], B0[2][2], B1[2][2];
    const char* cA = (const char*)g.A + (size_t)cur.pm * tstep + (size_t)cur.k0 * kstep; const char* cB = (const char*)g.Bt + (size_t)cur.pn * tstep + (size_t)cur.k0 * kstep;
    PG8_STAGE(PG8_SB(0, 0), cB, voffB); PG8_STAGE(PG8_SB(0, 1), cB + hstep, voffB); PG8_STAGE(PG8_SA(0, 0), cA, voffA); PG8_STAGE(PG8_SA(0, 1), cA + hstep, voffA);
    if (wr == 1) PG8_BAR;
    PG8_WAIT_V(2); PG8_BAR;
    PG8_STAGE(PG8_SB(1, 0), cB + kstep, voffB); PG8_STAGE(PG8_SA(1, 0), cA + kstep, voffA); PG8_STAGE(PG8_SB(1, 1), cB + hstep + kstep, voffB);
    PG8_WAIT_V(6); PG8_BAR;
    for (;;) {
        const bool has_next = S.next(ui + 1, nxt);
        const char* nA = has_next ? (const char*)g.A + (size_t)nxt.pm * tstep + (size_t)nxt.k0 * kstep : cA; const char* nB = has_next ? (const char*)g.Bt + (size_t)nxt.pn * tstep + (size_t)nxt.k0 * kstep : cB;
        const int nt = cur.nk;
        for (int t = 0; t < nt; t += 2) {
            const bool last = (t == nt - 2);
            const char* a1 = cA + (size_t)(t + 1) * kstep;
            const char* a2 = last ? nA : cA + (size_t)(t + 2) * kstep; const char* b2 = last ? nB : cB + (size_t)(t + 2) * kstep;
            const char* a3 = a2 + kstep; const char* b3 = b2 + kstep;
            PG8_LDB(B0, 0, 0); PG8_LDB(B1, 0, 1); PG8_SCHED; PG8_LDA(At, 0, 0); PG8_STAGE(PG8_SA(1, 1), a1 + hstep, voffA);
            PG8_WAIT_V(8); PG8_WAIT_L(0); PG8_BAR; PG8_MMA(0, 0, At, B0); PG8_MMA(0, 1, At, B1); PG8_BAR; PG8_SCHED;
            PG8_LDA(At, 0, 1); PG8_STAGE(PG8_SB(0, 0), b2, voffB); PG8_STAGE(PG8_SB(0, 1), b2 + hstep, voffB); PG8_STAGE(PG8_SA(0, 0), a2, voffA);
            PG8_WAIT_V(8); PG8_WAIT_L(0); PG8_BAR; PG8_MMA(1, 0, At, B0); PG8_MMA(1, 1, At, B1); PG8_BAR; PG8_SCHED;
            PG8_LDB(B0, 1, 0); PG8_LDB(B1, 1, 1); PG8_SCHED; PG8_LDA(At, 1, 0); PG8_STAGE(PG8_SA(0, 1), a2 + hstep, voffA);
            PG8_WAIT_V(8); PG8_WAIT_L(0); PG8_BAR; PG8_MMA(0, 0, At, B0); PG8_MMA(0, 1, At, B1); PG8_BAR; PG8_SCHED;
            PG8_LDA(At, 1, 1); PG8_STAGE(PG8_SB(1, 0), b3, voffB); PG8_STAGE(PG8_SB(1, 1), b3 + hstep, voffB); PG8_STAGE(PG8_SA(1, 0), a3, voffA);
            PG8_WAIT_V(8); PG8_WAIT_L(0); PG8_BAR; PG8_MMA(1, 0, At, B0); PG8_MMA(1, 1, At, B1); PG8_BAR; PG8_SCHED;
        }
        if (wr == 0) PG8_BAR;
        if (!(Epi::CAN_SPLIT && cur.split)) E(acc, cur, wr, wc, fr, fq, lds + LDS_STAGE, wid);
        if (!has_next) break;
#pragma unroll
        for (int a = 0; a < 2; ++a)
#pragma unroll
            for (int b = 0; b < 2; ++b)
#pragma unroll
                for (int m = 0; m < 4; ++m)
#pragma unroll
                    for (int n = 0; n < 2; ++n) acc[a][b][m][n] = (f32x4){0.f, 0.f, 0.f, 0.f};
        cur = nxt; cA = nA; cB = nB; ++ui;
        if (wr == 1) PG8_BAR;
    }
    PG8_WAIT_V(0);
    PG8_BAR;
    if (Epi::CAN_SPLIT && cur.split) E(acc, cur, wr, wc, fr, fq, lds + LDS_STAGE, wid);
#undef PG8_SA
#undef PG8_SB
#undef PG8_STAGE
#undef PG8_LDA
#undef PG8_LDB
#undef PG8_MMA
#undef PG8_WAIT_V
#undef PG8_WAIT_L
#undef PG8_BAR
#undef PG8_SCHED
}
}
using pg8::Unit;

struct EpiMod {
    static constexpr bool PERM = false, CAN_SPLIT = false, APERM = false;
    float* MOD; const float* bias;
    __device__ __forceinline__ void operator()(const f32x4 (&acc)[2][2][4][2], const Unit& u, int wr, int wc, int fr, int fq, LAS unsigned char*, int) const {
        const int col0 = u.pn * 256 + wc * 32 + 4 * fq;
#pragma unroll
        for (int ai = 0; ai < 2; ++ai)
#pragma unroll
            for (int m = 0; m < 4; ++m) {
                const int r = ai * 128 + wr * 64 + m * 16 + fr;
                if (r < 132) {
#pragma unroll
                    for (int bj = 0; bj < 2; ++bj)
#pragma unroll
                        for (int n = 0; n < 2; ++n) { const int c = col0 + bj * 128 + n * 16; *(f32x4*)(MOD + (size_t)r * 12288 + c) = acc[ai][bj][m][n] + *(const f32x4*)(bias + c); }
                }
            }
    }
};

__device__ __forceinline__ f32x4 unpack4(u32x2 w) { f32x4 v; v[0] = __uint_as_float(w.x << 16); v[1] = __uint_as_float(w.x & 0xffff0000u); v[2] = __uint_as_float(w.y << 16); v[3] = __uint_as_float(w.y & 0xffff0000u); return v; }
template <bool INB, bool OUTB>
struct EpiRes {
    static constexpr bool PERM = false, CAN_SPLIT = true, APERM = false;
    const float* xin_p; const float* xin_s; const bf16_t* xin_b; float* xo_f; bf16_t* xo_b; const float* gate;
    unsigned char* ws; unsigned* ticket;
    __device__ __forceinline__ float* slab(int idx) const { return (float*)(idx < 136 ? ws + W_H + (size_t)idx * 262144 : ws + W_ADA + (size_t)(idx - 136) * 262144); }
    __device__ __forceinline__ f32x4 ldx(int r, int c) const {
        if (INB) return unpack4(*(const u32x2*)(xin_b + (size_t)r * 1024 + c));
        return *(const f32x4*)((r < NPR ? xin_p + (size_t)r * 1024 : xin_s + (size_t)(r - NPR) * 1024) + c);
    }
    __device__ __forceinline__ void stx(int r, int c, f32x4 v) const {
        if (OUTB) *(u32x2*)(xo_b + (size_t)r * 1024 + c) = pack4(v); else *(f32x4*)(xo_f + (size_t)r * 1024 + c) = v;
    }
    __device__ __forceinline__ void operator()(const f32x4 (&acc)[2][2][4][2], const Unit& u, int wr, int wc, int fr, int fq, LAS unsigned char*, int wid) const {
        const bool prompt = u.pm < 64;
        const int col0 = u.pn * 256 + wc * 32 + 4 * fq;
        if (!u.split) {
            f32x4 gu[2][2];
            if (prompt) {
#pragma unroll
                for (int bj = 0; bj < 2; ++bj)
#pragma unroll
                    for (int n = 0; n < 2; ++n) gu[bj][n] = *(const f32x4*)(gate + (size_t)(u.pm >> 4) * 12288 + col0 + bj * 128 + n * 16);
            }
            if (INB && prompt) {
                u32x2 xr[2][4][2][2];
#pragma unroll
                for (int ai = 0; ai < 2; ++ai)
#pragma unroll
                    for (int m = 0; m < 4; ++m) { const int r = u.pm * 256 + ai * 128 + wr * 64 + m * 16 + fr;
#pragma unroll
                        for (int bj = 0; bj < 2; ++bj)
#pragma unroll
                            for (int n = 0; n < 2; ++n) xr[ai][m][bj][n] = *(const u32x2*)(xin_b + (size_t)r * 1024 + col0 + bj * 128 + n * 16); }
#pragma unroll
                for (int ai = 0; ai < 2; ++ai)
#pragma unroll
                    for (int m = 0; m < 4; ++m) { const int r = u.pm * 256 + ai * 128 + wr * 64 + m * 16 + fr;
#pragma unroll
                        for (int bj = 0; bj < 2; ++bj)
#pragma unroll
                            for (int n = 0; n < 2; ++n) stx(r, col0 + bj * 128 + n * 16, unpack4(xr[ai][m][bj][n]) + gu[bj][n] * acc[ai][bj][m][n]); }
            } else {
            constexpr int MB = 2;
#pragma unroll
            for (int ai = 0; ai < 2; ++ai)
#pragma unroll
                for (int mb = 0; mb < 4; mb += MB) {
                    u32x2 xr[MB][2][2]; f32x4 xf[INB ? 1 : MB][2][2];
#pragma unroll
                    for (int m = 0; m < MB; ++m) { const int r = u.pm * 256 + ai * 128 + wr * 64 + (mb + m) * 16 + fr;
#pragma unroll
                        for (int bj = 0; bj < 2; ++bj)
#pragma unroll
                            for (int n = 0; n < 2; ++n) { const int c = col0 + bj * 128 + n * 16;
                                if (INB) xr[m][bj][n] = *(const u32x2*)(xin_b + (size_t)r * 1024 + c);
                                else xf[INB ? 0 : m][bj][n] = *(const f32x4*)((r < NPR ? xin_p + (size_t)r * 1024 : xin_s + (size_t)(r - NPR) * 1024) + c); } }
                    f32x4 gs[MB][2][2];
                    if (!prompt) {
#pragma unroll
                        for (int m = 0; m < MB; ++m) { const int r = u.pm * 256 + ai * 128 + wr * 64 + (mb + m) * 16 + fr; const float* gp = gate + (size_t)(4 + ((r - NPR) >> 3)) * 12288;
#pragma unroll
                            for (int bj = 0; bj < 2; ++bj)
#pragma unroll
                                for (int n = 0; n < 2; ++n) gs[m][bj][n] = *(const f32x4*)(gp + col0 + bj * 128 + n * 16); }
                    }
#pragma unroll
                    for (int m = 0; m < MB; ++m) { const int r = u.pm * 256 + ai * 128 + wr * 64 + (mb + m) * 16 + fr;
#pragma unroll
                        for (int bj = 0; bj < 2; ++bj)
#pragma unroll
                            for (int n = 0; n < 2; ++n) { const f32x4 x0 = INB ? unpack4(xr[m][bj][n]) : xf[INB ? 0 : m][bj][n];
                                const f32x4 gg = prompt ? gu[bj][n] : gs[m][bj][n];
                                stx(r, col0 + bj * 128 + n * 16, x0 + gg * acc[ai][bj][mb + m][n]); } }
                }
            }
        } else {
            __amdgpu_buffer_rsrc_t srs = __builtin_amdgcn_make_buffer_rsrc((void*)slab(u.tl * u.S + u.k0 / u.nk), 0, 262144, 0x00020000);
            const unsigned soff = (unsigned)(wc * 32 + 4 * fq) * 4u;
#pragma unroll
            for (int ai = 0; ai < 2; ++ai)
#pragma unroll
                for (int m = 0; m < 4; ++m) {
                    const int rl = ai * 128 + wr * 64 + m * 16 + fr;
                    const int r = u.pm * 256 + rl;
                    const int mrow = prompt ? (r >> 12) : 4 + ((r - NPR) >> 3);
                    const float* gp = gate + (size_t)mrow * 12288;
#pragma unroll
                    for (int bj = 0; bj < 2; ++bj)
#pragma unroll
                        for (int n = 0; n < 2; ++n) { const int c = col0 + bj * 128 + n * 16;
                            const f32x4 d = *(const f32x4*)(gp + c) * acc[ai][bj][m][n];
                            __builtin_amdgcn_raw_buffer_store_b128(__builtin_bit_cast(u32x4, d), srs, soff + (unsigned)(rl * 256 + bj * 128 + n * 16) * 4u, 0, 16); }
                }
        }
        if (u.split) {
            const int lane = fq * 16 + fr;
            asm volatile("s_waitcnt vmcnt(0)" ::: "memory");
            __syncthreads();
            if (threadIdx.x == 0) {
                unsigned* tk = ticket + u.tl;
                const unsigned need = (unsigned)u.S;
                __hip_atomic_fetch_add(tk, 1u, __ATOMIC_RELAXED, __HIP_MEMORY_SCOPE_AGENT);
                unsigned sp = 0;
                while (__hip_atomic_load(tk, __ATOMIC_RELAXED, __HIP_MEMORY_SCOPE_AGENT) < need) { __builtin_amdgcn_s_sleep(2); if (++sp > (1u << 19)) break; }
                __builtin_amdgcn_fence(__ATOMIC_ACQUIRE, "agent");
                asm volatile("s_waitcnt vmcnt(0)" ::: "memory");
            }
            __syncthreads();
            const int w = (u.k0 / u.nk) * 8 + wid, nw = 8 * u.S;
            for (int vb = w * 64 + lane; vb < 16384; vb += 8 * nw * 64) {
                f32x4 tot[8];
#pragma unroll
                for (int k = 0; k < 8; ++k) {
                    const int v = vb + k * nw * 64;
                    if (v < 16384) {
                        const int r = u.pm * 256 + (v >> 6), c = u.pn * 256 + (v & 63) * 4;
                        f32x4 s0 = ldx(r, c), s1 = (f32x4){0.f, 0.f, 0.f, 0.f}, s2 = s1, s3 = s1;
                        int q = 0;
                        for (; q + 4 <= u.S; q += 4) {
                            const f32x4 a0 = *(const f32x4*)(slab(u.tl * u.S + q) + (size_t)v * 4), a1 = *(const f32x4*)(slab(u.tl * u.S + q + 1) + (size_t)v * 4);
                            const f32x4 a2 = *(const f32x4*)(slab(u.tl * u.S + q + 2) + (size_t)v * 4), a3 = *(const f32x4*)(slab(u.tl * u.S + q + 3) + (size_t)v * 4);
                            s0 += a0; s1 += a1; s2 += a2; s3 += a3; }
                        for (; q < u.S; ++q) s1 += *(const f32x4*)(slab(u.tl * u.S + q) + (size_t)v * 4);
                        tot[k] = (s0 + s1) + (s2 + s3);
                    }
                }
#pragma unroll
                for (int k = 0; k < 8; ++k) {
                    const int v = vb + k * nw * 64;
                    if (v < 16384) stx(u.pm * 256 + (v >> 6), u.pn * 256 + (v & 63) * 4, tot[k]);
                }
            }
        }
    }
};

struct EpiIn {
    static constexpr bool PERM = true, CAN_SPLIT = false, APERM = false;
    int layer;
    const float* gq; const float* gk; const float* lng; const float* lnb; const float* rope;
    bf16_t* Q; bf16_t* KB; bf16_t* VB; bf16_t* U; bf16_t* VG; float* out;
    __device__ __forceinline__ void operator()(const f32x4 (&acc)[2][2][4][2], const Unit& u, int wr, int wc, int fr, int fq, LAS unsigned char* ex, int wid) const {
        const int pn = u.pn;
        const bool prompt = u.pm < 64;
        const int rbase = u.pm * 256 + wr * 64 + fr;
        const int dq = 8 * fq;
        if (false) {}
#ifndef NOQK
        else if (pn < 2 || (pn == 2 && wc < 2)) {
            const bool isk = (pn == 2);
            const float* g = isk ? gk : gq;
            f32x4 gv[2][2];
#pragma unroll
            for (int bj = 0; bj < 2; ++bj)
#pragma unroll
                for (int n = 0; n < 2; ++n) gv[bj][n] = *(const f32x4*)(g + bj * 32 + dq + 4 * n);
#pragma unroll
            for (int ai = 0; ai < 2; ++ai)
#pragma unroll
              for (int mb = 0; mb < 4; mb += 4) {
                f32x4 rcs[4][2], rsn[4][2];
#pragma unroll
                for (int mm = 0; mm < 4; ++mm) { const int r = rbase + ai * 128 + (mb + mm) * 16; const float* rp = rope + (prompt ? (r & 4095) : 4096 + (r & 7)) * 16;
#pragma unroll
                    for (int n = 0; n < 2; ++n) { rcs[mm][n] = *(const f32x4*)(rp + 4 * n); rsn[mm][n] = *(const f32x4*)(rp + 8 + 4 * n); } }
#pragma unroll
                for (int mm = 0; mm < 4; ++mm) {
                    const int m = mb + mm;
                    const int r = rbase + ai * 128 + m * 16;
                    float ss = 0.f;
#pragma unroll
                    for (int bj = 0; bj < 2; ++bj)
#pragma unroll
                        for (int n = 0; n < 2; ++n) { const f32x4 v = acc[ai][bj][m][n]; ss += v[0] * v[0] + v[1] * v[1] + v[2] * v[2] + v[3] * v[3]; }
                    ss = xsum_fq(ss);
                    const float rs = rsqrtf(ss * (1.0f / 64.0f) + 1e-6f);
                    f32x4 y[2][2];
#pragma unroll
                    for (int bj = 0; bj < 2; ++bj)
#pragma unroll
                        for (int n = 0; n < 2; ++n) y[bj][n] = acc[ai][bj][m][n] * rs * gv[bj][n];
#pragma unroll
                    for (int n = 0; n < 2; ++n) {
                        const f32x4 cs = rcs[mm][n], sn = rsn[mm][n];
#pragma unroll
                        for (int e = 0; e < 4; ++e) {
                            const float own = y[0][n][e];
                            const float oth = __shfl_xor(own, 16);
                            const float rot = (fq == 0) ? own * cs[e] - oth * sn[e] : own * cs[e] + oth * sn[e];
                            y[0][n][e] = (fq < 2) ? rot : own;
                        }
                    }
                    if (!isk) {
                        bf16_t* qp = Q + (size_t)r * 512 + (pn * 4 + wc) * 64 + dq;
                        *(u32x4*)(qp) = pack8(y[0][0], y[0][1]); *(u32x4*)(qp + 32) = pack8(y[1][0], y[1][1]);
                    } else {
                        bf16_t* kp = KB + (size_t)r * 128 + wc * 64 + dq;
                        *(u32x4*)(kp) = pack8(y[0][0], y[0][1]); *(u32x4*)(kp + 32) = pack8(y[1][0], y[1][1]);
                        float* op = nullptr;
                        if (!prompt) op = out + O_NKS + ((size_t)layer * 1024 + (r - NPR)) * 128;
                        else if ((r & 4095) >= 3968) op = out + O_NKP + (((size_t)layer * 4 + (r >> 12)) * 128 + ((r & 4095) - 3968)) * 128;
                        if (op) { op += wc * 64 + dq;
                            *(f32x4*)(op) = y[0][0]; *(f32x4*)(op + 4) = y[0][1]; *(f32x4*)(op + 32) = y[1][0]; *(f32x4*)(op + 36) = y[1][1]; }
                    }
                }
            }
        }
#endif
#ifndef NOV
        else if (pn == 2) {
#pragma unroll
            for (int ai = 0; ai < 2; ++ai)
#pragma unroll
                for (int m = 0; m < 4; ++m) {
                    const int r = rbase + ai * 128 + m * 16;
                    bf16_t* vp = VB + (size_t)r * 128 + (wc - 2) * 64 + dq;
                    *(u32x4*)(vp) = pack8(acc[ai][0][m][0], acc[ai][0][m][1]); *(u32x4*)(vp + 32) = pack8(acc[ai][1][m][0], acc[ai][1][m][1]);
                    float* op = nullptr;
                    if (!prompt) op = out + O_NVS + ((size_t)layer * 1024 + (r - NPR)) * 128;
                    else if ((r & 4095) >= 3968) op = out + O_NVP + (((size_t)layer * 4 + (r >> 12)) * 128 + ((r & 4095) - 3968)) * 128;
                    if (op) { op += (wc - 2) * 64 + dq;
                        *(f32x4*)(op) = acc[ai][0][m][0]; *(f32x4*)(op + 4) = acc[ai][0][m][1]; *(f32x4*)(op + 32) = acc[ai][1][m][0]; *(f32x4*)(op + 36) = acc[ai][1][m][1]; }
                }
        }
#endif
#ifndef NOU
        else if (pn < 5) {
#pragma unroll
            for (int ai = 0; ai < 2; ++ai)
#pragma unroll
                for (int m = 0; m < 4; ++m) {
                    const int r = rbase + ai * 128 + m * 16;
                    f32x4 y[2][2];
#pragma unroll
                    for (int bj = 0; bj < 2; ++bj)
#pragma unroll
                        for (int n = 0; n < 2; ++n)
#pragma unroll
                            for (int e = 0; e < 4; ++e) y[bj][n][e] = gelu_f(acc[ai][bj][m][n][e]);
                    bf16_t* up = U + (size_t)r * 512 + (pn - 3) * 256 + wc * 64 + dq;
                    *(u32x4*)(up) = pack8(y[0][0], y[0][1]); *(u32x4*)(up + 32) = pack8(y[1][0], y[1][1]);
                }
        }
#endif
#ifndef NOLN
        else {
            LAS f32x2* exo = (LAS f32x2*)ex + wid * 128 + fr;
            LAS f32x2* exp_ = (LAS f32x2*)ex + (wid ^ 1) * 128 + fr;
#pragma unroll
            for (int ai = 0; ai < 2; ++ai)
#pragma unroll
                for (int m = 0; m < 4; ++m) {
                    float a = 0.f, b = 0.f;
#pragma unroll
                    for (int bj = 0; bj < 2; ++bj)
#pragma unroll
                        for (int n = 0; n < 2; ++n)
#pragma unroll
                            for (int e = 0; e < 4; ++e) { const float gl = gelu_f(acc[ai][bj][m][n][e]); a += gl; b += gl * gl; }
                    a = xsum_fq(a); b = xsum_fq(b);
                    if (fq == 0) exo[(ai * 4 + m) * 16] = (f32x2){a, b};
                }
            asm volatile("s_waitcnt lgkmcnt(0)" ::: "memory");
            __builtin_amdgcn_s_barrier();
            asm volatile("" ::: "memory");
            const int grp = (pn - 5) * 2 + (wc >> 1);
            const int w0 = (wc & 1) * 64 + dq;
            f32x4 lgv[2][2], lbv[2][2];
#pragma unroll
            for (int bj = 0; bj < 2; ++bj)
#pragma unroll
                for (int n = 0; n < 2; ++n) { lgv[bj][n] = *(const f32x4*)(lng + grp * 128 + w0 + bj * 32 + 4 * n); lbv[bj][n] = *(const f32x4*)(lnb + grp * 128 + w0 + bj * 32 + 4 * n); }
#pragma unroll
            for (int ai = 0; ai < 2; ++ai)
#pragma unroll
                for (int m = 0; m < 4; ++m) {
                    const int r = rbase + ai * 128 + m * 16;
                    const f32x2 o0 = exo[(ai * 4 + m) * 16];
                    const f32x2 o1 = exp_[(ai * 4 + m) * 16];
                    const float mean = (o0.x + o1.x) * (1.0f / 128.0f);
                    const float var = fmaxf((o0.y + o1.y) * (1.0f / 128.0f) - mean * mean, 0.f);
                    const float rstd = rsqrtf(var + 1e-6f);
                    bf16_t* vp = VG + (size_t)r * 512 + grp * 128 + w0;
                    float* op = out + O_NGS + ((size_t)layer * 1024 + (r - NPR)) * 512 + grp * 128 + w0;
#pragma unroll
                    for (int bj = 0; bj < 2; ++bj) {
                        f32x4 g0, g1;
#pragma unroll
                        for (int e = 0; e < 4; ++e) { float x0 = acc[ai][bj][m][0][e], x1 = acc[ai][bj][m][1][e]; asm volatile("" : "+v"(x0), "+v"(x1)); g0[e] = gelu_f(x0); g1[e] = gelu_f(x1); }
                        const f32x4 y0 = (g0 - mean) * rstd * lgv[bj][0] + lbv[bj][0];
                        const f32x4 y1 = (g1 - mean) * rstd * lgv[bj][1] + lbv[bj][1];
                        *(u32x4*)(vp + bj * 32) = pack8(y0, y1);
                        if (!prompt) { *(f32x4*)(op + bj * 32) = y0; *(f32x4*)(op + bj * 32 + 4) = y1; }
                    }
                    asm volatile("" ::: "memory");
                }
        }
#endif
    }
};

struct EpiFfnIn {
    static constexpr bool PERM = true, CAN_SPLIT = false, APERM = true;
    const float* cw; const float* cb; const float* cc;
    bf16_t* ACT; bf16_t* HALO; float* ncs; float* ncp;
    __device__ __forceinline__ static f32x4 shr1(f32x4 v) { f32x4 r; r[0] = dppf<0x111>(v[0]); r[1] = dppf<0x111>(v[1]); r[2] = dppf<0x111>(v[2]); r[3] = dppf<0x111>(v[3]); return r; }
    __device__ __forceinline__ static f32x4 act4(f32x4 g, f32x4 u) { f32x4 a; a[0] = silu_f(g[0]) * u[0]; a[1] = silu_f(g[1]) * u[1]; a[2] = silu_f(g[2]) * u[2]; a[3] = silu_f(g[3]) * u[3]; return a; }
    __device__ __forceinline__ void operator()(const f32x4 (&acc)[2][2][4][2], const Unit& u, int wr, int wc, int fr, int fq, LAS unsigned char*, int) const {
        const bool prompt = u.pm < 64;
        const int gc0 = u.pn * 128 + wc * 32 + 8 * fq;
        u32x2 res[2][2][4];
#pragma unroll
        for (int n = 0; n < 2; ++n) {
            const int gc = gc0 + 4 * n;
            const f32x4 w0g = *(const f32x4*)(cw + gc), w1g = *(const f32x4*)(cw + 5632 + gc), w2g = *(const f32x4*)(cw + 11264 + gc), bg = *(const f32x4*)(cb + gc);
            const f32x4 w0u = *(const f32x4*)(cw + 2816 + gc), w1u = *(const f32x4*)(cw + 5632 + 2816 + gc), w2u = *(const f32x4*)(cw + 11264 + 2816 + gc), bu = *(const f32x4*)(cb + 2816 + gc);
#pragma unroll
            for (int ai = 0; ai < 2; ++ai) {
                const int r0 = u.pm * 256 + ai * 128 + wr * 64 + 4 * fr;
                const f32x4 g0 = acc[ai][0][0][n], g1 = acc[ai][0][1][n], g2 = acc[ai][0][2][n], g3 = acc[ai][0][3][n];
                const f32x4 u0 = acc[ai][1][0][n], u1 = acc[ai][1][1][n], u2 = acc[ai][1][2][n], u3 = acc[ai][1][3][n];
                f32x4 pg2 = shr1(g2), pg3 = shr1(g3), pu2 = shr1(u2), pu3 = shr1(u3);
                if (!prompt && (fr & 1) == 0) { const float* cp = cc + (size_t)((r0 - NPR) >> 3) * 2 * 5632;
                    pg2 = *(const f32x4*)(cp + gc); pg3 = *(const f32x4*)(cp + 5632 + gc); pu2 = *(const f32x4*)(cp + 2816 + gc); pu3 = *(const f32x4*)(cp + 5632 + 2816 + gc); }
                res[n][ai][0] = pack4(act4(bg + w0g * pg2 + w1g * pg3 + w2g * g0, bu + w0u * pu2 + w1u * pu3 + w2u * u0));
                res[n][ai][1] = pack4(act4(bg + w0g * pg3 + w1g * g0 + w2g * g1, bu + w0u * pu3 + w1u * u0 + w2u * u1));
                res[n][ai][2] = pack4(act4(bg + w0g * g0 + w1g * g1 + w2g * g2, bu + w0u * u0 + w1u * u1 + w2u * u2));
                res[n][ai][3] = pack4(act4(bg + w0g * g1 + w1g * g2 + w2g * g3, bu + w0u * u1 + w1u * u2 + w2u * u3));
            }
        }
#pragma unroll
        for (int ai = 0; ai < 2; ++ai) {
            const int r0 = u.pm * 256 + ai * 128 + wr * 64 + 4 * fr;
            bf16_t* ap = ACT + (size_t)r0 * 2816 + gc0;
#pragma unroll
            for (int m = 0; m < 4; ++m) *(u32x4*)(ap + m * 2816) = (u32x4){res[0][ai][m].x, res[0][ai][m].y, res[1][ai][m].x, res[1][ai][m].y};
#pragma unroll
            for (int n = 0; n < 2; ++n) {
                const int gc = gc0 + 4 * n;
                const f32x4 g0 = acc[ai][0][0][n], g1 = acc[ai][0][1][n], g2 = acc[ai][0][2][n], g3 = acc[ai][0][3][n];
                const f32x4 u0 = acc[ai][1][0][n], u1 = acc[ai][1][1][n], u2 = acc[ai][1][2][n], u3 = acc[ai][1][3][n];
                if (prompt) {
                    if (fr == 0) { bf16_t* hp = HALO + (size_t)(r0 >> 6) * 4 * 5632;
                        *(u32x2*)(hp + gc) = pack4(g0); *(u32x2*)(hp + 2816 + gc) = pack4(u0); *(u32x2*)(hp + 5632 + gc) = pack4(g1); *(u32x2*)(hp + 5632 + 2816 + gc) = pack4(u1); }
                    if (fr == 15) { bf16_t* hp = HALO + ((size_t)(r0 >> 6) * 4 + 2) * 5632;
                        *(u32x2*)(hp + gc) = pack4(g2); *(u32x2*)(hp + 2816 + gc) = pack4(u2); *(u32x2*)(hp + 5632 + gc) = pack4(g3); *(u32x2*)(hp + 5632 + 2816 + gc) = pack4(u3);
                        if ((r0 & 4095) == 4092) { float* op = ncp + (size_t)(r0 >> 12) * 2 * 5632;
                            *(f32x4*)(op + gc) = g2; *(f32x4*)(op + 2816 + gc) = u2; *(f32x4*)(op + 5632 + gc) = g3; *(f32x4*)(op + 5632 + 2816 + gc) = u3; } }
                } else if (fr & 1) { float* op = ncs + (size_t)((r0 - NPR) >> 3) * 2 * 5632;
                    *(f32x4*)(op + gc) = g2; *(f32x4*)(op + 2816 + gc) = u2; *(f32x4*)(op + 5632 + gc) = g3; *(f32x4*)(op + 5632 + 2816 + gc) = u3; }
            }
        }
    }
};

__device__ __forceinline__ int perm_row(int nn, int ptype) {
    if (ptype == 1) { const int pn = nn >> 8, j = nn & 255; return pn * 256 + ((j >> 5) & 1) * 128 + (j >> 6) * 32 + (j & 31); }
    if (ptype == 2) { const int h = nn >= 2816 ? 1 : 0, jj = nn - h * 2816; return (jj >> 7) * 256 + h * 128 + (jj & 127); }
    return nn;
}
struct ConvJob { const float* src; bf16_t* dst; int N, K, k0, n0, ptype; };
__device__ __forceinline__ void conv_load(const ConvJob& jb, int tid, f32x4 (&v)[8]) {
#pragma unroll
    for (int i = 0; i < 8; ++i) { const int idx = tid + i * 512, kk = idx >> 6, c4 = idx & 63; v[i] = *(const f32x4*)(jb.src + (size_t)(jb.k0 + kk) * jb.N + jb.n0 + c4 * 4); }
}
__device__ __forceinline__ void conv_to_lds(int tid, const f32x4 (&v)[8], float* tl) {
#pragma unroll
    for (int i = 0; i < 8; ++i) { const int idx = tid + i * 512, kk = idx >> 6, c4 = idx & 63; float* t = tl + kk * 257 + c4 * 4; t[0] = v[i][0]; t[1] = v[i][1]; t[2] = v[i][2]; t[3] = v[i][3]; }
}
__device__ __forceinline__ void conv_store(const ConvJob& jb, int tid, const float* tl) {
#pragma unroll
    for (int i = 0; i < 4; ++i) {
        const int idx = tid + i * 512, kg = idx & 7, n = idx >> 3;
        const float* t = tl + (kg * 8) * 257 + n;
        u32x4 w; w.x = cvt_pk_bf16(t[0], t[257]); w.y = cvt_pk_bf16(t[2 * 257], t[3 * 257]); w.z = cvt_pk_bf16(t[4 * 257], t[5 * 257]); w.w = cvt_pk_bf16(t[6 * 257], t[7 * 257]);
        *(u32x4*)(jb.dst + (size_t)perm_row(jb.n0 + n, jb.ptype) * jb.K + jb.k0 + kg * 8) = w;
    }
}
__device__ __forceinline__ ConvJob conv_job_main(const Params& p, int j) {
    ConvJob jb; int l, t;
    if (j < 224) { l = j / 112; t = j % 112; jb.N = 1792; jb.K = 1024; jb.ptype = 1; jb.src = p.in[10] + (size_t)l * 1024 * 1792; jb.dst = (bf16_t*)(p.ws + W_IN) + (size_t)l * 1792 * 1024; }
    else if (j < 352) { j -= 224; l = j / 64; t = j % 64; jb.N = 1024; jb.K = 1024; jb.ptype = 0; jb.src = p.in[18] + (size_t)l * 1024 * 1024; jb.dst = (bf16_t*)(p.ws + W_OUT) + (size_t)l * 1024 * 1024; }
    else if (j < 1056) { j -= 352; l = j / 352; t = j % 352; jb.N = 5632; jb.K = 1024; jb.ptype = 2; jb.src = p.in[20] + (size_t)l * 1024 * 5632; jb.dst = (bf16_t*)(p.ws + W_FIN) + (size_t)l * 5632 * 1024; }
    else { j -= 1056; l = j / 176; t = j % 176; jb.N = 1024; jb.K = 2816; jb.ptype = 0; jb.src = p.in[23] + (size_t)l * 2816 * 1024; jb.dst = (bf16_t*)(p.ws + W_FOUT) + (size_t)l * 1024 * 2816; }
    const int nn = jb.N / 256; jb.k0 = (t / nn) * 64; jb.n0 = (t % nn) * 256;
    return jb;
}
__device__ __forceinline__ ConvJob conv_job_ada(const Params& p, int j) {
    ConvJob jb; const int l = j / 384, t = j % 384;
    jb.N = 6144; jb.K = 1024; jb.ptype = 0; jb.src = p.in[7] + (size_t)l * 1024 * 6144; jb.dst = (bf16_t*)(p.ws + W_ADA) + (size_t)l * 6144 * 1024; jb.k0 = (t / 24) * 64; jb.n0 = (t % 24) * 256;
    return jb;
}
template <bool ADA>
__device__ __forceinline__ void conv_run(const Params& p, int j0, int step, int njobs, float* tl) {
    const int tid = tid_opaque();
    if (j0 >= njobs) return;
    ConvJob cur = ADA ? conv_job_ada(p, j0) : conv_job_main(p, j0);
    f32x4 v[8];
    conv_load(cur, tid, v);
    for (int j = j0; j < njobs; j += step) {
        conv_to_lds(tid, v, tl);
        __syncthreads();
        const int jn = j + step; const bool hn = jn < njobs;
        ConvJob nxt = cur;
        if (hn) { nxt = ADA ? conv_job_ada(p, jn) : conv_job_main(p, jn); conv_load(nxt, tid, v); }
        conv_store(cur, tid, tl);
        __syncthreads();
        cur = nxt;
    }
}

__device__ __forceinline__ void phase_prep(const Params& p, unsigned char* shm) {
    float* tl = (float*)shm;
    const int nb = gridDim.x, bid = blockIdx.x, tid = tid_opaque();
    conv_run<true>(p, bid, nb, 768, tl);
    const int gtid = bid * 512 + tid, gn = nb * 512;
    bf16_t* CS = (bf16_t*)(p.ws + W_CS);
    for (int i = gtid; i < 256 * 1024 / 2; i += gn) { const int e = i * 2, row = e >> 10; float a = 0.f, b = 0.f;
        if (row < 4) { a = p.in[5][e]; b = p.in[5][e + 1]; } else if (row < 132) { a = p.in[6][e - 4096]; b = p.in[6][e - 4096 + 1]; }
        *(unsigned*)(CS + e) = cvt_pk_bf16(silu_f(a), silu_f(b)); }
    float* RT = (float*)(p.ws + W_ROPE);
    for (int i = gtid; i < 4104 * 8; i += gn) { const int pidx = i >> 3, a = i & 7; const int pos = pidx < 4096 ? pidx : 16384 + (pidx - 4096);
        const double ang = (double)pos * p.inv[a];
        const double kq = rint(ang * 0.63661977236758134308);
        double rr = fma(-kq, 1.5707963267948966192, ang); rr = fma(-kq, 6.123233995736766036e-17, rr);
        const double r2 = rr * rr;
        const double sn = rr * (1.0 + r2 * (-1.0 / 6 + r2 * (1.0 / 120 + r2 * (-1.0 / 5040 + r2 * (1.0 / 362880 + r2 * (-1.0 / 39916800))))));
        const double cs = 1.0 + r2 * (-0.5 + r2 * (1.0 / 24 + r2 * (-1.0 / 720 + r2 * (1.0 / 40320 + r2 * (-1.0 / 3628800 + r2 * (1.0 / 479001600))))));
        const int q = ((int)((long long)kq & 3));
        double c_, s_;
        if (q == 0) { c_ = cs; s_ = sn; } else if (q == 1) { c_ = -sn; s_ = cs; } else if (q == 2) { c_ = -cs; s_ = -sn; } else { c_ = sn; s_ = -cs; }
        RT[pidx * 16 + a] = (float)c_; RT[pidx * 16 + 8 + a] = (float)s_; }
    bf16_t* WSB = (bf16_t*)(p.ws + W_WS);
    for (int i = gtid; i < 2 * 4 * 128 * 128 / 2; i += gn) { const int e = i * 2, s = e & 127, t = (e >> 7) & 127;
        const float a = (s <= t) ? p.in[16][e] : 0.f, b = (s + 1 <= t) ? p.in[16][e + 1] : 0.f;
        *(unsigned*)(WSB + e) = cvt_pk_bf16(a, b); }
}

template <bool INB>
__device__ __forceinline__ void phase_norm(const float* xp, const float* xs, const bf16_t* xb, const float* gvec, const float* mod_sh, const float* mod_sc, bf16_t* H) {
    const int tid = tid_opaque(); const int wid = tid >> 6, lane = tid & 63;
    const int nw = gridDim.x * 8;
    f32x4 g[4];
#pragma unroll
    for (int i = 0; i < 4; ++i) g[i] = *(const f32x4*)(gvec + i * 256 + lane * 4);
    int r = blockIdx.x * 8 + wid;
    f32x4 v[4], sc[4], sh[4];
    auto load_row = [&](int rr, f32x4 (&vv)[4], f32x4 (&scc)[4], f32x4 (&shh)[4]) {
        const int mrow = rr < NPR ? (rr >> 12) : 4 + ((rr - NPR) >> 3);
#pragma unroll
        for (int i = 0; i < 4; ++i) { const int c = i * 256 + lane * 4;
            if (INB) vv[i] = unpack4(*(const u32x2*)(xb + (size_t)rr * 1024 + c));
            else vv[i] = *(const f32x4*)((rr < NPR ? xp + (size_t)rr * 1024 : xs + (size_t)(rr - NPR) * 1024) + c);
            scc[i] = *(const f32x4*)(mod_sc + (size_t)mrow * 12288 + c); shh[i] = *(const f32x4*)(mod_sh + (size_t)mrow * 12288 + c); }
    };
    if (r < MT) load_row(r, v, sc, sh);
    while (r < MT) {
        const int rn = r + nw; const int rnc = rn < MT ? rn : r;
        f32x4 v2[4], sc2[4], sh2[4];
        load_row(rnc, v2, sc2, sh2);
        float ss = 0.f;
#pragma unroll
        for (int i = 0; i < 4; ++i) ss += v[i][0] * v[i][0] + v[i][1] * v[i][1] + v[i][2] * v[i][2] + v[i][3] * v[i][3];
#pragma unroll
        for (int o = 32; o >= 1; o >>= 1) ss += __shfl_xor(ss, o);
        const float rs = rsqrtf(ss * (1.0f / 1024.0f) + 1e-6f);
#pragma unroll
        for (int i = 0; i < 4; ++i) *(u32x2*)(H + (size_t)r * 1024 + i * 256 + lane * 4) = pack4(v[i] * rs * g[i] * (sc[i] + 1.0f) + sh[i]);
#pragma unroll
        for (int i = 0; i < 4; ++i) { v[i] = v2[i]; sc[i] = sc2[i]; sh[i] = sh2[i]; }
        r = rn;
    }
}

__device__ __forceinline__ void attn_unit(const Params& p, int layer, bool sample, int b, int blk, int kvh, unsigned char* shm) {
    bf16_t* Ks = (bf16_t*)shm;
    bf16_t* Vt = Ks + 256 * 72;
    bf16_t* Pw = Vt + 64 * 280;
    const bf16_t* Q = (const bf16_t*)(p.ws + W_Q); const bf16_t* KB = (const bf16_t*)(p.ws + W_KB); const bf16_t* VB = (const bf16_t*)(p.ws + W_VB);
    bf16_t* MIX = (bf16_t*)(p.ws + W_MIX);
    const int tid = tid_opaque(), wid = tid >> 6, lane = tid & 63, fr = lane & 15, fq = lane >> 4;
    if (!sample) {
        const int row0 = b * 4096 + blk * 128 - 128;
#pragma unroll
        for (int i = 0; i < 4; ++i) { const int idx = tid + i * 512, j = idx >> 3, c8 = idx & 7; int gr = row0 + j; if (gr < b * 4096) gr += 128;
            *(u32x4*)(Ks + j * 72 + c8 * 8) = *(const u32x4*)(KB + (size_t)gr * 128 + kvh * 64 + c8 * 8); }
#pragma unroll
        for (int i = 0; i < 4; ++i) { const int idx = tid + i * 512, j = idx & 255, c8 = idx >> 8; int gr = row0 + j; if (gr < b * 4096) gr += 128;
            const u32x4 v = *(const u32x4*)(VB + (size_t)gr * 128 + kvh * 64 + c8 * 8);
            bf16_t* d = Vt + (c8 * 8) * 280 + j;
            d[0] = (bf16_t)(v.x & 0xffff); d[280] = (bf16_t)(v.x >> 16); d[2 * 280] = (bf16_t)(v.y & 0xffff); d[3 * 280] = (bf16_t)(v.y >> 16);
            d[4 * 280] = (bf16_t)(v.z & 0xffff); d[5 * 280] = (bf16_t)(v.z >> 16); d[6 * 280] = (bf16_t)(v.w & 0xffff); d[7 * 280] = (bf16_t)(v.w >> 16); }
        for (int i = tid; i < 64 * 24; i += 512) Vt[(i / 24) * 280 + 256 + (i % 24)] = 0;
    } else {
        const float* ck = p.in[2] + ((size_t)(layer * 128 + b) * 128) * 128 + kvh * 64;
        const float* cv = p.in[3] + ((size_t)(layer * 128 + b) * 128) * 128 + kvh * 64;
#pragma unroll
        for (int i = 0; i < 4; ++i) { const int idx = tid + i * 512, j = idx >> 4, c4 = idx & 15;
            const f32x4 v = *(const f32x4*)(ck + (size_t)j * 128 + c4 * 4); *(u32x2*)(Ks + j * 72 + c4 * 4) = pack4(v); }
#pragma unroll
        for (int i = 0; i < 4; ++i) { const int idx = tid + i * 512, j = idx & 127, c4 = idx >> 7;
            const f32x4 v = *(const f32x4*)(cv + (size_t)j * 128 + c4 * 4); const u32x2 w = pack4(v);
            bf16_t* d = Vt + (c4 * 4) * 280 + j;
            d[0] = (bf16_t)(w.x & 0xffff); d[280] = (bf16_t)(w.x >> 16); d[2 * 280] = (bf16_t)(w.y & 0xffff); d[3 * 280] = (bf16_t)(w.y >> 16); }
        if (tid < 128) { const int s = tid >> 3, c8 = tid & 7; u32x4 v = (u32x4){0u, 0u, 0u, 0u};
            if (s < 8) v = *(const u32x4*)(KB + (size_t)(NPR + b * 8 + s) * 128 + kvh * 64 + c8 * 8);
            *(u32x4*)(Ks + (128 + s) * 72 + c8 * 8) = v;
        } else if (tid < 256) { const int t2 = tid - 128, s = t2 & 15, c8 = t2 >> 4; u32x4 v = (u32x4){0u, 0u, 0u, 0u};
            if (s < 8) v = *(const u32x4*)(VB + (size_t)(NPR + b * 8 + s) * 128 + kvh * 64 + c8 * 8);
            bf16_t* d = Vt + (c8 * 8) * 280 + 128 + s;
            d[0] = (bf16_t)(v.x & 0xffff); d[280] = (bf16_t)(v.x >> 16); d[2 * 280] = (bf16_t)(v.y & 0xffff); d[3 * 280] = (bf16_t)(v.y >> 16);
            d[4 * 280] = (bf16_t)(v.z & 0xffff); d[5 * 280] = (bf16_t)(v.z >> 16); d[6 * 280] = (bf16_t)(v.w & 0xffff); d[7 * 280] = (bf16_t)(v.w >> 16);
        } else { const int t2 = tid - 256; for (int i = t2; i < 64 * 16; i += 256) Vt[(i >> 4) * 280 + 144 + (i & 15)] = 0; }
    }
    __syncthreads();
    const int hh = wid >> 1, half = wid & 1, head = kvh * 4 + hh;
    const int ntile = sample ? (half == 0 ? 1 : 0) : 4;
    const int kmin = sample ? 0 : (blk == 0 ? 128 : 0), kmax = sample ? 136 : 256;
    const float sink = p.in[13][layer * 8 + head];
    bf16_t* Pme = Pw + wid * 16 * 168;
    u32x2 ores[4][4];
    for (int rt = 0; rt < ntile; ++rt) {
        const int i0 = sample ? 0 : half * 64 + rt * 16;
        const int qi = sample ? (fr & 7) : i0 + fr;
        const size_t grow = sample ? (size_t)(NPR + b * 8 + qi) : (size_t)(b * 4096 + blk * 128 + qi);
        const bf16_t* qp = Q + grow * 512 + head * 64;
        bf16x8 qf[2]; qf[0] = *(const bf16x8*)(qp + fq * 8); qf[1] = *(const bf16x8*)(qp + 32 + fq * 8);
        f32x4 s[9];
#pragma unroll
        for (int kt = 0; kt < 9; ++kt) { s[kt] = (f32x4){0.f, 0.f, 0.f, 0.f};
#pragma unroll
            for (int ks = 0; ks < 2; ++ks) { const bf16x8 kf = *(const bf16x8*)(Ks + (i0 + 16 * kt + fr) * 72 + ks * 32 + fq * 8);
                s[kt] = __builtin_amdgcn_mfma_f32_16x16x32_bf16(kf, qf[ks], s[kt], 0, 0, 0); } }
        float mx = sink;
#pragma unroll
        for (int kt = 0; kt < 9; ++kt)
#pragma unroll
            for (int e = 0; e < 4; ++e) { const int kb = i0 + 16 * kt + 4 * fq + e;
                const bool valid = (!sample && kt >= 1 && kt <= 7) ? (i0 + 16 * kt >= kmin) : ((kb >= qi + 1) && (kb <= qi + 128) && (kb >= kmin) && (kb < kmax));
                const float sc = valid ? s[kt][e] * 0.125f : -1e30f; s[kt][e] = sc; mx = fmaxf(mx, sc); }
        mx = xmax_fq(mx);
        float sum = 0.f;
#pragma unroll
        for (int kt = 0; kt < 9; ++kt)
#pragma unroll
            for (int e = 0; e < 4; ++e) { const float pe = fast_exp(s[kt][e] - mx); s[kt][e] = pe; sum += pe; }
        sum = xsum_fq(sum) + fast_exp(sink - mx);
        const float inv = 1.0f / sum;
#pragma unroll
        for (int kt = 0; kt < 9; ++kt) *(u32x2*)(Pme + fr * 168 + 16 * kt + 4 * fq) = pack4(s[kt] * inv);
        *(u32x2*)(Pme + fr * 168 + 144 + 4 * fq) = (u32x2){0u, 0u};
        asm volatile("s_waitcnt lgkmcnt(0)" ::: "memory");
        f32x4 o[4];
#pragma unroll
        for (int dt = 0; dt < 4; ++dt) o[dt] = (f32x4){0.f, 0.f, 0.f, 0.f};
#pragma unroll
        for (int ks = 0; ks < 5; ++ks) { const bf16x8 pf = *(const bf16x8*)(Pme + fr * 168 + ks * 32 + fq * 8);
#pragma unroll
            for (int dt = 0; dt < 4; ++dt) { const bf16x8 vf = *(const bf16x8*)(Vt + (16 * dt + fr) * 280 + i0 + ks * 32 + fq * 8);
                o[dt] = __builtin_amdgcn_mfma_f32_16x16x32_bf16(vf, pf, o[dt], 0, 0, 0); } }
#pragma unroll
        for (int dt = 0; dt < 4; ++dt) {
            const u32x2 pk = pack4_mfma(o[dt]);
            if (rt == 0) ores[0][dt] = pk; else if (rt == 1) ores[1][dt] = pk; else if (rt == 2) ores[2][dt] = pk; else ores[3][dt] = pk; }
        asm volatile("s_waitcnt lgkmcnt(0)" ::: "memory");
    }
#pragma unroll
    for (int rt = 0; rt < 4; ++rt) {
        if (rt < ntile && (!sample || fr < 8)) {
            const int qi = sample ? (fr & 7) : half * 64 + rt * 16 + fr;
            const size_t grow = sample ? (size_t)(NPR + b * 8 + qi) : (size_t)(b * 4096 + blk * 128 + qi);
            bf16_t* mp = MIX + grow * 1024 + head * 64 + 4 * fq;
#pragma unroll
            for (int dt = 0; dt < 4; ++dt) *(u32x2*)(mp + 16 * dt) = ores[rt][dt];
        }
    }
    __syncthreads();
}

__device__ __forceinline__ void sg_unit(const Params& p, int layer, int b, int chunk, int g, unsigned char* shm) {
    bf16_t* VGt = (bf16_t*)shm;
    const bf16_t* U = (const bf16_t*)(p.ws + W_U); const bf16_t* VG = (const bf16_t*)(p.ws + W_VG); const bf16_t* WSB = (const bf16_t*)(p.ws + W_WS);
    bf16_t* MIX = (bf16_t*)(p.ws + W_MIX);
    const int tid = tid_opaque(), wid = tid >> 6, lane = tid & 63, fr = lane & 15, fq = lane >> 4;
    const int rb = b * 4096 + chunk * 128;
    const int t0 = 16 * wid, nks = (wid >> 1) + 1;
    const bf16_t* wp = WSB + ((size_t)(layer * 4 + g) * 128 + t0 + fr) * 128 + fq * 8;
    bf16x8 wfa[4];
#pragma unroll
    for (int ks = 0; ks < 4; ++ks) wfa[ks] = *(const bf16x8*)(wp + ks * 32);
    const float bs = p.in[17][(layer * 4 + g) * 128 + t0 + fr];
    const size_t row = (size_t)(rb + t0 + fr);
    u32x2 ua[8];
#pragma unroll
    for (int wt = 0; wt < 8; ++wt) ua[wt] = *(const u32x2*)(U + row * 512 + g * 128 + 16 * wt + 4 * fq);
#pragma unroll
    for (int i = 0; i < 4; ++i) { const int idx = tid + i * 512, s = idx & 127, c8 = idx >> 7;
        const u32x4 v = *(const u32x4*)(VG + (size_t)(rb + s) * 512 + g * 128 + c8 * 8);
        bf16_t* d = VGt + (c8 * 8) * 136 + s;
        d[0] = (bf16_t)(v.x & 0xffff); d[136] = (bf16_t)(v.x >> 16); d[2 * 136] = (bf16_t)(v.y & 0xffff); d[3 * 136] = (bf16_t)(v.y >> 16);
        d[4 * 136] = (bf16_t)(v.z & 0xffff); d[5 * 136] = (bf16_t)(v.z >> 16); d[6 * 136] = (bf16_t)(v.w & 0xffff); d[7 * 136] = (bf16_t)(v.w >> 16); }
    __syncthreads();
    f32x4 z[8];
#pragma unroll
    for (int wt = 0; wt < 8; ++wt) z[wt] = (f32x4){0.f, 0.f, 0.f, 0.f};
#pragma unroll
    for (int ks = 0; ks < 4; ++ks) { if (ks >= nks) break;
#pragma unroll
        for (int wt = 0; wt < 8; ++wt) { const bf16x8 vf = *(const bf16x8*)(VGt + (16 * wt + fr) * 136 + ks * 32 + fq * 8);
            z[wt] = __builtin_amdgcn_mfma_f32_16x16x32_bf16(vf, wfa[ks], z[wt], 0, 0, 0); } }
#pragma unroll
    for (int wt = 0; wt < 8; ++wt) { const int c = g * 128 + 16 * wt + 4 * fq;
        const u32x2 uu = ua[wt];
        f32x4 o; o[0] = __uint_as_float(uu.x << 16) * (z[wt][0] + bs); o[1] = __uint_as_float(uu.x & 0xffff0000u) * (z[wt][1] + bs);
        o[2] = __uint_as_float(uu.y << 16) * (z[wt][2] + bs); o[3] = __uint_as_float(uu.y & 0xffff0000u) * (z[wt][3] + bs);
        *(u32x2*)(MIX + row * 1024 + 512 + c) = pack4(o); }
    __syncthreads();
}

__device__ __forceinline__ void phase_mix(const Params& p, int layer, unsigned char* shm) {
    const int nb = gridDim.x, bid = blockIdx.x;
#ifndef NO_MIXA
    for (int u = bid; u < 256; u += nb) attn_unit(p, layer, false, u >> 6, (u >> 1) & 31, u & 1, shm);
#endif
#ifndef NO_MIXB
    for (int u = bid; u < 256; u += nb) attn_unit(p, layer, true, u >> 1, 0, u & 1, shm);
#endif
#ifndef NO_MIXC
    for (int u = bid; u < 512; u += nb) sg_unit(p, layer, u >> 7, (u >> 2) & 31, u & 3, shm);
#endif
    const bf16_t* U = (const bf16_t*)(p.ws + W_U); const bf16_t* VG = (const bf16_t*)(p.ws + W_VG); bf16_t* MIX = (bf16_t*)(p.ws + W_MIX);
    for (int idx = bid * 512 + tid_opaque(); idx < 1024 * 128; idx += nb * 512) {
        const int r = idx >> 7, c4 = (idx & 127) * 4, b = r >> 3, t = r & 7, g = c4 >> 7;
        const float* wrow = p.in[16] + ((size_t)(layer * 4 + g) * 128 + t) * 128;
        f32x4 z = (f32x4){0.f, 0.f, 0.f, 0.f};
        const f32x4 wa = *(const f32x4*)(wrow), wb = *(const f32x4*)(wrow + 4);
        u32x2 vv[8];
#pragma unroll
        for (int s = 0; s < 8; ++s) vv[s] = *(const u32x2*)(VG + (size_t)(NPR + b * 8 + s) * 512 + c4);
#pragma unroll
        for (int s = 0; s < 8; ++s) { const float w0 = s < 4 ? wa[s & 3] : wb[s & 3]; const float w = (s <= t) ? w0 : 0.f;
            z[0] += w * __uint_as_float(vv[s].x << 16); z[1] += w * __uint_as_float(vv[s].x & 0xffff0000u); z[2] += w * __uint_as_float(vv[s].y << 16); z[3] += w * __uint_as_float(vv[s].y & 0xffff0000u); }
        const float bs = p.in[17][(layer * 4 + g) * 128 + t];
        const u32x2 uu = *(const u32x2*)(U + (size_t)(NPR + r) * 512 + c4);
        f32x4 o; o[0] = __uint_as_float(uu.x << 16) * (z[0] + bs); o[1] = __uint_as_float(uu.x & 0xffff0000u) * (z[1] + bs);
        o[2] = __uint_as_float(uu.y << 16) * (z[2] + bs); o[3] = __uint_as_float(uu.y & 0xffff0000u) * (z[3] + bs);
        *(u32x2*)(MIX + (size_t)(NPR + r) * 1024 + 512 + c4) = pack4(o);
    }
}

__device__ __forceinline__ void phase_fix(const Params& p, int layer) {
    const bf16_t* HALO = (const bf16_t*)(p.ws + W_HALO); bf16_t* ACT = (bf16_t*)(p.ws + W_R);
    const float* cw = p.in[21] + (size_t)layer * 3 * 5632; const float* cb = p.in[22] + (size_t)layer * 5632;
    const int gtid = blockIdx.x * 512 + tid_opaque(), gn = gridDim.x * 512;
    for (int idx = gtid; idx < 256 * 704; idx += gn) {
        const int blk = idx / 704, c = (idx % 704) * 4;
        const bf16_t* own = HALO + (size_t)blk * 4 * 5632; const bf16_t* prv = own - 4 * 5632;
        const bool first = (blk & 63) == 0;
        f32x4 a0, a1;
        f32x4 cg[2], cu[2];
#pragma unroll
        for (int h = 0; h < 2; ++h) {
            const int cc = c + h * 2816;
            const f32x4 w0 = *(const f32x4*)(cw + cc), w1 = *(const f32x4*)(cw + 5632 + cc), w2 = *(const f32x4*)(cw + 11264 + cc), bb = *(const f32x4*)(cb + cc);
            const f32x4 zero = (f32x4){0.f, 0.f, 0.f, 0.f};
            const f32x4 m2 = first ? zero : unpack4(*(const u32x2*)(prv + 2 * 5632 + cc)), m1 = first ? zero : unpack4(*(const u32x2*)(prv + 3 * 5632 + cc));
            const f32x4 o0 = unpack4(*(const u32x2*)(own + cc)), o1 = unpack4(*(const u32x2*)(own + 5632 + cc));
            const f32x4 r0 = bb + w0 * m2 + w1 * m1 + w2 * o0, r1 = bb + w0 * m1 + w1 * o0 + w2 * o1;
            if (h == 0) { cg[0] = r0; cg[1] = r1; } else { cu[0] = r0; cu[1] = r1; }
        }
#pragma unroll
        for (int e = 0; e < 4; ++e) { a0[e] = silu_f(cg[0][e]) * cu[0][e]; a1[e] = silu_f(cg[1][e]) * cu[1][e]; }
        *(u32x2*)(ACT + (size_t)(blk * 64) * 2816 + c) = pack4(a0);
        *(u32x2*)(ACT + (size_t)(blk * 64 + 1) * 2816 + c) = pack4(a1);
    }
}

#define XB_TMO      128
#define XB_XCNT(j)  (256  + 64 * (j))
#define XB_XSUB(j)  (1280 + 64 * (j))
#define XB_XGEN(j)  (2304 + 64 * (j))
#define XB_TOP      3328
#define XB_TOPGEN   3392
#define XCD_BAR_WORDS 3456
#define XB_SPIN_CAP (1u << 18)
__device__ __forceinline__ unsigned xb_ld(unsigned* p)              { return __hip_atomic_load(p, __ATOMIC_RELAXED, __HIP_MEMORY_SCOPE_AGENT); }
__device__ __forceinline__ unsigned xb_add(unsigned* p, unsigned v) { return __hip_atomic_fetch_add(p, v, __ATOMIC_RELAXED, __HIP_MEMORY_SCOPE_AGENT); }
__device__ __forceinline__ unsigned xb_xcc_id() { return (unsigned)__builtin_amdgcn_s_getreg((3 << 11) | 20) & 0xFu; }
#define XB_SPIN(cond, bar) do { unsigned _sp = 0; while (cond) { __builtin_amdgcn_s_sleep(1); \
    if ((++_sp & 255u) == 0u) { if (xb_ld(&(bar)[XB_TMO])) break; if (_sp > XB_SPIN_CAP) { atomicAdd(&(bar)[XB_TMO], 1u); break; } } } } while (0)
struct XcdBarrier { unsigned* bar; unsigned x; volatile LAS unsigned* st; };
__device__ __forceinline__ XcdBarrier xcd_barrier_post(unsigned* bar, volatile LAS unsigned* st) {
    XcdBarrier b; b.bar = bar; b.x = xb_xcc_id(); b.st = st;
    if (threadIdx.x == 0) (void)xb_add(&bar[XB_XCNT(b.x)], 1u);
    return b;
}
__device__ __forceinline__ void xcd_barrier_complete(unsigned* bar, unsigned x, unsigned& nloc, unsigned& nx) {
    const unsigned G = gridDim.x * gridDim.y * gridDim.z;
    unsigned sum, cnt, mine, sp = 0u;
    for (;;) {
        sum = 0u; cnt = 0u; mine = 0u;
#pragma unroll
        for (unsigned j = 0; j < 16; ++j) { const unsigned c = xb_ld(&bar[XB_XCNT(j)]); sum += c; cnt += (c > 0u) ? 1u : 0u; mine = (j == x) ? c : mine; }
        if (sum == G) break;
        __builtin_amdgcn_s_sleep(1);
        if ((++sp & 255u) == 0u) { if (xb_ld(&bar[XB_TMO])) break; if (sp > XB_SPIN_CAP) { atomicAdd(&bar[XB_TMO], 1u); break; } }
    }
    nloc = mine > 0u ? mine : 1u; nx = cnt > 0u ? cnt : 1u;
}
__device__ __forceinline__ void xcd_barrier(const XcdBarrier& b) {
    asm volatile("s_waitcnt vmcnt(0)" ::: "memory");
    __syncthreads();
    if (threadIdx.x == 0) {
        unsigned* bar = b.bar;
        __builtin_amdgcn_s_waitcnt(0);
        unsigned nloc = b.st[0], nx = b.st[1];
        if (nloc == 0u) { xcd_barrier_complete(bar, b.x, nloc, nx); b.st[0] = nloc; b.st[1] = nx; }
        const unsigned old = xb_add(&bar[XB_XSUB(b.x)], 1u);
        const unsigned gen = old / nloc;
        if (old + 1u == (gen + 1u) * nloc) {
            __builtin_amdgcn_fence(__ATOMIC_RELEASE, "agent");
            asm volatile("s_waitcnt vmcnt(0)" ::: "memory");
            const unsigned og = xb_add(&bar[XB_TOP], 1u);
            const unsigned tg = og / nx;
            if (og + 1u == (tg + 1u) * nx) xb_add(&bar[XB_TOPGEN], 1u);
            else XB_SPIN(xb_ld(&bar[XB_TOPGEN]) == tg, bar);
            __builtin_amdgcn_fence(__ATOMIC_ACQUIRE, "agent");
            xb_add(&bar[XB_XGEN(b.x)], 1u);
            asm volatile("s_waitcnt vmcnt(0)" ::: "memory");
        } else {
            XB_SPIN(xb_ld(&bar[XB_XGEN(b.x)]) == gen, bar);
            __builtin_amdgcn_fence(__ATOMIC_ACQUIRE, "agent");
            asm volatile("s_waitcnt vmcnt(0)" ::: "memory");
        }
    }
    __syncthreads();
}

__device__ __forceinline__ void run_phase(const Params& p, int ph, unsigned char* shm) {
    LAS unsigned char* lds = (LAS unsigned char*)shm;
    float* MOD = (float*)(p.ws + W_MOD);
    const int nb = gridDim.x, bid = blockIdx.x;
    if (ph == 0) { phase_prep(p, shm); return; }
    if (ph == 1) {
        const int ng = nb > 96 ? 48 : 0;
        if (ng == 0 || bid < ng) {
            pg8::StaticOrder S; S.init(256, 12288, 1024, ng ? ng : nb, bid, false);
            pg8::Gemm g{(const bf16_t*)(p.ws + W_CS), (const bf16_t*)(p.ws + W_ADA), 256, 12288, 1024};
            EpiMod E{MOD, p.in[8]};
            pg8::gemm_phase(lds, g, S, E);
        }
        if (ng == 0 || bid >= ng) {
            const int nc = ng ? nb - ng : nb, c0 = ng ? bid - ng : bid;
            conv_run<false>(p, c0, nc, 1408, (float*)shm);
        }
        return;
    }
    const int layer = (ph - 2) >> 3, sub = (ph - 2) & 7;
    const float* modl = MOD + layer * 6144;
    bf16_t* XB = (bf16_t*)(p.ws + W_XB);
    unsigned* tick = (unsigned*)(p.ws + W_BAR + 16384);
    pg8::StaticOrder S;
    switch (sub) {
    case 0: if (layer == 0) phase_norm<false>(p.in[0], p.in[1], nullptr, p.in[9], modl + 0, modl + 1024, (bf16_t*)(p.ws + W_H));
            else phase_norm<true>(nullptr, nullptr, XB, p.in[9] + layer * 1024, modl + 0, modl + 1024, (bf16_t*)(p.ws + W_H));
            break;
    case 1: { S.init(MT, 1792, 1024, nb, bid, false); S.reverse = 1;
        pg8::Gemm g{(const bf16_t*)(p.ws + W_H), (const bf16_t*)(p.ws + W_IN) + (size_t)layer * 1792 * 1024, MT, 1792, 1024};
        EpiIn E{layer, p.in[11] + layer * 64, p.in[12] + layer * 64, p.in[14] + layer * 512, p.in[15] + layer * 512, (const float*)(p.ws + W_ROPE),
                (bf16_t*)(p.ws + W_Q), (bf16_t*)(p.ws + W_KB), (bf16_t*)(p.ws + W_VB), (bf16_t*)(p.ws + W_U), (bf16_t*)(p.ws + W_VG), p.out};
        pg8::gemm_phase(lds, g, S, E); } break;
    case 2: phase_mix(p, layer, shm); break;
    case 3: { S.init(MT, 1024, 1024, nb, bid, true);
        pg8::Gemm g{(const bf16_t*)(p.ws + W_MIX), (const bf16_t*)(p.ws + W_OUT) + (size_t)layer * 1024 * 1024, MT, 1024, 1024};
        if (layer == 0) { EpiRes<false, true> E{p.in[0], p.in[1], nullptr, nullptr, XB, modl + 2048, p.ws, tick + (layer * 2 + 0) * 128}; pg8::gemm_phase(lds, g, S, E); }
        else { EpiRes<true, true> E{nullptr, nullptr, XB, nullptr, XB, modl + 2048, p.ws, tick + (layer * 2 + 0) * 128}; pg8::gemm_phase(lds, g, S, E); }
        } break;
    case 4: phase_norm<true>(nullptr, nullptr, XB, p.in[19] + layer * 1024, modl + 3072, modl + 4096, (bf16_t*)(p.ws + W_H)); break;
    case 5: { S.init(MT, 5632, 1024, nb, bid, false); S.reverse = 1;
        pg8::Gemm g{(const bf16_t*)(p.ws + W_H), (const bf16_t*)(p.ws + W_FIN) + (size_t)layer * 5632 * 1024, MT, 5632, 1024};
        EpiFfnIn E{p.in[21] + (size_t)layer * 3 * 5632, p.in[22] + (size_t)layer * 5632, p.in[4] + (size_t)layer * 128 * 2 * 5632,
                   (bf16_t*)(p.ws + W_R), (bf16_t*)(p.ws + W_HALO), p.out + O_NCS + (size_t)layer * 128 * 2 * 5632, p.out + O_NCP + (size_t)layer * 4 * 2 * 5632};
        pg8::gemm_phase(lds, g, S, E); } break;
    case 6: phase_fix(p, layer); break;
    case 7: { S.init(MT, 1024, 2816, nb, bid, true);
        pg8::Gemm g{(const bf16_t*)(p.ws + W_R), (const bf16_t*)(p.ws + W_FOUT) + (size_t)layer * 1024 * 2816, MT, 1024, 2816};
        if (layer == 0) { EpiRes<true, true> E{nullptr, nullptr, XB, nullptr, XB, modl + 5120, p.ws, tick + (layer * 2 + 1) * 128}; pg8::gemm_phase(lds, g, S, E); }
        else { EpiRes<true, false> E{nullptr, nullptr, XB, p.out, nullptr, modl + 5120, p.ws, tick + (layer * 2 + 1) * 128}; pg8::gemm_phase(lds, g, S, E); }
        } break;
    }
}

__global__ __launch_bounds__(512, 2) void mega_fwd(Params p) {
    extern __shared__ __attribute__((aligned(16))) unsigned char shm[];
    cg::grid_group grid = cg::this_grid();
    const int lo = p.ph_lo, hi = p.ph_hi;
    if (lo < 0) grid.sync();
    volatile LAS unsigned* st = (volatile LAS unsigned*)((LAS unsigned char*)shm + LDS_MISC);
    if (threadIdx.x < 4) st[threadIdx.x] = 0u;
    __syncthreads();
    XcdBarrier xb; xb.bar = (unsigned*)(p.ws + W_BAR); xb.x = 0; xb.st = st;
    if (hi - lo > 1) xb = xcd_barrier_post((unsigned*)(p.ws + W_BAR), st);
#ifndef PROBE_DUP
#define PROBE_DUP -1
#endif
#define PHASE(k) do { if (lo <= (k) && (k) < hi) run_phase(p, (k), shm); if (lo <= (k) && (k) + 1 < hi) xcd_barrier(xb); \
        if ((k) == PROBE_DUP) { run_phase(p, (k), shm); xcd_barrier(xb); } } while (0)
    PHASE(0); PHASE(1); PHASE(2); PHASE(3); PHASE(4); PHASE(5); PHASE(6); PHASE(7); PHASE(8); PHASE(9);
    PHASE(10); PHASE(11); PHASE(12); PHASE(13); PHASE(14); PHASE(15); PHASE(16); PHASE(17);
#undef PHASE
}

extern "C" void kernel_launch(void* const* d_in, const int* in_sizes, int n_in, void* d_out, int out_size, void* d_ws, size_t ws_size, hipStream_t stream) {
    static int grid = 0;
    if (grid == 0) {
        if (n_in != 24 || ws_size < W_END) { fprintf(stderr, "kernel_launch: unexpected n_in %d / ws %zu (need %zu)\n", n_in, ws_size, (size_t)W_END); grid = -1; return; }
        int dev = 0, cus = 0, per_cu = 0;
        hipGetDevice(&dev); hipDeviceGetAttribute(&cus, hipDeviceAttributeMultiprocessorCount, dev);
        if (hipFuncSetAttribute((const void*)mega_fwd, hipFuncAttributeMaxDynamicSharedMemorySize, LDS_BYTES) != hipSuccess) { fprintf(stderr, "kernel_launch: hipFuncSetAttribute failed\n"); grid = -1; return; }
        if (hipOccupancyMaxActiveBlocksPerMultiprocessor(&per_cu, (const void*)mega_fwd, 512, LDS_BYTES) != hipSuccess || per_cu < 1) { fprintf(stderr, "kernel_launch: occupancy query says %d\n", per_cu); per_cu = 1; }
        (void)hipGetLastError();
        grid = cus * 1;
        if (grid > 256) grid = 256;
    }
    if (grid < 0) return;
    Params p{};
    for (int i = 0; i < 24; ++i) p.in[i] = (const float*)d_in[i];
    p.out = (float*)d_out; p.ws = (unsigned char*)d_ws;
    for (int a = 0; a < 8; ++a) p.inv[a] = std::pow(500000.0, -(double)a / 8.0);
#if ONE_LAUNCH
    (void)hipMemsetAsync((char*)d_ws + W_BAR, 0, 32768, stream);
    p.ph_lo = 0; p.ph_hi = NPH;
    void* args[] = {&p};
    hipError_t e = hipLaunchCooperativeKernel((const void*)mega_fwd, dim3(grid), dim3(512), args, LDS_BYTES, stream);
    if (e != hipSuccess) fprintf(stderr, "cooperative launch failed: %s (grid %d)\n", hipGetErrorString(e), grid);
#else
    for (int ph = 0; ph < NPH; ++ph) {
        p.ph_lo = ph; p.ph_hi = ph + 1;
        hipLaunchKernelGGL(mega_fwd, dim3(grid), dim3(512), LDS_BYTES, stream, p);
    }
#endif
}
#ifdef TESTK
__global__ __launch_bounds__(512, 2) void tk(const bf16_t* A, const bf16_t* B, float* MOD, const float* bias) {
    extern __shared__ __attribute__((aligned(16))) unsigned char shm2[];
    pg8::StaticOrder S; S.init(256, 12288, 1024, gridDim.x, blockIdx.x, true);
    pg8::Gemm g{A, B, 256, 12288, 1024}; EpiMod E{MOD, bias};
    pg8::gemm_phase((LAS unsigned char*)shm2, g, S, E);
}
#endif
```

```cpp
#include <hip/hip_runtime.h>
#include <hip/hip_cooperative_groups.h>
#include <cstdio>
#include <cmath>
namespace cg = cooperative_groups;

#define LAS __attribute__((address_space(3)))
typedef unsigned short bf16_t;
typedef short bf16x8 __attribute__((ext_vector_type(8)));
typedef float f32x4 __attribute__((ext_vector_type(4)));
typedef float f32x2 __attribute__((ext_vector_type(2)));
typedef unsigned u32x4 __attribute__((ext_vector_type(4)));
typedef unsigned u32x2 __attribute__((ext_vector_type(2)));

#ifndef ONE_LAUNCH
#define ONE_LAUNCH 1
#endif

constexpr int NPR = 16384, NSM = 1024, MT = 17408;
constexpr int NPH = 18;
constexpr size_t O_Y = 0;
constexpr size_t O_NKP = 17825792, O_NVP = 17956864, O_NCP = 18087936, O_NKS = 18178048, O_NVS = 18440192, O_NGS = 18702336, O_NCS = 19750912;
constexpr size_t W_ADA = 0;
constexpr size_t W_IN = W_ADA + 12288ull * 1024 * 2;
constexpr size_t W_OUT = W_IN + 2ull * 1792 * 1024 * 2;
constexpr size_t W_FIN = W_OUT + 2ull * 1024 * 1024 * 2;
constexpr size_t W_FOUT = W_FIN + 2ull * 5632 * 1024 * 2;
constexpr size_t W_CS = W_FOUT + 2ull * 1024 * 2816 * 2;
constexpr size_t W_MOD = W_CS + 256ull * 1024 * 2;
constexpr size_t W_ROPE = W_MOD + 132ull * 12288 * 4;
constexpr size_t W_WS = W_ROPE + 4104ull * 16 * 4;
constexpr size_t W_H = W_WS + 2ull * 4 * 128 * 128 * 2;
constexpr size_t W_R = W_H + (size_t)MT * 1024 * 2;
constexpr size_t W_Q = W_R;
constexpr size_t W_KB = W_Q + (size_t)MT * 512 * 2;
constexpr size_t W_VB = W_KB + (size_t)MT * 128 * 2;
constexpr size_t W_U = W_VB + (size_t)MT * 128 * 2;
constexpr size_t W_VG = W_U + (size_t)MT * 512 * 2;
constexpr size_t W_MIX = W_VG + (size_t)MT * 512 * 2;
constexpr size_t W_HALO = W_R + (size_t)MT * 2816 * 2;
constexpr size_t W_XB = W_HALO + 256ull * 4 * 5632 * 2;
constexpr size_t W_BAR = W_XB + (size_t)MT * 1024 * 2;
constexpr size_t W_END = W_BAR + 32768;

constexpr int LDS_STAGE = 131072, LDS_MISC = LDS_STAGE + 8192, LDS_BYTES = LDS_MISC + 16;

struct Params {
    const float* in[24];
    float* out;
    unsigned char* ws;
    double inv[8];
    int ph_lo, ph_hi;
};

__device__ __forceinline__ unsigned cvt_pk_bf16(float lo, float hi) { unsigned r; asm volatile("v_cvt_pk_bf16_f32 %0, %1, %2" : "=v"(r) : "v"(lo), "v"(hi)); return r; }
__device__ __forceinline__ unsigned cvt_pk_bf16_mfma(float lo, float hi) { unsigned r; asm volatile("s_nop 7\n\ts_nop 7\n\tv_cvt_pk_bf16_f32 %0, %1, %2" : "=v"(r) : "v"(lo), "v"(hi)); return r; }
__device__ __forceinline__ float bf2f(bf16_t b) { return __uint_as_float(((unsigned)b) << 16); }
__device__ __forceinline__ float fast_exp(float x) { return __builtin_amdgcn_exp2f(x * 1.4426950408889634f); }
__device__ __forceinline__ float silu_f(float x) { return x * __builtin_amdgcn_rcpf(1.0f + fast_exp(-x)); }
__device__ __forceinline__ float gelu_f(float x) { const float a = x * __builtin_fmaf(x * x, -0.10294324f, -2.3022082f); return x * __builtin_amdgcn_rcpf(1.0f + __builtin_amdgcn_exp2f(a)); }
template <int CTRL> __device__ __forceinline__ float dppf(float x) { return __builtin_bit_cast(float, __builtin_amdgcn_update_dpp(0, __builtin_bit_cast(int, x), CTRL, 0xf, 0xf, false)); }
template <int N> __device__ __forceinline__ f32x4 ror4(f32x4 v) { f32x4 r; r[0] = dppf<0x120 + N>(v[0]); r[1] = dppf<0x120 + N>(v[1]); r[2] = dppf<0x120 + N>(v[2]); r[3] = dppf<0x120 + N>(v[3]); return r; }
__device__ __forceinline__ float xsum_fq(float v) { v += __shfl_xor(v, 16); v += __shfl_xor(v, 32); return v; }
__device__ __forceinline__ float xmax_fq(float v) { v = fmaxf(v, __shfl_xor(v, 16)); v = fmaxf(v, __shfl_xor(v, 32)); return v; }
__device__ __forceinline__ u32x2 pack4(f32x4 v) { u32x2 w; w.x = cvt_pk_bf16(v[0], v[1]); w.y = cvt_pk_bf16(v[2], v[3]); return w; }
__device__ __forceinline__ u32x2 pack4_mfma(f32x4 v) { u32x2 w; w.x = cvt_pk_bf16_mfma(v[0], v[1]); w.y = cvt_pk_bf16(v[2], v[3]); return w; }
__device__ __forceinline__ u32x4 pack8(f32x4 a, f32x4 b) { u32x4 w; w.x = cvt_pk_bf16(a[0], a[1]); w.y = cvt_pk_bf16(a[2], a[3]); w.z = cvt_pk_bf16(b[0], b[1]); w.w = cvt_pk_bf16(b[2], b[3]); return w; }

__device__ __forceinline__ int tid_opaque() { int t = threadIdx.x; asm volatile("" : "+v"(t)); return t; }

namespace pg8 {
constexpr int BM = 256, BK = 64, HALF = 128, HTB = HALF * BK * 2, NXCD = 8, WGM = 8;
__device__ __forceinline__ int lds_byte(int r, int c) { const int st = (r >> 4) * 2 + (c >> 5), rr = r & 15, cc = c & 31, ob = rr * 64 + cc * 2; return st * 1024 + (ob ^ (((ob >> 9) & 1) << 5)); }
__device__ __forceinline__ void stage_rc(int b, int& R, int& C) { const int st = b / 1024, sb = b % 1024, swz = sb ^ (((sb >> 9) & 1) << 5); R = (st >> 1) * 16 + swz / 64; C = (st & 1) * 32 + (swz % 64) / 2; }
__device__ __forceinline__ int perm32(int rho) { const int n = rho >> 4, i = rho & 15; return 8 * (i >> 2) + 4 * n + (i & 3); }
struct Unit { int pm, pn, k0, nk, split, tl, S; };
struct Gemm { const bf16_t* A; const bf16_t* Bt; int M, N, K; };
struct StaticOrder {
    int nM, nN, nwg, G, c, R, Lf, S, nt, heavy_first, reverse;
    __device__ __forceinline__ void init(int M, int N, int K, int G_, int c_, bool allow_split) {
        nM = M / BM; nN = N / BM; nwg = nM * nN; G = G_; c = c_; nt = K / BK; heavy_first = 0; reverse = 0;
        R = nwg / G; Lf = nwg - R * G; S = 1;
        if (allow_split && Lf > 0 && Lf * 2 <= G) { int smax = G / Lf; int s = nt / 4; while (s > 1 && (s > smax || nt % (2 * s) != 0)) --s; S = s; }
    }
    __device__ __forceinline__ void tile_pmpn(int L, Unit& u) const {
        int wgid = L; if (reverse) { const int xq = L % NXCD, xo = L / NXCD; const int cnt = nwg / NXCD + (xq < nwg % NXCD ? 1 : 0); wgid = xq + (cnt - 1 - xo) * NXCD; }
        { const int q = nwg / NXCD, r = nwg % NXCD, xcd = wgid % NXCD, off = wgid / NXCD; wgid = (xcd < r ? xcd * (q + 1) : r * (q + 1) + (xcd - r) * q) + off; }
        const int nig = WGM * nN, gid = wgid / nig, fm = gid * WGM, gsz = (nM - fm) < WGM ? (nM - fm) : WGM;
        u.pm = fm + ((wgid % nig) % gsz); u.pn = (wgid % nig) / gsz;
        if (heavy_first) { const int q = u.pn; u.pn = q < 2 ? 5 + q : (q < 4 ? 1 + q : q - 4); }
    }
    __device__ __forceinline__ bool next(int i, Unit& u) const {
        int L = 0, k0 = 0, nk = nt, split = 0, tl = 0; bool ok = false;
        if (i < R) { L = i * G + c; ok = true; }
        else if (i == R && S == 1) { L = R * G + c; ok = c < Lf; }
        else if (i == R) { tl = c % Lf; L = R * G + tl; nk = nt / S; k0 = (c / Lf) * nk; split = 1; ok = c < Lf * S; }
        if (!ok) L = 0;
        Unit t; tile_pmpn(L, t);
        u.pm = t.pm; u.pn = t.pn; u.k0 = k0; u.nk = nk; u.split = split; u.tl = tl; u.S = S;
        return ok;
    }
};

template <class Epi>
__device__ __forceinline__ void gemm_phase(LAS unsigned char* lds, const Gemm g, const StaticOrder& S, const Epi& E) {
    const int tid = tid_opaque(), wid = __builtin_amdgcn_readfirstlane(tid >> 6), lane = tid & 63, wr = wid >> 2, wc = wid & 3, fr = lane & 15, fq = lane >> 4;
    const int K = g.K;
    unsigned voffA[2], voffB[2];
#pragma unroll
    for (int i = 0; i < 2; ++i) { int R, C; stage_rc(tid * 16 + i * 8192, R, C); const int Rb = Epi::PERM ? ((R & ~31) + perm32(R & 31)) : R;
        const int Ra = Epi::APERM ? ((R & 64) | ((R & 15) << 2) | ((R >> 4) & 3)) : R;
        voffA[i] = (unsigned)(Ra * K + C) * 2u; voffB[i] = (unsigned)(Rb * K + C) * 2u; }
    const size_t kstep = (size_t)(BK * 2);
    const size_t hstep = (size_t)HALF * K * 2;
    const size_t tstep = 2 * hstep;
    const unsigned ldsw = (unsigned)wid * 1024u;
    const int aoff = lds_byte(wr * 64 + fr, fq * 8), boff = lds_byte(wc * 32 + fr, fq * 8);
#define PG8_SA(b, h) (((b) * 2 + (h)) * HTB)
#define PG8_SB(b, h) ((4 + (b) * 2 + (h)) * HTB)
#define PG8_STAGE(bufoff, gbase, voff) do { _Pragma("unroll") for (int _i = 0; _i < 2; ++_i) \
        __builtin_amdgcn_global_load_lds((const unsigned*)((const char*)(gbase) + (voff)[_i]), (LAS unsigned*)(lds + (bufoff) + ldsw + _i * 8192), 16, 0, 0); } while (0)
#define PG8_LDA(dst, b, h) do { _Pragma("unroll") for (int m = 0; m < 4; ++m) _Pragma("unroll") for (int k = 0; k < 2; ++k) dst[m][k] = *(const LAS bf16x8*)(lds + PG8_SA(b, h) + aoff + m * 2048 + k * 1024); } while (0)
#define PG8_LDB(dst, b, h) do { _Pragma("unroll") for (int n = 0; n < 2; ++n) _Pragma("unroll") for (int k = 0; k < 2; ++k) dst[n][k] = *(const LAS bf16x8*)(lds + PG8_SB(b, h) + boff + n * 2048 + k * 1024); } while (0)
#define PG8_MMA(ai, bj, At, Bt) do { __builtin_amdgcn_s_setprio(1); _Pragma("unroll") for (int m = 0; m < 4; ++m) _Pragma("unroll") for (int n = 0; n < 2; ++n) _Pragma("unroll") for (int k = 0; k < 2; ++k) \
        acc[ai][bj][m][n] = __builtin_amdgcn_mfma_f32_16x16x32_bf16(Bt[n][k], At[m][k], acc[ai][bj][m][n], 0, 0, 0); __builtin_amdgcn_s_setprio(0); } while (0)
#define PG8_WAIT_V(n) asm volatile("s_waitcnt vmcnt(" #n ")" ::: "memory")
#define PG8_WAIT_L(n) asm volatile("s_waitcnt lgkmcnt(" #n ")" ::: "memory")
#define PG8_BAR __builtin_amdgcn_s_barrier()
#define PG8_SCHED __builtin_amdgcn_sched_barrier(0)
    Unit cur, nxt; int ui = 0;
    if (!S.next(0, cur)) return;
    f32x4 acc[2][2][4][2];
#pragma unroll
    for (int a = 0; a < 2; ++a)
#pragma unroll
        for (int b = 0; b < 2; ++b)
#pragma unroll
            for (int m = 0; m < 4; ++m)
#pragma unroll
                for (int n = 0; n < 2; ++n) acc[a][b][m][n] = (f32x4){0.f, 0.f, 0.f, 0.f};
    bf16x8 At[4][2], B0[2][2], B1[2][2];
    const char* cA = (const char*)g.A + (size_t)cur.pm * tstep + (size_t)cur.k0 * kstep; const char* cB = (const char*)g.Bt + (size_t)cur.pn * tstep + (size_t)cur.k0 * kstep;
    PG8_STAGE(PG8_SB(0, 0), cB, voffB); PG8_STAGE(PG8_SB(0, 1), cB + hstep, voffB); PG8_STAGE(PG8_SA(0, 0), cA, voffA); PG8_STAGE(PG8_SA(0, 1), cA + hstep, voffA);
    if (wr == 1) PG8_BAR;
    PG8_WAIT_V(2); PG8_BAR;
    PG8_STAGE(PG8_SB(1, 0), cB + kstep, voffB); PG8_STAGE(PG8_SA(1, 0), cA + kstep, voffA); PG8_STAGE(PG8_SB(1, 1), cB + hstep + kstep, voffB);
    PG8_WAIT_V(6); PG8_BAR;
    for (;;) {
        const bool has_next = S.next(ui + 1, nxt);
        const char* nA = has_next ? (const char*)g.A + (size_t)nxt.pm * tstep + (size_t)nxt.k0 * kstep : cA; const char* nB = has_next ? (const char*)g.Bt + (size_t)nxt.pn * tstep + (size_t)nxt.k0 * kstep : cB;
        const int nt = cur.nk;
        for (int t = 0; t < nt; t += 2) {
            const bool last = (t == nt - 2);
            const char* a1 = cA + (size_t)(t + 1) * kstep;
            const char* a2 = last ? nA : cA + (size_t)(t + 2) * kstep; const char* b2 = last ? nB : cB + (size_t)(t + 2) * kstep;
            const char* a3 = a2 + kstep; const char* b3 = b2 + kstep;
            PG8_LDB(B0, 0, 0); PG8_LDB(B1, 0, 1); PG8_SCHED; PG8_LDA(At, 0, 0); PG8_STAGE(PG8_SA(1, 1), a1 + hstep, voffA);
            PG8_WAIT_V(8); PG8_WAIT_L(0); PG8_BAR; PG8_MMA(0, 0, At, B0); PG8_MMA(0, 1, At, B1); PG8_BAR; PG8_SCHED;
            PG8_LDA(At, 0, 1); PG8_STAGE(PG8_SB(0, 0), b2, voffB); PG8_STAGE(PG8_SB(0, 1), b2 + hstep, voffB); PG8_STAGE(PG8_SA(0, 0), a2, voffA);
            PG8_WAIT_V(8); PG8_WAIT_L(0); PG8_BAR; PG8_MMA(1, 0, At, B0); PG8_MMA(1, 1, At, B1); PG8_BAR; PG8_SCHED;
            PG8_LDB(B0, 1, 0); PG8_LDB(B1, 1, 1); PG8_SCHED; PG8_LDA(At, 1, 0); PG8_STAGE(PG8_SA(0, 1), a2 + hstep, voffA);
            PG8_WAIT_V(8); PG8_WAIT_L(0); PG8_BAR; PG8_MMA(0, 0, At, B0); PG8_MMA(0, 1, At, B1); PG8_BAR; PG8_SCHED;
            PG8_LDA(At, 1, 1); PG8_STAGE(PG8_SB(1, 0), b3, voffB); PG8_STAGE(PG8_SB(1, 1), b3 + hstep, voffB); PG8_STAGE(PG8_SA(1, 0), a3, voffA);
            PG8_WAIT_V(8); PG8_WAIT_L(0); PG8_BAR; PG8_MMA(1, 0, At, B0); PG8_MMA(1, 1, At, B1); PG8_BAR; PG8_SCHED;
        }
        if (wr == 0) PG8_BAR;
        if (!(Epi::CAN_SPLIT && cur.split)) E(acc, cur, wr, wc, fr, fq, lds + LDS_STAGE, wid);
        if (!has_next) break;
#pragma unroll
        for (int a = 0; a < 2; ++a)
#pragma unroll
            for (int b = 0; b < 2; ++b)
#pragma unroll
                for (int m = 0; m < 4; ++m)
#pragma unroll
                    for (int n = 0; n < 2; ++n) acc[a][b][m][n] = (f32x4){0.f, 0.f, 0.f, 0.f};
        cur = nxt; cA = nA; cB = nB; ++ui;
        if (wr == 1) PG8_BAR;
    }
    PG8_WAIT_V(0);
    PG8_BAR;
    if (Epi::CAN_SPLIT && cur.split) E(acc, cur, wr, wc, fr, fq, lds + LDS_STAGE, wid);
#undef PG8_SA
#undef PG8_SB
#undef PG8_STAGE
#undef PG8_LDA
#undef PG8_LDB
#undef PG8_MMA
#undef PG8_WAIT_V
#undef PG8_WAIT_L
#undef PG8_BAR
#undef PG8_SCHED
}
}
using pg8::Unit;

struct EpiMod {
    static constexpr bool PERM = false, CAN_SPLIT = false, APERM = false;
    float* MOD; const float* bias;
    __device__ __forceinline__ void operator()(const f32x4 (&acc)[2][2][4][2], const Unit& u, int wr, int wc, int fr, int fq, LAS unsigned char*, int) const {
        const int col0 = u.pn * 256 + wc * 32 + 4 * fq;
#pragma unroll
        for (int ai = 0; ai < 2; ++ai)
#pragma unroll
            for (int m = 0; m < 4; ++m) {
                const int r = ai * 128 + wr * 64 + m * 16 + fr;
                if (r < 132) {
#pragma unroll
                    for (int bj = 0; bj < 2; ++bj)
#pragma unroll
                        for (int n = 0; n < 2; ++n) { const int c = col0 + bj * 128 + n * 16; *(f32x4*)(MOD + (size_t)r * 12288 + c) = acc[ai][bj][m][n] + *(const f32x4*)(bias + c); }
                }
            }
    }
};

__device__ __forceinline__ f32x4 unpack4(u32x2 w) { f32x4 v; v[0] = __uint_as_float(w.x << 16); v[1] = __uint_as_float(w.x & 0xffff0000u); v[2] = __uint_as_float(w.y << 16); v[3] = __uint_as_float(w.y & 0xffff0000u); return v; }
template <bool INB, bool OUTB>
struct EpiRes {
    static constexpr bool PERM = false, CAN_SPLIT = true, APERM = false;
    const float* xin_p; const float* xin_s; const bf16_t* xin_b; float* xo_f; bf16_t* xo_b; const float* gate;
    unsigned char* ws; unsigned* ticket;
    __device__ __forceinline__ float* slab(int idx) const { return (float*)(idx < 136 ? ws + W_H + (size_t)idx * 262144 : ws + W_ADA + (size_t)(idx - 136) * 262144); }
    __device__ __forceinline__ f32x4 ldx(int r, int c) const {
        if (INB) return unpack4(*(const u32x2*)(xin_b + (size_t)r * 1024 + c));
        return *(const f32x4*)((r < NPR ? xin_p + (size_t)r * 1024 : xin_s + (size_t)(r - NPR) * 1024) + c);
    }
    __device__ __forceinline__ void stx(int r, int c, f32x4 v) const {
        if (OUTB) *(u32x2*)(xo_b + (size_t)r * 1024 + c) = pack4(v); else *(f32x4*)(xo_f + (size_t)r * 1024 + c) = v;
    }
    __device__ __forceinline__ void operator()(const f32x4 (&acc)[2][2][4][2], const Unit& u, int wr, int wc, int fr, int fq, LAS unsigned char*, int wid) const {
        const bool prompt = u.pm < 64;
        const int col0 = u.pn * 256 + wc * 32 + 4 * fq;
        if (!u.split) {
            f32x4 gu[2][2];
            if (prompt) {
#pragma unroll
                for (int bj = 0; bj < 2; ++bj)
#pragma unroll
                    for (int n = 0; n < 2; ++n) gu[bj][n] = *(const f32x4*)(gate + (size_t)(u.pm >> 4) * 12288 + col0 + bj * 128 + n * 16);
            }
            if (INB && prompt) {
                u32x2 xr[2][4][2][2];
#pragma unroll
                for (int ai = 0; ai < 2; ++ai)
#pragma unroll
                    for (int m = 0; m < 4; ++m) { const int r = u.pm * 256 + ai * 128 + wr * 64 + m * 16 + fr;
#pragma unroll
                        for (int bj = 0; bj < 2; ++bj)
#pragma unroll
                            for (int n = 0; n < 2; ++n) xr[ai][m][bj][n] = *(const u32x2*)(xin_b + (size_t)r * 1024 + col0 + bj * 128 + n * 16); }
#pragma unroll
                for (int ai = 0; ai < 2; ++ai)
#pragma unroll
                    for (int m = 0; m < 4; ++m) { const int r = u.pm * 256 + ai * 128 + wr * 64 + m * 16 + fr;
#pragma unroll
                        for (int bj = 0; bj < 2; ++bj)
#pragma unroll
                            for (int n = 0; n < 2; ++n) stx(r, col0 + bj * 128 + n * 16, unpack4(xr[ai][m][bj][n]) + gu[bj][n] * acc[ai][bj][m][n]); }
            } else {
            constexpr int MB = 2;
#pragma unroll
            for (int ai = 0; ai < 2; ++ai)
#pragma unroll
                for (int mb = 0; mb < 4; mb += MB) {
                    u32x2 xr[MB][2][2]; f32x4 xf[INB ? 1 : MB][2][2];
#pragma unroll
                    for (int m = 0; m < MB; ++m) { const int r = u.pm * 256 + ai * 128 + wr * 64 + (mb + m) * 16 + fr;
#pragma unroll
                        for (int bj = 0; bj < 2; ++bj)
#pragma unroll
                            for (int n = 0; n < 2; ++n) { const int c = col0 + bj * 128 + n * 16;
                                if (INB) xr[m][bj][n] = *(const u32x2*)(xin_b + (size_t)r * 1024 + c);
                                else xf[INB ? 0 : m][bj][n] = *(const f32x4*)((r < NPR ? xin_p + (size_t)r * 1024 : xin_s + (size_t)(r - NPR) * 1024) + c); } }
                    f32x4 gs[MB][2][2];
                    if (!prompt) {
#pragma unroll
                        for (int m = 0; m < MB; ++m) { const int r = u.pm * 256 + ai * 128 + wr * 64 + (mb + m) * 16 + fr; const float* gp = gate + (size_t)(4 + ((r - NPR) >> 3)) * 12288;
#pragma unroll
                            for (int bj = 0; bj < 2; ++bj)
#pragma unroll
                                for (int n = 0; n < 2; ++n) gs[m][bj][n] = *(const f32x4*)(gp + col0 + bj * 128 + n * 16); }
                    }
#pragma unroll
                    for (int m = 0; m < MB; ++m) { const int r = u.pm * 256 + ai * 128 + wr * 64 + (mb + m) * 16 + fr;
#pragma unroll
                        for (int bj = 0; bj < 2; ++bj)
#pragma unroll
                            for (int n = 0; n < 2; ++n) { const f32x4 x0 = INB ? unpack4(xr[m][bj][n]) : xf[INB ? 0 : m][bj][n];
                                const f32x4 gg = prompt ? gu[bj][n] : gs[m][bj][n];
                                stx(r, col0 + bj * 128 + n * 16, x0 + gg * acc[ai][bj][mb + m][n]); } }
                }
            }
        } else {
            __amdgpu_buffer_rsrc_t srs = __builtin_amdgcn_make_buffer_rsrc((void*)slab(u.tl * u.S + u.k0 / u.nk), 0, 262144, 0x00020000);
            const unsigned soff = (unsigned)(wc * 32 + 4 * fq) * 4u;
#pragma unroll
            for (int ai = 0; ai < 2; ++ai)
#pragma unroll
                for (int m = 0; m < 4; ++m) {
                    const int rl = ai * 128 + wr * 64 + m * 16 + fr;
                    const int r = u.pm * 256 + rl;
                    const int mrow = prompt ? (r >> 12) : 4 + ((r - NPR) >> 3);
                    const float* gp = gate + (size_t)mrow * 12288;
#pragma unroll
                    for (int bj = 0; bj < 2; ++bj)
#pragma unroll
                        for (int n = 0; n < 2; ++n) { const int c = col0 + bj * 128 + n * 16;
                            const f32x4 d = *(const f32x4*)(gp + c) * acc[ai][bj][m][n];
                            __builtin_amdgcn_raw_buffer_store_b128(__builtin_bit_cast(u32x4, d), srs, soff + (unsigned)(rl * 256 + bj * 128 + n * 16) * 4u, 0, 16); }
                }
        }
        if (u.split) {
            const int lane = fq * 16 + fr;
            asm volatile("s_waitcnt vmcnt(0)" ::: "memory");
            __syncthreads();
            if (threadIdx.x == 0) {
                unsigned* tk = ticket + u.tl;
                const unsigned need = (unsigned)u.S;
                __hip_atomic_fetch_add(tk, 1u, __ATOMIC_RELAXED, __HIP_MEMORY_SCOPE_AGENT);
                unsigned sp = 0;
                while (__hip_atomic_load(tk, __ATOMIC_RELAXED, __HIP_MEMORY_SCOPE_AGENT) < need) { __builtin_amdgcn_s_sleep(2); if (++sp > (1u << 19)) break; }
                __builtin_amdgcn_fence(__ATOMIC_ACQUIRE, "agent");
                asm volatile("s_waitcnt vmcnt(0)" ::: "memory");
            }
            __syncthreads();
            const int w = (u.k0 / u.nk) * 8 + wid, nw = 8 * u.S;
            for (int vb = w * 64 + lane; vb < 16384; vb += 8 * nw * 64) {
                f32x4 tot[8];
#pragma unroll
                for (int k = 0; k < 8; ++k) {
                    const int v = vb + k * nw * 64;
                    if (v < 16384) {
                        const int r = u.pm * 256 + (v >> 6), c = u.pn * 256 + (v & 63) * 4;
                        f32x4 s0 = ldx(r, c), s1 = (f32x4){0.f, 0.f, 0.f, 0.f}, s2 = s1, s3 = s1;
                        int q = 0;
                        for (; q + 4 <= u.S; q += 4) {
                            const f32x4 a0 = *(const f32x4*)(slab(u.tl * u.S + q) + (size_t)v * 4), a1 = *(const f32x4*)(slab(u.tl * u.S + q + 1) + (size_t)v * 4);
                            const f32x4 a2 = *(const f32x4*)(slab(u.tl * u.S + q + 2) + (size_t)v * 4), a3 = *(const f32x4*)(slab(u.tl * u.S + q + 3) + (size_t)v * 4);
                            s0 += a0; s1 += a1; s2 += a2; s3 += a3; }
                        for (; q < u.S; ++q) s1 += *(const f32x4*)(slab(u.tl * u.S + q) + (size_t)v * 4);
                        tot[k] = (s0 + s1) + (s2 + s3);
                    }
                }
#pragma unroll
                for (int k = 0; k < 8; ++k) {
                    const int v = vb + k * nw * 64;
                    if (v < 16384) stx(u.pm * 256 + (v >> 6), u.pn * 256 + (v & 63) * 4, tot[k]);
                }
            }
        }
    }
};

struct EpiIn {
    static constexpr bool PERM = true, CAN_SPLIT = false, APERM = false;
    int layer;
    const float* gq; const float* gk; const float* lng; const float* lnb; const float* rope;
    bf16_t* Q; bf16_t* KB; bf16_t* VB; bf16_t* U; bf16_t* VG; float* out;
    __device__ __forceinline__ void operator()(const f32x4 (&acc)[2][2][4][2], const Unit& u, int wr, int wc, int fr, int fq, LAS unsigned char* ex, int wid) const {
        const int pn = u.pn;
        const bool prompt = u.pm < 64;
        const int rbase = u.pm * 256 + wr * 64 + fr;
        const int dq = 8 * fq;
        if (false) {}
#ifndef NOQK
        else if (pn < 2 || (pn == 2 && wc < 2)) {
            const bool isk = (pn == 2);
            const float* g = isk ? gk : gq;
            f32x4 gv[2][2];
#pragma unroll
            for (int bj = 0; bj < 2; ++bj)
#pragma unroll
                for (int n = 0; n < 2; ++n) gv[bj][n] = *(const f32x4*)(g + bj * 32 + dq + 4 * n);
#pragma unroll
            for (int ai = 0; ai < 2; ++ai)
#pragma unroll
              for (int mb = 0; mb < 4; mb += 4) {
                f32x4 rcs[4][2], rsn[4][2];
#pragma unroll
                for (int mm = 0; mm < 4; ++mm) { const int r = rbase + ai * 128 + (mb + mm) * 16; const float* rp = rope + (prompt ? (r & 4095) : 4096 + (r & 7)) * 16;
#pragma unroll
                    for (int n = 0; n < 2; ++n) { rcs[mm][n] = *(const f32x4*)(rp + 4 * n); rsn[mm][n] = *(const f32x4*)(rp + 8 + 4 * n); } }
#pragma unroll
                for (int mm = 0; mm < 4; ++mm) {
                    const int m = mb + mm;
                    const int r = rbase + ai * 128 + m * 16;
                    float ss = 0.f;
#pragma unroll
                    for (int bj = 0; bj < 2; ++bj)
#pragma unroll
                        for (int n = 0; n < 2; ++n) { const f32x4 v = acc[ai][bj][m][n]; ss += v[0] * v[0] + v[1] * v[1] + v[2] * v[2] + v[3] * v[3]; }
                    ss = xsum_fq(ss);
                    const float rs = rsqrtf(ss * (1.0f / 64.0f) + 1e-6f);
                    f32x4 y[2][2];
#pragma unroll
                    for (int bj = 0; bj < 2; ++bj)
#pragma unroll
                        for (int n = 0; n < 2; ++n) y[bj][n] = acc[ai][bj][m][n] * rs * gv[bj][n];
#pragma unroll
                    for (int n = 0; n < 2; ++n) {
                        const f32x4 cs = rcs[mm][n], sn = rsn[mm][n];
#pragma unroll
                        for (int e = 0; e < 4; ++e) {
                            const float own = y[0][n][e];
                            const float oth = __shfl_xor(own, 16);
                            const float rot = (fq == 0) ? own * cs[e] - oth * sn[e] : own * cs[e] + oth * sn[e];
                            y[0][n][e] = (fq < 2) ? rot : own;
                        }
                    }
                    if (!isk) {
                        bf16_t* qp = Q + (size_t)r * 512 + (pn * 4 + wc) * 64 + dq;
                        *(u32x4*)(qp) = pack8(y[0][0], y[0][1]); *(u32x4*)(qp + 32) = pack8(y[1][0], y[1][1]);
                    } else {
                        bf16_t* kp = KB + (size_t)r * 128 + wc * 64 + dq;
                        *(u32x4*)(kp) = pack8(y[0][0], y[0][1]); *(u32x4*)(kp + 32) = pack8(y[1][0], y[1][1]);
                        float* op = nullptr;
                        if (!prompt) op = out + O_NKS + ((size_t)layer * 1024 + (r - NPR)) * 128;
                        else if ((r & 4095) >= 3968) op = out + O_NKP + (((size_t)layer * 4 + (r >> 12)) * 128 + ((r & 4095) - 3968)) * 128;
                        if (op) { op += wc * 64 + dq;
                            *(f32x4*)(op) = y[0][0]; *(f32x4*)(op + 4) = y[0][1]; *(f32x4*)(op + 32) = y[1][0]; *(f32x4*)(op + 36) = y[1][1]; }
                    }
                }
            }
        }
#endif
#ifndef NOV
        else if (pn == 2) {
#pragma unroll
            for (int ai = 0; ai < 2; ++ai)
#pragma unroll
                for (int m = 0; m < 4; ++m) {
                    const int r = rbase + ai * 128 + m * 16;
                    bf16_t* vp = VB + (size_t)r * 128 + (wc - 2) * 64 + dq;
                    *(u32x4*)(vp) = pack8(acc[ai][0][m][0], acc[ai][0][m][1]); *(u32x4*)(vp + 32) = pack8(acc[ai][1][m][0], acc[ai][1][m][1]);
                    float* op = nullptr;
                    if (!prompt) op = out + O_NVS + ((size_t)layer * 1024 + (r - NPR)) * 128;
                    else if ((r & 4095) >= 3968) op = out + O_NVP + (((size_t)layer * 4 + (r >> 12)) * 128 + ((r & 4095) - 3968)) * 128;
                    if (op) { op += (wc - 2) * 64 + dq;
                        *(f32x4*)(op) = acc[ai][0][m][0]; *(f32x4*)(op + 4) = acc[ai][0][m][1]; *(f32x4*)(op + 32) = acc[ai][1][m][0]; *(f32x4*)(op + 36) = acc[ai][1][m][1]; }
                }
        }
#endif
#ifndef NOU
        else if (pn < 5) {
#pragma unroll
            for (int ai = 0; ai < 2; ++ai)
#pragma unroll
                for (int m = 0; m < 4; ++m) {
                    const int r = rbase + ai * 128 + m * 16;
                    f32x4 y[2][2];
#pragma unroll
                    for (int bj = 0; bj < 2; ++bj)
#pragma unroll
                        for (int n = 0; n < 2; ++n)
#pragma unroll
                            for (int e = 0; e < 4; ++e) y[bj][n][e] = gelu_f(acc[ai][bj][m][n][e]);
                    bf16_t* up = U + (size_t)r * 512 + (pn - 3) * 256 + wc * 64 + dq;
                    *(u32x4*)(up) = pack8(y[0][0], y[0][1]); *(u32x4*)(up + 32) = pack8(y[1][0], y[1][1]);
                }
        }
#endif
#ifndef NOLN
        else {
            LAS f32x2* exo = (LAS f32x2*)ex + wid * 128 + fr;
            LAS f32x2* exp_ = (LAS f32x2*)ex + (wid ^ 1) * 128 + fr;
#pragma unroll
            for (int ai = 0; ai < 2; ++ai)
#pragma unroll
                for (int m = 0; m < 4; ++m) {
                    float a = 0.f, b = 0.f;
#pragma unroll
                    for (int bj = 0; bj < 2; ++bj)
#pragma unroll
                        for (int n = 0; n < 2; ++n)
#pragma unroll
                            for (int e = 0; e < 4; ++e) { const float gl = gelu_f(acc[ai][bj][m][n][e]); a += gl; b += gl * gl; }
                    a = xsum_fq(a); b = xsum_fq(b);
                    if (fq == 0) exo[(ai * 4 + m) * 16] = (f32x2){a, b};
                }
            asm volatile("s_waitcnt lgkmcnt(0)" ::: "memory");
            __builtin_amdgcn_s_barrier();
            asm volatile("" ::: "memory");
            const int grp = (pn - 5) * 2 + (wc >> 1);
            const int w0 = (wc & 1) * 64 + dq;
            f32x4 lgv[2][2], lbv[2][2];
#pragma unroll
            for (int bj = 0; bj < 2; ++bj)
#pragma unroll
                for (int n = 0; n < 2; ++n) { lgv[bj][n] = *(const f32x4*)(lng + grp * 128 + w0 + bj * 32 + 4 * n); lbv[bj][n] = *(const f32x4*)(lnb + grp * 128 + w0 + bj * 32 + 4 * n); }
#pragma unroll
            for (int ai = 0; ai < 2; ++ai)
#pragma unroll
                for (int m = 0; m < 4; ++m) {
                    const int r = rbase + ai * 128 + m * 16;
                    const f32x2 o0 = exo[(ai * 4 + m) * 16];
                    const f32x2 o1 = exp_[(ai * 4 + m) * 16];
                    const float mean = (o0.x + o1.x) * (1.0f / 128.0f);
                    const float var = fmaxf((o0.y + o1.y) * (1.0f / 128.0f) - mean * mean, 0.f);
                    const float rstd = rsqrtf(var + 1e-6f);
                    bf16_t* vp = VG + (size_t)r * 512 + grp * 128 + w0;
                    float* op = out + O_NGS + ((size_t)layer * 1024 + (r - NPR)) * 512 + grp * 128 + w0;
#pragma unroll
                    for (int bj = 0; bj < 2; ++bj) {
                        f32x4 g0, g1;
#pragma unroll
                        for (int e = 0; e < 4; ++e) { float x0 = acc[ai][bj][m][0][e], x1 = acc[ai][bj][m][1][e]; asm volatile("" : "+v"(x0), "+v"(x1)); g0[e] = gelu_f(x0); g1[e] = gelu_f(x1); }
                        const f32x4 y0 = (g0 - mean) * rstd * lgv[bj][0] + lbv[bj][0];
                        const f32x4 y1 = (g1 - mean) * rstd * lgv[bj][1] + lbv[bj][1];
                        *(u32x4*)(vp + bj * 32) = pack8(y0, y1);
                        if (!prompt) { *(f32x4*)(op + bj * 32) = y0; *(f32x4*)(op + bj * 32 + 4) = y1; }
                    }
                    asm volatile("" ::: "memory");
                }
        }
#endif
    }
};

struct EpiFfnIn {
    static constexpr bool PERM = true, CAN_SPLIT = false, APERM = true;
    const float* cw; const float* cb; const float* cc;
    bf16_t* ACT; bf16_t* HALO; float* ncs; float* ncp;
    __device__ __forceinline__ static f32x4 shr1(f32x4 v) { f32x4 r; r[0] = dppf<0x111>(v[0]); r[1] = dppf<0x111>(v[1]); r[2] = dppf<0x111>(v[2]); r[3] = dppf<0x111>(v[3]); return r; }
    __device__ __forceinline__ static f32x4 act4(f32x4 g, f32x4 u) { f32x4 a; a[0] = silu_f(g[0]) * u[0]; a[1] = silu_f(g[1]) * u[1]; a[2] = silu_f(g[2]) * u[2]; a[3] = silu_f(g[3]) * u[3]; return a; }
    __device__ __forceinline__ void operator()(const f32x4 (&acc)[2][2][4][2], const Unit& u, int wr, int wc, int fr, int fq, LAS unsigned char*, int) const {
        const bool prompt = u.pm < 64;
        const int gc0 = u.pn * 128 + wc * 32 + 8 * fq;
        u32x2 res[2][2][4];
#pragma unroll
        for (int n = 0; n < 2; ++n) {
            const int gc = gc0 + 4 * n;
            const f32x4 w0g = *(const f32x4*)(cw + gc), w1g = *(const f32x4*)(cw + 5632 + gc), w2g = *(const f32x4*)(cw + 11264 + gc), bg = *(const f32x4*)(cb + gc);
            const f32x4 w0u = *(const f32x4*)(cw + 2816 + gc), w1u = *(const f32x4*)(cw + 5632 + 2816 + gc), w2u = *(const f32x4*)(cw + 11264 + 2816 + gc), bu = *(const f32x4*)(cb + 2816 + gc);
#pragma unroll
            for (int ai = 0; ai < 2; ++ai) {
                const int r0 = u.pm * 256 + ai * 128 + wr * 64 + 4 * fr;
                const f32x4 g0 = acc[ai][0][0][n], g1 = acc[ai][0][1][n], g2 = acc[ai][0][2][n], g3 = acc[ai][0][3][n];
                const f32x4 u0 = acc[ai][1][0][n], u1 = acc[ai][1][1][n], u2 = acc[ai][1][2][n], u3 = acc[ai][1][3][n];
                f32x4 pg2 = shr1(g2), pg3 = shr1(g3), pu2 = shr1(u2), pu3 = shr1(u3);
                if (!prompt && (fr & 1) == 0) { const float* cp = cc + (size_t)((r0 - NPR) >> 3) * 2 * 5632;
                    pg2 = *(const f32x4*)(cp + gc); pg3 = *(const f32x4*)(cp + 5632 + gc); pu2 = *(const f32x4*)(cp + 2816 + gc); pu3 = *(const f32x4*)(cp + 5632 + 2816 + gc); }
                res[n][ai][0] = pack4(act4(bg + w0g * pg2 + w1g * pg3 + w2g * g0, bu + w0u * pu2 + w1u * pu3 + w2u * u0));
                res[n][ai][1] = pack4(act4(bg + w0g * pg3 + w1g * g0 + w2g * g1, bu + w0u * pu3 + w1u * u0 + w2u * u1));
                res[n][ai][2] = pack4(act4(bg + w0g * g0 + w1g * g1 + w2g * g2, bu + w0u * u0 + w1u * u1 + w2u * u2));
                res[n][ai][3] = pack4(act4(bg + w0g * g1 + w1g * g2 + w2g * g3, bu + w0u * u1 + w1u * u2 + w2u * u3));
            }
        }
#pragma unroll
        for (int ai = 0; ai < 2; ++ai) {
            const int r0 = u.pm * 256 + ai * 128 + wr * 64 + 4 * fr;
            bf16_t* ap = ACT + (size_t)r0 * 2816 + gc0;
#pragma unroll
            for (int m = 0; m < 4; ++m) *(u32x4*)(ap + m * 2816) = (u32x4){res[0][ai][m].x, res[0][ai][m].y, res[1][ai][m].x, res[1][ai][m].y};
#pragma unroll
            for (int n = 0; n < 2; ++n) {
                const int gc = gc0 + 4 * n;
                const f32x4 g0 = acc[ai][0][0][n], g1 = acc[ai][0][1][n], g2 = acc[ai][0][2][n], g3 = acc[ai][0][3][n];
                const f32x4 u0 = acc[ai][1][0][n], u1 = acc[ai][1][1][n], u2 = acc[ai][1][2][n], u3 = acc[ai][1][3][n];
                if (prompt) {
                    if (fr == 0) { bf16_t* hp = HALO + (size_t)(r0 >> 6) * 4 * 5632;
                        *(u32x2*)(hp + gc) = pack4(g0); *(u32x2*)(hp + 2816 + gc) = pack4(u0); *(u32x2*)(hp + 5632 + gc) = pack4(g1); *(u32x2*)(hp + 5632 + 2816 + gc) = pack4(u1); }
                    if (fr == 15) { bf16_t* hp = HALO + ((size_t)(r0 >> 6) * 4 + 2) * 5632;
                        *(u32x2*)(hp + gc) = pack4(g2); *(u32x2*)(hp + 2816 + gc) = pack4(u2); *(u32x2*)(hp + 5632 + gc) = pack4(g3); *(u32x2*)(hp + 5632 + 2816 + gc) = pack4(u3);
                        if ((r0 & 4095) == 4092) { float* op = ncp + (size_t)(r0 >> 12) * 2 * 5632;
                            *(f32x4*)(op + gc) = g2; *(f32x4*)(op + 2816 + gc) = u2; *(f32x4*)(op + 5632 + gc) = g3; *(f32x4*)(op + 5632 + 2816 + gc) = u3; } }
                } else if (fr & 1) { float* op = ncs + (size_t)((r0 - NPR) >> 3) * 2 * 5632;
                    *(f32x4*)(op + gc) = g2; *(f32x4*)(op + 2816 + gc) = u2; *(f32x4*)(op + 5632 + gc) = g3; *(f32x4*)(op + 5632 + 2816 + gc) = u3; }
            }
        }
    }
};

__device__ __forceinline__ int perm_row(int nn, int ptype) {
    if (ptype == 1) { const int pn = nn >> 8, j = nn & 255; return pn * 256 + ((j >> 5) & 1) * 128 + (j >> 6) * 32 + (j & 31); }
    if (ptype == 2) { const int h = nn >= 2816 ? 1 : 0, jj = nn - h * 2816; return (jj >> 7) * 256 + h * 128 + (jj & 127); }
    return nn;
}
struct ConvJob { const float* src; bf16_t* dst; int N, K, k0, n0, ptype; };
__device__ __forceinline__ void conv_load(const ConvJob& jb, int tid, f32x4 (&v)[8]) {
#pragma unroll
    for (int i = 0; i < 8; ++i) { const int idx = tid + i * 512, kk = idx >> 6, c4 = idx & 63; v[i] = *(const f32x4*)(jb.src + (size_t)(jb.k0 + kk) * jb.N + jb.n0 + c4 * 4); }
}
__device__ __forceinline__ void conv_to_lds(int tid, const f32x4 (&v)[8], float* tl) {
#pragma unroll
    for (int i = 0; i < 8; ++i) { const int idx = tid + i * 512, kk = idx >> 6, c4 = idx & 63; float* t = tl + kk * 257 + c4 * 4; t[0] = v[i][0]; t[1] = v[i][1]; t[2] = v[i][2]; t[3] = v[i][3]; }
}
__device__ __forceinline__ void conv_store(const ConvJob& jb, int tid, const float* tl) {
#pragma unroll
    for (int i = 0; i < 4; ++i) {
        const int idx = tid + i * 512, kg = idx & 7, n = idx >> 3;
        const float* t = tl + (kg * 8) * 257 + n;
        u32x4 w; w.x = cvt_pk_bf16(t[0], t[257]); w.y = cvt_pk_bf16(t[2 * 257], t[3 * 257]); w.z = cvt_pk_bf16(t[4 * 257], t[5 * 257]); w.w = cvt_pk_bf16(t[6 * 257], t[7 * 257]);
        *(u32x4*)(jb.dst + (size_t)perm_row(jb.n0 + n, jb.ptype) * jb.K + jb.k0 + kg * 8) = w;
    }
}
__device__ __forceinline__ ConvJob conv_job_main(const Params& p, int j) {
    ConvJob jb; int l, t;
    if (j < 224) { l = j / 112; t = j % 112; jb.N = 1792; jb.K = 1024; jb.ptype = 1; jb.src = p.in[10] + (size_t)l * 1024 * 1792; jb.dst = (bf16_t*)(p.ws + W_IN) + (size_t)l * 1792 * 1024; }
    else if (j < 352) { j -= 224; l = j / 64; t = j % 64; jb.N = 1024; jb.K = 1024; jb.ptype = 0; jb.src = p.in[18] + (size_t)l * 1024 * 1024; jb.dst = (bf16_t*)(p.ws + W_OUT) + (size_t)l * 1024 * 1024; }
    else if (j < 1056) { j -= 352; l = j / 352; t = j % 352; jb.N = 5632; jb.K = 1024; jb.ptype = 2; jb.src = p.in[20] + (size_t)l * 1024 * 5632; jb.dst = (bf16_t*)(p.ws + W_FIN) + (size_t)l * 5632 * 1024; }
    else { j -= 1056; l = j / 176; t = j % 176; jb.N = 1024; jb.K = 2816; jb.ptype = 0; jb.src = p.in[23] + (size_t)l * 2816 * 1024; jb.dst = (bf16_t*)(p.ws + W_FOUT) + (size_t)l * 1024 * 2816; }
    const int nn = jb.N / 256; jb.k0 = (t / nn) * 64; jb.n0 = (t % nn) * 256;
    return jb;
}
__device__ __forceinline__ ConvJob conv_job_ada(const Params& p, int j) {
    ConvJob jb; const int l = j / 384, t = j % 384;
    jb.N = 6144; jb.K = 1024; jb.ptype = 0; jb.src = p.in[7] + (size_t)l * 1024 * 6144; jb.dst = (bf16_t*)(p.ws + W_ADA) + (size_t)l * 6144 * 1024; jb.k0 = (t / 24) * 64; jb.n0 = (t % 24) * 256;
    return jb;
}
template <bool ADA>
__device__ __forceinline__ void conv_run(const Params& p, int j0, int step, int njobs, float* tl) {
    const int tid = tid_opaque();
    if (j0 >= njobs) return;
    ConvJob cur = ADA ? conv_job_ada(p, j0) : conv_job_main(p, j0);
    f32x4 v[8];
    conv_load(cur, tid, v);
    for (int j = j0; j < njobs; j += step) {
        conv_to_lds(tid, v, tl);
        __syncthreads();
        const int jn = j + step; const bool hn = jn < njobs;
        ConvJob nxt = cur;
        if (hn) { nxt = ADA ? conv_job_ada(p, jn) : conv_job_main(p, jn); conv_load(nxt, tid, v); }
        conv_store(cur, tid, tl);
        __syncthreads();
        cur = nxt;
    }
}

__device__ __forceinline__ void phase_prep(const Params& p, unsigned char* shm) {
    float* tl = (float*)shm;
    const int nb = gridDim.x, bid = blockIdx.x, tid = tid_opaque();
    conv_run<true>(p, bid, nb, 768, tl);
    const int gtid = bid * 512 + tid, gn = nb * 512;
    bf16_t* CS = (bf16_t*)(p.ws + W_CS);
    for (int i = gtid; i < 256 * 1024 / 2; i += gn) { const int e = i * 2, row = e >> 10; float a = 0.f, b = 0.f;
        if (row < 4) { a = p.in[5][e]; b = p.in[5][e + 1]; } else if (row < 132) { a = p.in[6][e - 4096]; b = p.in[6][e - 4096 + 1]; }
        *(unsigned*)(CS + e) = cvt_pk_bf16(silu_f(a), silu_f(b)); }
    float* RT = (float*)(p.ws + W_ROPE);
    for (int i = gtid; i < 4104 * 8; i += gn) { const int pidx = i >> 3, a = i & 7; const int pos = pidx < 4096 ? pidx : 16384 + (pidx - 4096);
        const double ang = (double)pos * p.inv[a];
        const double kq = rint(ang * 0.63661977236758134308);
        double rr = fma(-kq, 1.5707963267948966192, ang); rr = fma(-kq, 6.123233995736766036e-17, rr);
        const double r2 = rr * rr;
        const double sn = rr * (1.0 + r2 * (-1.0 / 6 + r2 * (1.0 / 120 + r2 * (-1.0 / 5040 + r2 * (1.0 / 362880 + r2 * (-1.0 / 39916800))))));
        const double cs = 1.0 + r2 * (-0.5 + r2 * (1.0 / 24 + r2 * (-1.0 / 720 + r2 * (1.0 / 40320 + r2 * (-1.0 / 3628800 + r2 * (1.0 / 479001600))))));
        const int q = ((int)((long long)kq & 3));
        double c_, s_;
        if (q == 0) { c_ = cs; s_ = sn; } else if (q == 1) { c_ = -sn; s_ = cs; } else if (q == 2) { c_ = -cs; s_ = -sn; } else { c_ = sn; s_ = -cs; }
        RT[pidx * 16 + a] = (float)c_; RT[pidx * 16 + 8 + a] = (float)s_; }
    bf16_t* WSB = (bf16_t*)(p.ws + W_WS);
    for (int i = gtid; i < 2 * 4 * 128 * 128 / 2; i += gn) { const int e = i * 2, s = e & 127, t = (e >> 7) & 127;
        const float a = (s <= t) ? p.in[16][e] : 0.f, b = (s + 1 <= t) ? p.in[16][e + 1] : 0.f;
        *(unsigned*)(WSB + e) = cvt_pk_bf16(a, b); }
}

template <bool INB>
__device__ __forceinline__ void phase_norm(const float* xp, const float* xs, const bf16_t* xb, const float* gvec, const float* mod_sh, const float* mod_sc, bf16_t* H) {
    const int tid = tid_opaque(); const int wid = tid >> 6, lane = tid & 63;
    const int nw = gridDim.x * 8;
    f32x4 g[4];
#pragma unroll
    for (int i = 0; i < 4; ++i) g[i] = *(const f32x4*)(gvec + i * 256 + lane * 4);
    int r = blockIdx.x * 8 + wid;
    f32x4 v[4], sc[4], sh[4];
    auto load_row = [&](int rr, f32x4 (&vv)[4], f32x4 (&scc)[4], f32x4 (&shh)[4]) {
        const int mrow = rr < NPR ? (rr >> 12) : 4 + ((rr - NPR) >> 3);
#pragma unroll
        for (int i = 0; i < 4; ++i) { const int c = i * 256 + lane * 4;
            if (INB) vv[i] = unpack4(*(const u32x2*)(xb + (size_t)rr * 1024 + c));
            else vv[i] = *(const f32x4*)((rr < NPR ? xp + (size_t)rr * 1024 : xs + (size_t)(rr - NPR) * 1024) + c);
            scc[i] = *(const f32x4*)(mod_sc + (size_t)mrow * 12288 + c); shh[i] = *(const f32x4*)(mod_sh + (size_t)mrow * 12288 + c); }
    };
    if (r < MT) load_row(r, v, sc, sh);
    while (r < MT) {
        const int rn = r + nw; const int rnc = rn < MT ? rn : r;
        f32x4 v2[4], sc2[4], sh2[4];
        load_row(rnc, v2, sc2, sh2);
        float ss = 0.f;
#pragma unroll
        for (int i = 0; i < 4; ++i) ss += v[i][0] * v[i][0] + v[i][1] * v[i][1] + v[i][2] * v[i][2] + v[i][3] * v[i][3];
#pragma unroll
        for (int o = 32; o >= 1; o >>= 1) ss += __shfl_xor(ss, o);
        const float rs = rsqrtf(ss * (1.0f / 1024.0f) + 1e-6f);
#pragma unroll
        for (int i = 0; i < 4; ++i) *(u32x2*)(H + (size_t)r * 1024 + i * 256 + lane * 4) = pack4(v[i] * rs * g[i] * (sc[i] + 1.0f) + sh[i]);
#pragma unroll
        for (int i = 0; i < 4; ++i) { v[i] = v2[i]; sc[i] = sc2[i]; sh[i] = sh2[i]; }
        r = rn;
    }
}

__device__ __forceinline__ void attn_unit(const Params& p, int layer, bool sample, int b, int blk, int kvh, unsigned char* shm) {
    bf16_t* Ks = (bf16_t*)shm;
    bf16_t* Vt = Ks + 256 * 72;
    bf16_t* Pw = Vt + 64 * 280;
    const bf16_t* Q = (const bf16_t*)(p.ws + W_Q); const bf16_t* KB = (const bf16_t*)(p.ws + W_KB); const bf16_t* VB = (const bf16_t*)(p.ws + W_VB);
    bf16_t* MIX = (bf16_t*)(p.ws + W_MIX);
    const int tid = tid_opaque(), wid = tid >> 6, lane = tid & 63, fr = lane & 15, fq = lane >> 4;
    if (!sample) {
        const int row0 = b * 4096 + blk * 128 - 128;
#pragma unroll
        for (int i = 0; i < 4; ++i) { const int idx = tid + i * 512, j = idx >> 3, c8 = idx & 7; int gr = row0 + j; if (gr < b * 4096) gr += 128;
            *(u32x4*)(Ks + j * 72 + c8 * 8) = *(const u32x4*)(KB + (size_t)gr * 128 + kvh * 64 + c8 * 8); }
#pragma unroll
        for (int i = 0; i < 4; ++i) { const int idx = tid + i * 512, j = idx & 255, c8 = idx >> 8; int gr = row0 + j; if (gr < b * 4096) gr += 128;
            const u32x4 v = *(const u32x4*)(VB + (size_t)gr * 128 + kvh * 64 + c8 * 8);
            bf16_t* d = Vt + (c8 * 8) * 280 + j;
            d[0] = (bf16_t)(v.x & 0xffff); d[280] = (bf16_t)(v.x >> 16); d[2 * 280] = (bf16_t)(v.y & 0xffff); d[3 * 280] = (bf16_t)(v.y >> 16);
            d[4 * 280] = (bf16_t)(v.z & 0xffff); d[5 * 280] = (bf16_t)(v.z >> 16); d[6 * 280] = (bf16_t)(v.w & 0xffff); d[7 * 280] = (bf16_t)(v.w >> 16); }
        for (int i = tid; i < 64 * 24; i += 512) Vt[(i / 24) * 280 + 256 + (i % 24)] = 0;
    } else {
        const float* ck = p.in[2] + ((size_t)(layer * 128 + b) * 128) * 128 + kvh * 64;
        const float* cv = p.in[3] + ((size_t)(layer * 128 + b) * 128) * 128 + kvh * 64;
#pragma unroll
        for (int i = 0; i < 4; ++i) { const int idx = tid + i * 512, j = idx >> 4, c4 = idx & 15;
            const f32x4 v = *(const f32x4*)(ck + (size_t)j * 128 + c4 * 4); *(u32x2*)(Ks + j * 72 + c4 * 4) = pack4(v); }
#pragma unroll
        for (int i = 0; i < 4; ++i) { const int idx = tid + i * 512, j = idx & 127, c4 = idx >> 7;
            const f32x4 v = *(const f32x4*)(cv + (size_t)j * 128 + c4 * 4); const u32x2 w = pack4(v);
            bf16_t* d = Vt + (c4 * 4) * 280 + j;
            d[0] = (bf16_t)(w.x & 0xffff); d[280] = (bf16_t)(w.x >> 16); d[2 * 280] = (bf16_t)(w.y & 0xffff); d[3 * 280] = (bf16_t)(w.y >> 16); }
        if (tid < 128) { const int s = tid >> 3, c8 = tid & 7; u32x4 v = (u32x4){0u, 0u, 0u, 0u};
            if (s < 8) v = *(const u32x4*)(KB + (size_t)(NPR + b * 8 + s) * 128 + kvh * 64 + c8 * 8);
            *(u32x4*)(Ks + (128 + s) * 72 + c8 * 8) = v;
        } else if (tid < 256) { const int t2 = tid - 128, s = t2 & 15, c8 = t2 >> 4; u32x4 v = (u32x4){0u, 0u, 0u, 0u};
            if (s < 8) v = *(const u32x4*)(VB + (size_t)(NPR + b * 8 + s) * 128 + kvh * 64 + c8 * 8);
            bf16_t* d = Vt + (c8 * 8) * 280 + 128 + s;
            d[0] = (bf16_t)(v.x & 0xffff); d[280] = (bf16_t)(v.x >> 16); d[2 * 280] = (bf16_t)(v.y & 0xffff); d[3 * 280] = (bf16_t)(v.y >> 16);
            d[4 * 280] = (bf16_t)(v.z & 0xffff); d[5 * 280] = (bf16_t)(v.z >> 16); d[6 * 280] = (bf16_t)(v.w & 0xffff); d[7 * 280] = (bf16_t)(v.w >> 16);
        } else { const int t2 = tid - 256; for (int i = t2; i < 64 * 16; i += 256) Vt[(i >> 4) * 280 + 144 + (i & 15)] = 0; }
    }
    __syncthreads();
    const int hh = wid >> 1, half = wid & 1, head = kvh * 4 + hh;
    const int ntile = sample ? (half == 0 ? 1 : 0) : 4;
    const int kmin = sample ? 0 : (blk == 0 ? 128 : 0), kmax = sample ? 136 : 256;
    const float sink = p.in[13][layer * 8 + head];
    bf16_t* Pme = Pw + wid * 16 * 168;
    u32x2 ores[4][4];
    for (int rt = 0; rt < ntile; ++rt) {
        const int i0 = sample ? 0 : half * 64 + rt * 16;
        const int qi = sample ? (fr & 7) : i0 + fr;
        const size_t grow = sample ? (size_t)(NPR + b * 8 + qi) : (size_t)(b * 4096 + blk * 128 + qi);
        const bf16_t* qp = Q + grow * 512 + head * 64;
        bf16x8 qf[2]; qf[0] = *(const bf16x8*)(qp + fq * 8); qf[1] = *(const bf16x8*)(qp + 32 + fq * 8);
        f32x4 s[9];
#pragma unroll
        for (int kt = 0; kt < 9; ++kt) { s[kt] = (f32x4){0.f, 0.f, 0.f, 0.f};
#pragma unroll
            for (int ks = 0; ks < 2; ++ks) { const bf16x8 kf = *(const bf16x8*)(Ks + (i0 + 16 * kt + fr) * 72 + ks * 32 + fq * 8);
                s[kt] = __builtin_amdgcn_mfma_f32_16x16x32_bf16(kf, qf[ks], s[kt], 0, 0, 0); } }
        const float sink2 = sink * 1.4426950408889634f;
        float mx = sink2;
#pragma unroll
        for (int kt = 0; kt < 9; ++kt)
#pragma unroll
            for (int e = 0; e < 4; ++e) { const int kb = i0 + 16 * kt + 4 * fq + e;
                const bool valid = (!sample && kt >= 1 && kt <= 7) ? (i0 + 16 * kt >= kmin) : ((kb >= qi + 1) && (kb <= qi + 128) && (kb >= kmin) && (kb < kmax));
                const float sc = valid ? s[kt][e] * 0.18033688011112042f : -1e30f; s[kt][e] = sc; mx = fmaxf(mx, sc); }
        mx = xmax_fq(mx);
        float sum = 0.f;
#pragma unroll
        for (int kt = 0; kt < 9; ++kt)
#pragma unroll
            for (int e = 0; e < 4; ++e) { const float pe = __builtin_amdgcn_exp2f(s[kt][e] - mx); s[kt][e] = pe; sum += pe; }
        sum = xsum_fq(sum) + __builtin_amdgcn_exp2f(sink2 - mx);
        const float inv = 1.0f / sum;
#pragma unroll
        for (int kt = 0; kt < 9; ++kt) *(u32x2*)(Pme + fr * 168 + 16 * kt + 4 * fq) = pack4(s[kt] * inv);
        *(u32x2*)(Pme + fr * 168 + 144 + 4 * fq) = (u32x2){0u, 0u};
        asm volatile("s_waitcnt lgkmcnt(0)" ::: "memory");
        f32x4 o[4];
#pragma unroll
        for (int dt = 0; dt < 4; ++dt) o[dt] = (f32x4){0.f, 0.f, 0.f, 0.f};
#pragma unroll
        for (int ks = 0; ks < 5; ++ks) { const bf16x8 pf = *(const bf16x8*)(Pme + fr * 168 + ks * 32 + fq * 8);
#pragma unroll
            for (int dt = 0; dt < 4; ++dt) { const bf16x8 vf = *(const bf16x8*)(Vt + (16 * dt + fr) * 280 + i0 + ks * 32 + fq * 8);
                o[dt] = __builtin_amdgcn_mfma_f32_16x16x32_bf16(vf, pf, o[dt], 0, 0, 0); } }
#pragma unroll
        for (int dt = 0; dt < 4; ++dt) {
            const u32x2 pk = pack4_mfma(o[dt]);
            if (rt == 0) ores[0][dt] = pk; else if (rt == 1) ores[1][dt] = pk; else if (rt == 2) ores[2][dt] = pk; else ores[3][dt] = pk; }
        asm volatile("s_waitcnt lgkmcnt(0)" ::: "memory");
    }
#pragma unroll
    for (int rt = 0; rt < 4; ++rt) {
        if (rt < ntile && (!sample || fr < 8)) {
            const int qi = sample ? (fr & 7) : half * 64 + rt * 16 + fr;
            const size_t grow = sample ? (size_t)(NPR + b * 8 + qi) : (size_t)(b * 4096 + blk * 128 + qi);
            bf16_t* mp = MIX + grow * 1024 + head * 64 + 4 * fq;
#pragma unroll
            for (int dt = 0; dt < 4; ++dt) *(u32x2*)(mp + 16 * dt) = ores[rt][dt];
        }
    }
    __syncthreads();
}

__device__ __forceinline__ void sg_unit(const Params& p, int layer, int b, int chunk, int g, unsigned char* shm) {
    bf16_t* VGt = (bf16_t*)shm;
    const bf16_t* U = (const bf16_t*)(p.ws + W_U); const bf16_t* VG = (const bf16_t*)(p.ws + W_VG); const bf16_t* WSB = (const bf16_t*)(p.ws + W_WS);
    bf16_t* MIX = (bf16_t*)(p.ws + W_MIX);
    const int tid = tid_opaque(), wid = tid >> 6, lane = tid & 63, fr = lane & 15, fq = lane >> 4;
    const int rb = b * 4096 + chunk * 128;
    const int t0 = 16 * wid, nks = (wid >> 1) + 1;
    const bf16_t* wp = WSB + ((size_t)(layer * 4 + g) * 128 + t0 + fr) * 128 + fq * 8;
    bf16x8 wfa[4];
#pragma unroll
    for (int ks = 0; ks < 4; ++ks) wfa[ks] = *(const bf16x8*)(wp + ks * 32);
    const float bs = p.in[17][(layer * 4 + g) * 128 + t0 + fr];
    const size_t row = (size_t)(rb + t0 + fr);
    u32x2 ua[8];
#pragma unroll
    for (int wt = 0; wt < 8; ++wt) ua[wt] = *(const u32x2*)(U + row * 512 + g * 128 + 16 * wt + 4 * fq);
#pragma unroll
    for (int i = 0; i < 4; ++i) { const int idx = tid + i * 512, s = idx & 127, c8 = idx >> 7;
        const u32x4 v = *(const u32x4*)(VG + (size_t)(rb + s) * 512 + g * 128 + c8 * 8);
        bf16_t* d = VGt + (c8 * 8) * 136 + s;
        d[0] = (bf16_t)(v.x & 0xffff); d[136] = (bf16_t)(v.x >> 16); d[2 * 136] = (bf16_t)(v.y & 0xffff); d[3 * 136] = (bf16_t)(v.y >> 16);
        d[4 * 136] = (bf16_t)(v.z & 0xffff); d[5 * 136] = (bf16_t)(v.z >> 16); d[6 * 136] = (bf16_t)(v.w & 0xffff); d[7 * 136] = (bf16_t)(v.w >> 16); }
    __syncthreads();
    f32x4 z[8];
#pragma unroll
    for (int wt = 0; wt < 8; ++wt) z[wt] = (f32x4){0.f, 0.f, 0.f, 0.f};
#pragma unroll
    for (int ks = 0; ks < 4; ++ks) { if (ks >= nks) break;
#pragma unroll
        for (int wt = 0; wt < 8; ++wt) { const bf16x8 vf = *(const bf16x8*)(VGt + (16 * wt + fr) * 136 + ks * 32 + fq * 8);
            z[wt] = __builtin_amdgcn_mfma_f32_16x16x32_bf16(vf, wfa[ks], z[wt], 0, 0, 0); } }
#pragma unroll
    for (int wt = 0; wt < 8; ++wt) { const int c = g * 128 + 16 * wt + 4 * fq;
        const u32x2 uu = ua[wt];
        f32x4 o; o[0] = __uint_as_float(uu.x << 16) * (z[wt][0] + bs); o[1] = __uint_as_float(uu.x & 0xffff0000u) * (z[wt][1] + bs);
        o[2] = __uint_as_float(uu.y << 16) * (z[wt][2] + bs); o[3] = __uint_as_float(uu.y & 0xffff0000u) * (z[wt][3] + bs);
        *(u32x2*)(MIX + row * 1024 + 512 + c) = pack4(o); }
    __syncthreads();
}

__device__ __forceinline__ void phase_mix(const Params& p, int layer, unsigned char* shm) {
    const int nb = gridDim.x, bid = blockIdx.x;
#ifndef NO_MIXA
    for (int u = bid; u < 256; u += nb) attn_unit(p, layer, false, u >> 6, (u >> 1) & 31, u & 1, shm);
#endif
#ifndef NO_MIXB
    for (int u = bid; u < 256; u += nb) attn_unit(p, layer, true, u >> 1, 0, u & 1, shm);
#endif
#ifndef NO_MIXC
    for (int u = bid; u < 512; u += nb) sg_unit(p, layer, u >> 7, (u >> 2) & 31, u & 3, shm);
#endif
    const bf16_t* U = (const bf16_t*)(p.ws + W_U); const bf16_t* VG = (const bf16_t*)(p.ws + W_VG); bf16_t* MIX = (bf16_t*)(p.ws + W_MIX);
    for (int idx = bid * 512 + tid_opaque(); idx < 1024 * 128; idx += nb * 512) {
        const int r = idx >> 7, c4 = (idx & 127) * 4, b = r >> 3, t = r & 7, g = c4 >> 7;
        const float* wrow = p.in[16] + ((size_t)(layer * 4 + g) * 128 + t) * 128;
        f32x4 z = (f32x4){0.f, 0.f, 0.f, 0.f};
        const f32x4 wa = *(const f32x4*)(wrow), wb = *(const f32x4*)(wrow + 4);
        u32x2 vv[8];
#pragma unroll
        for (int s = 0; s < 8; ++s) vv[s] = *(const u32x2*)(VG + (size_t)(NPR + b * 8 + s) * 512 + c4);
#pragma unroll
        for (int s = 0; s < 8; ++s) { const float w0 = s < 4 ? wa[s & 3] : wb[s & 3]; const float w = (s <= t) ? w0 : 0.f;
            z[0] += w * __uint_as_float(vv[s].x << 16); z[1] += w * __uint_as_float(vv[s].x & 0xffff0000u); z[2] += w * __uint_as_float(vv[s].y << 16); z[3] += w * __uint_as_float(vv[s].y & 0xffff0000u); }
        const float bs = p.in[17][(layer * 4 + g) * 128 + t];
        const u32x2 uu = *(const u32x2*)(U + (size_t)(NPR + r) * 512 + c4);
        f32x4 o; o[0] = __uint_as_float(uu.x << 16) * (z[0] + bs); o[1] = __uint_as_float(uu.x & 0xffff0000u) * (z[1] + bs);
        o[2] = __uint_as_float(uu.y << 16) * (z[2] + bs); o[3] = __uint_as_float(uu.y & 0xffff0000u) * (z[3] + bs);
        *(u32x2*)(MIX + (size_t)(NPR + r) * 1024 + 512 + c4) = pack4(o);
    }
}

__device__ __forceinline__ void phase_fix(const Params& p, int layer) {
    const bf16_t* HALO = (const bf16_t*)(p.ws + W_HALO); bf16_t* ACT = (bf16_t*)(p.ws + W_R);
    const float* cw = p.in[21] + (size_t)layer * 3 * 5632; const float* cb = p.in[22] + (size_t)layer * 5632;
    const int gtid = blockIdx.x * 512 + tid_opaque(), gn = gridDim.x * 512;
    for (int idx = gtid; idx < 256 * 704; idx += gn) {
        const int blk = idx / 704, c = (idx % 704) * 4;
        const bf16_t* own = HALO + (size_t)blk * 4 * 5632; const bf16_t* prv = own - 4 * 5632;
        const bool first = (blk & 63) == 0;
        f32x4 a0, a1;
        f32x4 cg[2], cu[2];
#pragma unroll
        for (int h = 0; h < 2; ++h) {
            const int cc = c + h * 2816;
            const f32x4 w0 = *(const f32x4*)(cw + cc), w1 = *(const f32x4*)(cw + 5632 + cc), w2 = *(const f32x4*)(cw + 11264 + cc), bb = *(const f32x4*)(cb + cc);
            const f32x4 zero = (f32x4){0.f, 0.f, 0.f, 0.f};
            const f32x4 m2 = first ? zero : unpack4(*(const u32x2*)(prv + 2 * 5632 + cc)), m1 = first ? zero : unpack4(*(const u32x2*)(prv + 3 * 5632 + cc));
            const f32x4 o0 = unpack4(*(const u32x2*)(own + cc)), o1 = unpack4(*(const u32x2*)(own + 5632 + cc));
            const f32x4 r0 = bb + w0 * m2 + w1 * m1 + w2 * o0, r1 = bb + w0 * m1 + w1 * o0 + w2 * o1;
            if (h == 0) { cg[0] = r0; cg[1] = r1; } else { cu[0] = r0; cu[1] = r1; }
        }
#pragma unroll
        for (int e = 0; e < 4; ++e) { a0[e] = silu_f(cg[0][e]) * cu[0][e]; a1[e] = silu_f(cg[1][e]) * cu[1][e]; }
        *(u32x2*)(ACT + (size_t)(blk * 64) * 2816 + c) = pack4(a0);
        *(u32x2*)(ACT + (size_t)(blk * 64 + 1) * 2816 + c) = pack4(a1);
    }
}

#define XB_TMO      128
#define XB_XCNT(j)  (256  + 64 * (j))
#define XB_XSUB(j)  (1280 + 64 * (j))
#define XB_XGEN(j)  (2304 + 64 * (j))
#define XB_TOP      3328
#define XB_TOPGEN   3392
#define XCD_BAR_WORDS 3456
#define XB_SPIN_CAP (1u << 18)
__device__ __forceinline__ unsigned xb_ld(unsigned* p)              { return __hip_atomic_load(p, __ATOMIC_RELAXED, __HIP_MEMORY_SCOPE_AGENT); }
__device__ __forceinline__ unsigned xb_add(unsigned* p, unsigned v) { return __hip_atomic_fetch_add(p, v, __ATOMIC_RELAXED, __HIP_MEMORY_SCOPE_AGENT); }
__device__ __forceinline__ unsigned xb_xcc_id() { return (unsigned)__builtin_amdgcn_s_getreg((3 << 11) | 20) & 0xFu; }
#define XB_SPIN(cond, bar) do { unsigned _sp = 0; while (cond) { __builtin_amdgcn_s_sleep(1); \
    if ((++_sp & 255u) == 0u) { if (xb_ld(&(bar)[XB_TMO])) break; if (_sp > XB_SPIN_CAP) { atomicAdd(&(bar)[XB_TMO], 1u); break; } } } } while (0)
struct XcdBarrier { unsigned* bar; unsigned x; volatile LAS unsigned* st; };
__device__ __forceinline__ XcdBarrier xcd_barrier_post(unsigned* bar, volatile LAS unsigned* st) {
    XcdBarrier b; b.bar = bar; b.x = xb_xcc_id(); b.st = st;
    if (threadIdx.x == 0) (void)xb_add(&bar[XB_XCNT(b.x)], 1u);
    return b;
}
__device__ __forceinline__ void xcd_barrier_complete(unsigned* bar, unsigned x, unsigned& nloc, unsigned& nx) {
    const unsigned G = gridDim.x * gridDim.y * gridDim.z;
    unsigned sum, cnt, mine, sp = 0u;
    for (;;) {
        sum = 0u; cnt = 0u; mine = 0u;
#pragma unroll
        for (unsigned j = 0; j < 16; ++j) { const unsigned c = xb_ld(&bar[XB_XCNT(j)]); sum += c; cnt += (c > 0u) ? 1u : 0u; mine = (j == x) ? c : mine; }
        if (sum == G) break;
        __builtin_amdgcn_s_sleep(1);
        if ((++sp & 255u) == 0u) { if (xb_ld(&bar[XB_TMO])) break; if (sp > XB_SPIN_CAP) { atomicAdd(&bar[XB_TMO], 1u); break; } }
    }
    nloc = mine > 0u ? mine : 1u; nx = cnt > 0u ? cnt : 1u;
}
__device__ __forceinline__ void xcd_barrier(const XcdBarrier& b) {
    asm volatile("s_waitcnt vmcnt(0)" ::: "memory");
    __syncthreads();
    if (threadIdx.x == 0) {
        unsigned* bar = b.bar;
        __builtin_amdgcn_s_waitcnt(0);
        unsigned nloc = b.st[0], nx = b.st[1];
        if (nloc == 0u) { xcd_barrier_complete(bar, b.x, nloc, nx); b.st[0] = nloc; b.st[1] = nx; }
        const unsigned old = xb_add(&bar[XB_XSUB(b.x)], 1u);
        const unsigned gen = old / nloc;
        if (old + 1u == (gen + 1u) * nloc) {
            __builtin_amdgcn_fence(__ATOMIC_RELEASE, "agent");
            asm volatile("s_waitcnt vmcnt(0)" ::: "memory");
            const unsigned og = xb_add(&bar[XB_TOP], 1u);
            const unsigned tg = og / nx;
            if (og + 1u == (tg + 1u) * nx) xb_add(&bar[XB_TOPGEN], 1u);
            else XB_SPIN(xb_ld(&bar[XB_TOPGEN]) == tg, bar);
            __builtin_amdgcn_fence(__ATOMIC_ACQUIRE, "agent");
            xb_add(&bar[XB_XGEN(b.x)], 1u);
            asm volatile("s_waitcnt vmcnt(0)" ::: "memory");
        } else {
            XB_SPIN(xb_ld(&bar[XB_XGEN(b.x)]) == gen, bar);
            __builtin_amdgcn_fence(__ATOMIC_ACQUIRE, "agent");
            asm volatile("s_waitcnt vmcnt(0)" ::: "memory");
        }
    }
    __syncthreads();
}

__device__ __forceinline__ void run_phase(const Params& p, int ph, unsigned char* shm) {
    LAS unsigned char* lds = (LAS unsigned char*)shm;
    float* MOD = (float*)(p.ws + W_MOD);
    const int nb = gridDim.x, bid = blockIdx.x;
    if (ph == 0) { phase_prep(p, shm); return; }
    if (ph == 1) {
        const int ng = nb > 96 ? 48 : 0;
        if (ng == 0 || bid < ng) {
            pg8::StaticOrder S; S.init(256, 12288, 1024, ng ? ng : nb, bid, false);
            pg8::Gemm g{(const bf16_t*)(p.ws + W_CS), (const bf16_t*)(p.ws + W_ADA), 256, 12288, 1024};
            EpiMod E{MOD, p.in[8]};
            pg8::gemm_phase(lds, g, S, E);
        }
        if (ng == 0 || bid >= ng) {
            const int nc = ng ? nb - ng : nb, c0 = ng ? bid - ng : bid;
            conv_run<false>(p, c0, nc, 1408, (float*)shm);
        }
        return;
    }
    const int layer = (ph - 2) >> 3, sub = (ph - 2) & 7;
    const float* modl = MOD + layer * 6144;
    bf16_t* XB = (bf16_t*)(p.ws + W_XB);
    unsigned* tick = (unsigned*)(p.ws + W_BAR + 16384);
    pg8::StaticOrder S;
    switch (sub) {
    case 0: if (layer == 0) phase_norm<false>(p.in[0], p.in[1], nullptr, p.in[9], modl + 0, modl + 1024, (bf16_t*)(p.ws + W_H));
            else phase_norm<true>(nullptr, nullptr, XB, p.in[9] + layer * 1024, modl + 0, modl + 1024, (bf16_t*)(p.ws + W_H));
            break;
    case 1: { S.init(MT, 1792, 1024, nb, bid, false); S.reverse = 1;
        pg8::Gemm g{(const bf16_t*)(p.ws + W_H), (const bf16_t*)(p.ws + W_IN) + (size_t)layer * 1792 * 1024, MT, 1792, 1024};
        EpiIn E{layer, p.in[11] + layer * 64, p.in[12] + layer * 64, p.in[14] + layer * 512, p.in[15] + layer * 512, (const float*)(p.ws + W_ROPE),
                (bf16_t*)(p.ws + W_Q), (bf16_t*)(p.ws + W_KB), (bf16_t*)(p.ws + W_VB), (bf16_t*)(p.ws + W_U), (bf16_t*)(p.ws + W_VG), p.out};
        pg8::gemm_phase(lds, g, S, E); } break;
    case 2: phase_mix(p, layer, shm); break;
    case 3: { S.init(MT, 1024, 1024, nb, bid, true);
        pg8::Gemm g{(const bf16_t*)(p.ws + W_MIX), (const bf16_t*)(p.ws + W_OUT) + (size_t)layer * 1024 * 1024, MT, 1024, 1024};
        if (layer == 0) { EpiRes<false, true> E{p.in[0], p.in[1], nullptr, nullptr, XB, modl + 2048, p.ws, tick + (layer * 2 + 0) * 128}; pg8::gemm_phase(lds, g, S, E); }
        else { EpiRes<true, true> E{nullptr, nullptr, XB, nullptr, XB, modl + 2048, p.ws, tick + (layer * 2 + 0) * 128}; pg8::gemm_phase(lds, g, S, E); }
        } break;
    case 4: phase_norm<true>(nullptr, nullptr, XB, p.in[19] + layer * 1024, modl + 3072, modl + 4096, (bf16_t*)(p.ws + W_H)); break;
    case 5: { S.init(MT, 5632, 1024, nb, bid, false); S.reverse = 1;
        pg8::Gemm g{(const bf16_t*)(p.ws + W_H), (const bf16_t*)(p.ws + W_FIN) + (size_t)layer * 5632 * 1024, MT, 5632, 1024};
        EpiFfnIn E{p.in[21] + (size_t)layer * 3 * 5632, p.in[22] + (size_t)layer * 5632, p.in[4] + (size_t)layer * 128 * 2 * 5632,
                   (bf16_t*)(p.ws + W_R), (bf16_t*)(p.ws + W_HALO), p.out + O_NCS + (size_t)layer * 128 * 2 * 5632, p.out + O_NCP + (size_t)layer * 4 * 2 * 5632};
        pg8::gemm_phase(lds, g, S, E); } break;
    case 6: phase_fix(p, layer); break;
    case 7: { S.init(MT, 1024, 2816, nb, bid, true);
        pg8::Gemm g{(const bf16_t*)(p.ws + W_R), (const bf16_t*)(p.ws + W_FOUT) + (size_t)layer * 1024 * 2816, MT, 1024, 2816};
        if (layer == 0) { EpiRes<true, true> E{nullptr, nullptr, XB, nullptr, XB, modl + 5120, p.ws, tick + (layer * 2 + 1) * 128}; pg8::gemm_phase(lds, g, S, E); }
        else { EpiRes<true, false> E{nullptr, nullptr, XB, p.out, nullptr, modl + 5120, p.ws, tick + (layer * 2 + 1) * 128}; pg8::gemm_phase(lds, g, S, E); }
        } break;
    }
}

__global__ __launch_bounds__(512, 2) void mega_fwd(Params p) {
    extern __shared__ __attribute__((aligned(16))) unsigned char shm[];
    cg::grid_group grid = cg::this_grid();
    const int lo = p.ph_lo, hi = p.ph_hi;
    if (lo < 0) grid.sync();
    volatile LAS unsigned* st = (volatile LAS unsigned*)((LAS unsigned char*)shm + LDS_MISC);
    if (threadIdx.x < 4) st[threadIdx.x] = 0u;
    __syncthreads();
    XcdBarrier xb; xb.bar = (unsigned*)(p.ws + W_BAR); xb.x = 0; xb.st = st;
    if (hi - lo > 1) xb = xcd_barrier_post((unsigned*)(p.ws + W_BAR), st);
#ifndef PROBE_DUP
#define PROBE_DUP -1
#endif
#define PHASE(k) do { if (lo <= (k) && (k) < hi) run_phase(p, (k), shm); if (lo <= (k) && (k) + 1 < hi) xcd_barrier(xb); \
        if ((k) == PROBE_DUP) { run_phase(p, (k), shm); xcd_barrier(xb); } } while (0)
    PHASE(0); PHASE(1); PHASE(2); PHASE(3); PHASE(4); PHASE(5); PHASE(6); PHASE(7); PHASE(8); PHASE(9);
    PHASE(10); PHASE(11); PHASE(12); PHASE(13); PHASE(14); PHASE(15); PHASE(16); PHASE(17);
#undef PHASE
}

extern "C" void kernel_launch(void* const* d_in, const int* in_sizes, int n_in, void* d_out, int out_size, void* d_ws, size_t ws_size, hipStream_t stream) {
    static int grid = 0;
    if (grid == 0) {
        if (n_in != 24 || ws_size < W_END) { fprintf(stderr, "kernel_launch: unexpected n_in %d / ws %zu (need %zu)\n", n_in, ws_size, (size_t)W_END); grid = -1; return; }
        int dev = 0, cus = 0, per_cu = 0;
        hipGetDevice(&dev); hipDeviceGetAttribute(&cus, hipDeviceAttributeMultiprocessorCount, dev);
        if (hipFuncSetAttribute((const void*)mega_fwd, hipFuncAttributeMaxDynamicSharedMemorySize, LDS_BYTES) != hipSuccess) { fprintf(stderr, "kernel_launch: hipFuncSetAttribute failed\n"); grid = -1; return; }
        if (hipOccupancyMaxActiveBlocksPerMultiprocessor(&per_cu, (const void*)mega_fwd, 512, LDS_BYTES) != hipSuccess || per_cu < 1) { fprintf(stderr, "kernel_launch: occupancy query says %d\n", per_cu); per_cu = 1; }
        (void)hipGetLastError();
        grid = cus * 1;
        if (grid > 256) grid = 256;
    }
    if (grid < 0) return;
    Params p{};
    for (int i = 0; i < 24; ++i) p.in[i] = (const float*)d_in[i];
    p.out = (float*)d_out; p.ws = (unsigned char*)d_ws;
    for (int a = 0; a < 8; ++a) p.inv[a] = std::pow(500000.0, -(double)a / 8.0);
#if ONE_LAUNCH
    (void)hipMemsetAsync((char*)d_ws + W_BAR, 0, 32768, stream);
    p.ph_lo = 0; p.ph_hi = NPH;
    void* args[] = {&p};
    hipError_t e = hipLaunchCooperativeKernel((const void*)mega_fwd, dim3(grid), dim3(512), args, LDS_BYTES, stream);
    if (e != hipSuccess) fprintf(stderr, "cooperative launch failed: %s (grid %d)\n", hipGetErrorString(e), grid);
#else
    for (int ph = 0; ph < NPH; ++ph) {
        p.ph_lo = ph; p.ph_hi = ph + 1;
        hipLaunchKernelGGL(mega_fwd, dim3(grid), dim3(512), LDS_BYTES, stream, p);
    }
#endif
}
#ifdef TESTK
__global__ __launch_bounds__(512, 2) void tk(const bf16_t* A, const bf16_t* B, float* MOD, const float* bias) {
    extern __shared__ __attribute__((aligned(16))) unsigned char shm2[];
    pg8::StaticOrder S; S.init(256, 12288, 1024, gridDim.x, blockIdx.x, true);
    pg8::Gemm g{A, B, 256, 12288, 1024}; EpiMod E{MOD, bias};
    pg8::gemm_phase((LAS unsigned char*)shm2, g, S, E);
}
#endif
```

```cpp
#include <hip/hip_runtime.h>
#include <hip/hip_cooperative_groups.h>
#include <cstdio>
#include <cmath>
namespace cg = cooperative_groups;

#define LAS __attribute__((address_space(3)))
typedef unsigned short bf16_t;
typedef short bf16x8 __attribute__((ext_vector_type(8)));
typedef float f32x4 __attribute__((ext_vector_type(4)));
typedef float f32x2 __attribute__((ext_vector_type(2)));
typedef unsigned u32x4 __attribute__((ext_vector_type(4)));
typedef unsigned u32x2 __attribute__((ext_vector_type(2)));

#ifndef ONE_LAUNCH
#define ONE_LAUNCH 1
#endif

constexpr int NPR = 16384, NSM = 1024, MT = 17408;
constexpr int NPH = 18;
constexpr size_t O_Y = 0;
constexpr size_t O_NKP = 17825792, O_NVP = 17956864, O_NCP = 18087936, O_NKS = 18178048, O_NVS = 18440192, O_NGS = 18702336, O_NCS = 19750912;
constexpr size_t W_ADA = 0;
constexpr size_t W_IN = W_ADA + 12288ull * 1024 * 2;
constexpr size_t W_OUT = W_IN + 2ull * 1792 * 1024 * 2;
constexpr size_t W_FIN = W_OUT + 2ull * 1024 * 1024 * 2;
constexpr size_t W_FOUT = W_FIN + 2ull * 5632 * 1024 * 2;
constexpr size_t W_CS = W_FOUT + 2ull * 1024 * 2816 * 2;
constexpr size_t W_MOD = W_CS + 256ull * 1024 * 2;
constexpr size_t W_ROPE = W_MOD + 132ull * 12288 * 4;
constexpr size_t W_WS = W_ROPE + 4104ull * 16 * 4;
constexpr size_t W_H = W_WS + 2ull * 4 * 128 * 128 * 2;
constexpr size_t W_R = W_H + (size_t)MT * 1024 * 2;
constexpr size_t W_Q = W_R;
constexpr size_t W_KB = W_Q + (size_t)MT * 512 * 2;
constexpr size_t W_VB = W_KB + (size_t)MT * 128 * 2;
constexpr size_t W_U = W_VB + (size_t)MT * 128 * 2;
constexpr size_t W_VG = W_U + (size_t)MT * 512 * 2;
constexpr size_t W_MIX = W_VG + (size_t)MT * 512 * 2;
constexpr size_t W_HALO = W_R + (size_t)MT * 2816 * 2;
constexpr size_t W_XB = W_HALO + 256ull * 4 * 5632 * 2;
constexpr size_t W_BAR = W_XB + (size_t)MT * 1024 * 2;
constexpr size_t W_END = W_BAR + 32768;

constexpr int LDS_STAGE = 131072, LDS_MISC = LDS_STAGE + 8192, LDS_BYTES = LDS_MISC + 16;

struct Params {
    const float* in[24];
    float* out;
    unsigned char* ws;
    double inv[8];
    int ph_lo, ph_hi;
};

__device__ __forceinline__ unsigned cvt_pk_bf16(float lo, float hi) { unsigned r; asm volatile("v_cvt_pk_bf16_f32 %0, %1, %2" : "=v"(r) : "v"(lo), "v"(hi)); return r; }
__device__ __forceinline__ unsigned cvt_pk_bf16_mfma(float lo, float hi) { unsigned r; asm volatile("s_nop 7\n\ts_nop 7\n\tv_cvt_pk_bf16_f32 %0, %1, %2" : "=v"(r) : "v"(lo), "v"(hi)); return r; }
__device__ __forceinline__ float bf2f(bf16_t b) { return __uint_as_float(((unsigned)b) << 16); }
__device__ __forceinline__ float fast_exp(float x) { return __builtin_amdgcn_exp2f(x * 1.4426950408889634f); }
__device__ __forceinline__ float silu_f(float x) { return x * __builtin_amdgcn_rcpf(1.0f + fast_exp(-x)); }
__device__ __forceinline__ float gelu_f(float x) { const float a = x * __builtin_fmaf(x * x, -0.10294324f, -2.3022082f); return x * __builtin_amdgcn_rcpf(1.0f + __builtin_amdgcn_exp2f(a)); }
template <int CTRL> __device__ __forceinline__ float dppf(float x) { return __builtin_bit_cast(float, __builtin_amdgcn_update_dpp(0, __builtin_bit_cast(int, x), CTRL, 0xf, 0xf, false)); }
template <int N> __device__ __forceinline__ f32x4 ror4(f32x4 v) { f32x4 r; r[0] = dppf<0x120 + N>(v[0]); r[1] = dppf<0x120 + N>(v[1]); r[2] = dppf<0x120 + N>(v[2]); r[3] = dppf<0x120 + N>(v[3]); return r; }
__device__ __forceinline__ float xsum_fq(float v) { v += __shfl_xor(v, 16); v += __shfl_xor(v, 32); return v; }
__device__ __forceinline__ float xmax_fq(float v) { v = fmaxf(v, __shfl_xor(v, 16)); v = fmaxf(v, __shfl_xor(v, 32)); return v; }
__device__ __forceinline__ u32x2 pack4(f32x4 v) { u32x2 w; w.x = cvt_pk_bf16(v[0], v[1]); w.y = cvt_pk_bf16(v[2], v[3]); return w; }
__device__ __forceinline__ u32x2 pack4_mfma(f32x4 v) { u32x2 w; w.x = cvt_pk_bf16_mfma(v[0], v[1]); w.y = cvt_pk_bf16(v[2], v[3]); return w; }
__device__ __forceinline__ u32x4 pack8(f32x4 a, f32x4 b) { u32x4 w; w.x = cvt_pk_bf16(a[0], a[1]); w.y = cvt_pk_bf16(a[2], a[3]); w.z = cvt_pk_bf16(b[0], b[1]); w.w = cvt_pk_bf16(b[2], b[3]); return w; }

__device__ __forceinline__ int tid_opaque() { int t = threadIdx.x; asm volatile("" : "+v"(t)); return t; }

namespace pg8 {
constexpr int BM = 256, BK = 64, HALF = 128, HTB = HALF * BK * 2, NXCD = 8, WGM = 8;
__device__ __forceinline__ int lds_byte(int r, int c) { const int st = (r >> 4) * 2 + (c >> 5), rr = r & 15, cc = c & 31, ob = rr * 64 + cc * 2; return st * 1024 + (ob ^ (((ob >> 9) & 1) << 5)); }
__device__ __forceinline__ void stage_rc(int b, int& R, int& C) { const int st = b / 1024, sb = b % 1024, swz = sb ^ (((sb >> 9) & 1) << 5); R = (st >> 1) * 16 + swz / 64; C = (st & 1) * 32 + (swz % 64) / 2; }
__device__ __forceinline__ int perm32(int rho) { const int n = rho >> 4, i = rho & 15; return 8 * (i >> 2) + 4 * n + (i & 3); }
struct Unit { int pm, pn, k0, nk, split, tl, S; };
struct Gemm { const bf16_t* A; const bf16_t* Bt; int M, N, K; };
struct StaticOrder {
    int nM, nN, nwg, G, c, R, Lf, S, nt, heavy_first, reverse;
    __device__ __forceinline__ void init(int M, int N, int K, int G_, int c_, bool allow_split) {
        nM = M / BM; nN = N / BM; nwg = nM * nN; G = G_; c = c_; nt = K / BK; heavy_first = 0; reverse = 0;
        R = nwg / G; Lf = nwg - R * G; S = 1;
        if (allow_split && Lf > 0 && Lf * 2 <= G) { int smax = G / Lf; int s = nt / 4; while (s > 1 && (s > smax || nt % (2 * s) != 0)) --s; S = s; }
    }
    __device__ __forceinline__ void tile_pmpn(int L, Unit& u) const {
        int wgid = L; if (reverse) { const int xq = L % NXCD, xo = L / NXCD; const int cnt = nwg / NXCD + (xq < nwg % NXCD ? 1 : 0); wgid = xq + (cnt - 1 - xo) * NXCD; }
        { const int q = nwg / NXCD, r = nwg % NXCD, xcd = wgid % NXCD, off = wgid / NXCD; wgid = (xcd < r ? xcd * (q + 1) : r * (q + 1) + (xcd - r) * q) + off; }
        const int nig = WGM * nN, gid = wgid / nig, fm = gid * WGM, gsz = (nM - fm) < WGM ? (nM - fm) : WGM;
        u.pm = fm + ((wgid % nig) % gsz); u.pn = (wgid % nig) / gsz;
        if (heavy_first) { const int q = u.pn; u.pn = q < 2 ? 5 + q : (q < 4 ? 1 + q : q - 4); }
    }
    __device__ __forceinline__ bool next(int i, Unit& u) const {
        int L = 0, k0 = 0, nk = nt, split = 0, tl = 0; bool ok = false;
        if (i < R) { L = i * G + c; ok = true; }
        else if (i == R && S == 1) { L = R * G + c; ok = c < Lf; }
        else if (i == R) { tl = c % Lf; L = R * G + tl; nk = nt / S; k0 = (c / Lf) * nk; split = 1; ok = c < Lf * S; }
        if (!ok) L = 0;
        Unit t; tile_pmpn(L, t);
        u.pm = t.pm; u.pn = t.pn; u.k0 = k0; u.nk = nk; u.split = split; u.tl = tl; u.S = S;
        return ok;
    }
};

template <class Epi>
__device__ __forceinline__ void gemm_phase(LAS unsigned char* lds, const Gemm g, const StaticOrder& S, const Epi& E) {
    const int tid = tid_opaque(), wid = __builtin_amdgcn_readfirstlane(tid >> 6), lane = tid & 63, wr = wid >> 2, wc = wid & 3, fr = lane & 15, fq = lane >> 4;
    const int K = g.K;
    unsigned voffA[2], voffB[2];
#pragma unroll
    for (int i = 0; i < 2; ++i) { int R, C; stage_rc(tid * 16 + i * 8192, R, C); const int Rb = Epi::PERM ? ((R & ~31) + perm32(R & 31)) : R;
        const int Ra = Epi::APERM ? ((R & 64) | ((R & 15) << 2) | ((R >> 4) & 3)) : R;
        voffA[i] = (unsigned)(Ra * K + C) * 2u; voffB[i] = (unsigned)(Rb * K + C) * 2u; }
    const size_t kstep = (size_t)(BK * 2);
    const size_t hstep = (size_t)HALF * K * 2;
    const size_t tstep = 2 * hstep;
    const unsigned ldsw = (unsigned)wid * 1024u;
    const int aoff = lds_byte(wr * 64 + fr, fq * 8), boff = lds_byte(wc * 32 + fr, fq * 8);
#define PG8_SA(b, h) (((b) * 2 + (h)) * HTB)
#define PG8_SB(b, h) ((4 + (b) * 2 + (h)) * HTB)
#define PG8_STAGE(bufoff, gbase, voff) do { _Pragma("unroll") for (int _i = 0; _i < 2; ++_i) \
        __builtin_amdgcn_global_load_lds((const unsigned*)((const char*)(gbase) + (voff)[_i]), (LAS unsigned*)(lds + (bufoff) + ldsw + _i * 8192), 16, 0, 0); } while (0)
#define PG8_LDA(dst, b, h) do { _Pragma("unroll") for (int m = 0; m < 4; ++m) _Pragma("unroll") for (int k = 0; k < 2; ++k) dst[m][k] = *(const LAS bf16x8*)(lds + PG8_SA(b, h) + aoff + m * 2048 + k * 1024); } while (0)
#define PG8_LDB(dst, b, h) do { _Pragma("unroll") for (int n = 0; n < 2; ++n) _Pragma("unroll") for (int k = 0; k < 2; ++k) dst[n][k] = *(const LAS bf16x8*)(lds + PG8_SB(b, h) + boff + n * 2048 + k * 1024); } while (0)
#define PG8_MMA(ai, bj, At, Bt) do { __builtin_amdgcn_s_setprio(1); _Pragma("unroll") for (int m = 0; m < 4; ++m) _Pragma("unroll") for (int n = 0; n < 2; ++n) _Pragma("unroll") for (int k = 0; k < 2; ++k) \
        acc[ai][bj][m][n] = __builtin_amdgcn_mfma_f32_16x16x32_bf16(Bt[n][k], At[m][k], acc[ai][bj][m][n], 0, 0, 0); __builtin_amdgcn_s_setprio(0); } while (0)
#define PG8_WAIT_V(n) asm volatile("s_waitcnt vmcnt(" #n ")" ::: "memory")
#define PG8_WAIT_L(n) asm volatile("s_waitcnt lgkmcnt(" #n ")" ::: "memory")
#define PG8_BAR __builtin_amdgcn_s_barrier()
#define PG8_SCHED __builtin_amdgcn_sched_barrier(0)
    Unit cur, nxt; int ui = 0;
    if (!S.next(0, cur)) return;
    f32x4 acc[2][2][4][2];
#pragma unroll
    for (int a = 0; a < 2; ++a)
#pragma unroll
        for (int b = 0; b < 2; ++b)
#pragma unroll
            for (int m = 0; m < 4; ++m)
#pragma unroll
                for (int n = 0; n < 2; ++n) acc[a][b][m][n] = (f32x4){0.f, 0.f, 0.f, 0.f};
    bf16x8 At[4][2], B0[2][2], B1[2][2];
    const char* cA = (const char*)g.A + (size_t)cur.pm * tstep + (size_t)cur.k0 * kstep; const char* cB = (const char*)g.Bt + (size_t)cur.pn * tstep + (size_t)cur.k0 * kstep;
    PG8_STAGE(PG8_SB(0, 0), cB, voffB); PG8_STAGE(PG8_SB(0, 1), cB + hstep, voffB); PG8_STAGE(PG8_SA(0, 0), cA, voffA); PG8_STAGE(PG8_SA(0, 1), cA + hstep, voffA);
    if (wr == 1) PG8_BAR;
    PG8_WAIT_V(2); PG8_BAR;
    PG8_STAGE(PG8_SB(1, 0), cB + kstep, voffB); PG8_STAGE(PG8_SA(1, 0), cA + kstep, voffA); PG8_STAGE(PG8_SB(1, 1), cB + hstep + kstep, voffB);
    PG8_WAIT_V(6); PG8_BAR;
    for (;;) {
        const bool has_next = S.next(ui + 1, nxt);
        const char* nA = has_next ? (const char*)g.A + (size_t)nxt.pm * tstep + (size_t)nxt.k0 * kstep : cA; const char* nB = has_next ? (const char*)g.Bt + (size_t)nxt.pn * tstep + (size_t)nxt.k0 * kstep : cB;
        const int nt = cur.nk;
        for (int t = 0; t < nt; t += 2) {
            const bool last = (t == nt - 2);
            const char* a1 = cA + (size_t)(t + 1) * kstep;
            const char* a2 = last ? nA : cA + (size_t)(t + 2) * kstep; const char* b2 = last ? nB : cB + (size_t)(t + 2) * kstep;
            const char* a3 = a2 + kstep; const char* b3 = b2 + kstep;
            PG8_LDB(B0, 0, 0); PG8_LDB(B1, 0, 1); PG8_SCHED; PG8_LDA(At, 0, 0); PG8_STAGE(PG8_SA(1, 1), a1 + hstep, voffA);
            PG8_WAIT_V(8); PG8_WAIT_L(0); PG8_BAR; PG8_MMA(0, 0, At, B0); PG8_MMA(0, 1, At, B1); PG8_BAR; PG8_SCHED;
            PG8_LDA(At, 0, 1); PG8_STAGE(PG8_SB(0, 0), b2, voffB); PG8_STAGE(PG8_SB(0, 1), b2 + hstep, voffB); PG8_STAGE(PG8_SA(0, 0), a2, voffA);
            PG8_WAIT_V(8); PG8_WAIT_L(0); PG8_BAR; PG8_MMA(1, 0, At, B0); PG8_MMA(1, 1, At, B1); PG8_BAR; PG8_SCHED;
            PG8_LDB(B0, 1, 0); PG8_LDB(B1, 1, 1); PG8_SCHED; PG8_LDA(At, 1, 0); PG8_STAGE(PG8_SA(0, 1), a2 + hstep, voffA);
            PG8_WAIT_V(8); PG8_WAIT_L(0); PG8_BAR; PG8_MMA(0, 0, At, B0); PG8_MMA(0, 1, At, B1); PG8_BAR; PG8_SCHED;
            PG8_LDA(At, 1, 1); PG8_STAGE(PG8_SB(1, 0), b3, voffB); PG8_STAGE(PG8_SB(1, 1), b3 + hstep, voffB); PG8_STAGE(PG8_SA(1, 0), a3, voffA);
            PG8_WAIT_V(8); PG8_WAIT_L(0); PG8_BAR; PG8_MMA(1, 0, At, B0); PG8_MMA(1, 1, At, B1); PG8_BAR; PG8_SCHED;
        }
        if (wr == 0) PG8_BAR;
        if (!(Epi::CAN_SPLIT && cur.split)) E(acc, cur, wr, wc, fr, fq, lds + LDS_STAGE, wid);
        if (!has_next) break;
#pragma unroll
        for (int a = 0; a < 2; ++a)
#pragma unroll
            for (int b = 0; b < 2; ++b)
#pragma unroll
                for (int m = 0; m < 4; ++m)
#pragma unroll
                    for (int n = 0; n < 2; ++n) acc[a][b][m][n] = (f32x4){0.f, 0.f, 0.f, 0.f};
        cur = nxt; cA = nA; cB = nB; ++ui;
        if (wr == 1) PG8_BAR;
    }
    PG8_WAIT_V(0);
    PG8_BAR;
    if (Epi::CAN_SPLIT && cur.split) E(acc, cur, wr, wc, fr, fq, lds + LDS_STAGE, wid);
#undef PG8_SA
#undef PG8_SB
#undef PG8_STAGE
#undef PG8_LDA
#undef PG8_LDB
#undef PG8_MMA
#undef PG8_WAIT_V
#undef PG8_WAIT_L
#undef PG8_BAR
#undef PG8_SCHED
}
}
using pg8::Unit;

struct EpiMod {
    static constexpr bool PERM = false, CAN_SPLIT = false, APERM = false;
    float* MOD; const float* bias;
    __device__ __forceinline__ void operator()(const f32x4 (&acc)[2][2][4][2], const Unit& u, int wr, int wc, int fr, int fq, LAS unsigned char*, int) const {
        const int col0 = u.pn * 256 + wc * 32 + 4 * fq;
#pragma unroll
        for (int ai = 0; ai < 2; ++ai)
#pragma unroll
            for (int m = 0; m < 4; ++m) {
                const int r = ai * 128 + wr * 64 + m * 16 + fr;
                if (r < 132) {
#pragma unroll
                    for (int bj = 0; bj < 2; ++bj)
#pragma unroll
                        for (int n = 0; n < 2; ++n) { const int c = col0 + bj * 128 + n * 16; *(f32x4*)(MOD + (size_t)r * 12288 + c) = acc[ai][bj][m][n] + *(const f32x4*)(bias + c); }
                }
            }
    }
};

__device__ __forceinline__ f32x4 unpack4(u32x2 w) { f32x4 v; v[0] = __uint_as_float(w.x << 16); v[1] = __uint_as_float(w.x & 0xffff0000u); v[2] = __uint_as_float(w.y << 16); v[3] = __uint_as_float(w.y & 0xffff0000u); return v; }
template <bool INB, bool OUTB>
struct EpiRes {
    static constexpr bool PERM = false, CAN_SPLIT = true, APERM = false;
    const float* xin_p; const float* xin_s; const bf16_t* xin_b; float* xo_f; bf16_t* xo_b; const float* gate;
    unsigned char* ws; unsigned* ticket;
    __device__ __forceinline__ float* slab(int idx) const { return (float*)(idx < 136 ? ws + W_H + (size_t)idx * 262144 : ws + W_ADA + (size_t)(idx - 136) * 262144); }
    __device__ __forceinline__ f32x4 ldx(int r, int c) const {
        if (INB) return unpack4(*(const u32x2*)(xin_b + (size_t)r * 1024 + c));
        return *(const f32x4*)((r < NPR ? xin_p + (size_t)r * 1024 : xin_s + (size_t)(r - NPR) * 1024) + c);
    }
    __device__ __forceinline__ void stx(int r, int c, f32x4 v) const {
        if (OUTB) *(u32x2*)(xo_b + (size_t)r * 1024 + c) = pack4(v); else *(f32x4*)(xo_f + (size_t)r * 1024 + c) = v;
    }
    __device__ __forceinline__ void operator()(const f32x4 (&acc)[2][2][4][2], const Unit& u, int wr, int wc, int fr, int fq, LAS unsigned char*, int wid) const {
        const bool prompt = u.pm < 64;
        const int col0 = u.pn * 256 + wc * 32 + 4 * fq;
        if (!u.split) {
            f32x4 gu[2][2];
            if (prompt) {
#pragma unroll
                for (int bj = 0; bj < 2; ++bj)
#pragma unroll
                    for (int n = 0; n < 2; ++n) gu[bj][n] = *(const f32x4*)(gate + (size_t)(u.pm >> 4) * 12288 + col0 + bj * 128 + n * 16);
            }
            if (INB && prompt) {
                u32x2 xr[2][4][2][2];
#pragma unroll
                for (int ai = 0; ai < 2; ++ai)
#pragma unroll
                    for (int m = 0; m < 4; ++m) { const int r = u.pm * 256 + ai * 128 + wr * 64 + m * 16 + fr;
#pragma unroll
                        for (int bj = 0; bj < 2; ++bj)
#pragma unroll
                            for (int n = 0; n < 2; ++n) xr[ai][m][bj][n] = *(const u32x2*)(xin_b + (size_t)r * 1024 + col0 + bj * 128 + n * 16); }
#pragma unroll
                for (int ai = 0; ai < 2; ++ai)
#pragma unroll
                    for (int m = 0; m < 4; ++m) { const int r = u.pm * 256 + ai * 128 + wr * 64 + m * 16 + fr;
#pragma unroll
                        for (int bj = 0; bj < 2; ++bj)
#pragma unroll
                            for (int n = 0; n < 2; ++n) stx(r, col0 + bj * 128 + n * 16, unpack4(xr[ai][m][bj][n]) + gu[bj][n] * acc[ai][bj][m][n]); }
            } else {
            constexpr int MB = 2;
#pragma unroll
            for (int ai = 0; ai < 2; ++ai)
#pragma unroll
                for (int mb = 0; mb < 4; mb += MB) {
                    u32x2 xr[MB][2][2]; f32x4 xf[INB ? 1 : MB][2][2];
#pragma unroll
                    for (int m = 0; m < MB; ++m) { const int r = u.pm * 256 + ai * 128 + wr * 64 + (mb + m) * 16 + fr;
#pragma unroll
                        for (int bj = 0; bj < 2; ++bj)
#pragma unroll
                            for (int n = 0; n < 2; ++n) { const int c = col0 + bj * 128 + n * 16;
                                if (INB) xr[m][bj][n] = *(const u32x2*)(xin_b + (size_t)r * 1024 + c);
                                else xf[INB ? 0 : m][bj][n] = *(const f32x4*)((r < NPR ? xin_p + (size_t)r * 1024 : xin_s + (size_t)(r - NPR) * 1024) + c); } }
                    f32x4 gs[MB][2][2];
                    if (!prompt) {
#pragma unroll
                        for (int m = 0; m < MB; ++m) { const int r = u.pm * 256 + ai * 128 + wr * 64 + (mb + m) * 16 + fr; const float* gp = gate + (size_t)(4 + ((r - NPR) >> 3)) * 12288;
#pragma unroll
                            for (int bj = 0; bj < 2; ++bj)
#pragma unroll
                                for (int n = 0; n < 2; ++n) gs[m][bj][n] = *(const f32x4*)(gp + col0 + bj * 128 + n * 16); }
                    }
#pragma unroll
                    for (int m = 0; m < MB; ++m) { const int r = u.pm * 256 + ai * 128 + wr * 64 + (mb + m) * 16 + fr;
#pragma unroll
                        for (int bj = 0; bj < 2; ++bj)
#pragma unroll
                            for (int n = 0; n < 2; ++n) { const f32x4 x0 = INB ? unpack4(xr[m][bj][n]) : xf[INB ? 0 : m][bj][n];
                                const f32x4 gg = prompt ? gu[bj][n] : gs[m][bj][n];
                                stx(r, col0 + bj * 128 + n * 16, x0 + gg * acc[ai][bj][mb + m][n]); } }
                }
            }
        } else {
            __amdgpu_buffer_rsrc_t srs = __builtin_amdgcn_make_buffer_rsrc((void*)slab(u.tl * u.S + u.k0 / u.nk), 0, 262144, 0x00020000);
            const unsigned soff = (unsigned)(wc * 32 + 4 * fq) * 4u;
#pragma unroll
            for (int ai = 0; ai < 2; ++ai)
#pragma unroll
                for (int m = 0; m < 4; ++m) {
                    const int rl = ai * 128 + wr * 64 + m * 16 + fr;
                    const int r = u.pm * 256 + rl;
                    const int mrow = prompt ? (r >> 12) : 4 + ((r - NPR) >> 3);
                    const float* gp = gate + (size_t)mrow * 12288;
#pragma unroll
                    for (int bj = 0; bj < 2; ++bj)
#pragma unroll
                        for (int n = 0; n < 2; ++n) { const int c = col0 + bj * 128 + n * 16;
                            const f32x4 d = *(const f32x4*)(gp + c) * acc[ai][bj][m][n];
                            __builtin_amdgcn_raw_buffer_store_b128(__builtin_bit_cast(u32x4, d), srs, soff + (unsigned)(rl * 256 + bj * 128 + n * 16) * 4u, 0, 16); }
                }
        }
        if (u.split) {
            const int lane = fq * 16 + fr;
            asm volatile("s_waitcnt vmcnt(0)" ::: "memory");
            __syncthreads();
            if (threadIdx.x == 0) {
                unsigned* tk = ticket + u.tl;
                const unsigned need = (unsigned)u.S;
                __hip_atomic_fetch_add(tk, 1u, __ATOMIC_RELAXED, __HIP_MEMORY_SCOPE_AGENT);
                unsigned sp = 0;
                while (__hip_atomic_load(tk, __ATOMIC_RELAXED, __HIP_MEMORY_SCOPE_AGENT) < need) { __builtin_amdgcn_s_sleep(2); if (++sp > (1u << 19)) break; }
                __builtin_amdgcn_fence(__ATOMIC_ACQUIRE, "agent");
                asm volatile("s_waitcnt vmcnt(0)" ::: "memory");
            }
            __syncthreads();
            const int w = (u.k0 / u.nk) * 8 + wid, nw = 8 * u.S;
            for (int vb = w * 64 + lane; vb < 16384; vb += 8 * nw * 64) {
                f32x4 tot[8];
#pragma unroll
                for (int k = 0; k < 8; ++k) {
                    const int v = vb + k * nw * 64;
                    if (v < 16384) {
                        const int r = u.pm * 256 + (v >> 6), c = u.pn * 256 + (v & 63) * 4;
                        f32x4 s0 = ldx(r, c), s1 = (f32x4){0.f, 0.f, 0.f, 0.f}, s2 = s1, s3 = s1;
                        int q = 0;
                        for (; q + 4 <= u.S; q += 4) {
                            const f32x4 a0 = *(const f32x4*)(slab(u.tl * u.S + q) + (size_t)v * 4), a1 = *(const f32x4*)(slab(u.tl * u.S + q + 1) + (size_t)v * 4);
                            const f32x4 a2 = *(const f32x4*)(slab(u.tl * u.S + q + 2) + (size_t)v * 4), a3 = *(const f32x4*)(slab(u.tl * u.S + q + 3) + (size_t)v * 4);
                            s0 += a0; s1 += a1; s2 += a2; s3 += a3; }
                        for (; q < u.S; ++q) s1 += *(const f32x4*)(slab(u.tl * u.S + q) + (size_t)v * 4);
                        tot[k] = (s0 + s1) + (s2 + s3);
                    }
                }
#pragma unroll
                for (int k = 0; k < 8; ++k) {
                    const int v = vb + k * nw * 64;
                    if (v < 16384) stx(u.pm * 256 + (v >> 6), u.pn * 256 + (v & 63) * 4, tot[k]);
                }
            }
        }
    }
};

struct EpiIn {
    static constexpr bool PERM = true, CAN_SPLIT = false, APERM = false;
    int layer;
    const float* gq; const float* gk; const float* lng; const float* lnb; const float* rope;
    bf16_t* Q; bf16_t* KB; bf16_t* VB; bf16_t* U; bf16_t* VG; float* out;
    __device__ __forceinline__ void operator()(const f32x4 (&acc)[2][2][4][2], const Unit& u, int wr, int wc, int fr, int fq, LAS unsigned char* ex, int wid) const {
        const int pn = u.pn;
        const bool prompt = u.pm < 64;
        const int rbase = u.pm * 256 + wr * 64 + fr;
        const int dq = 8 * fq;
        if (false) {}
#ifndef NOQK
        else if (pn < 2 || (pn == 2 && wc < 2)) {
            const bool isk = (pn == 2);
            const float* g = isk ? gk : gq;
            f32x4 gv[2][2];
#pragma unroll
            for (int bj = 0; bj < 2; ++bj)
#pragma unroll
                for (int n = 0; n < 2; ++n) gv[bj][n] = *(const f32x4*)(g + bj * 32 + dq + 4 * n);
#pragma unroll
            for (int ai = 0; ai < 2; ++ai)
#pragma unroll
              for (int mb = 0; mb < 4; mb += 4) {
                f32x4 rcs[4][2], rsn[4][2];
#pragma unroll
                for (int mm = 0; mm < 4; ++mm) { const int r = rbase + ai * 128 + (mb + mm) * 16; const float* rp = rope + (prompt ? (r & 4095) : 4096 + (r & 7)) * 16;
#pragma unroll
                    for (int n = 0; n < 2; ++n) { rcs[mm][n] = *(const f32x4*)(rp + 4 * n); rsn[mm][n] = *(const f32x4*)(rp + 8 + 4 * n); } }
#pragma unroll
                for (int mm = 0; mm < 4; ++mm) {
                    const int m = mb + mm;
                    const int r = rbase + ai * 128 + m * 16;
                    float ss = 0.f;
#pragma unroll
                    for (int bj = 0; bj < 2; ++bj)
#pragma unroll
                        for (int n = 0; n < 2; ++n) { const f32x4 v = acc[ai][bj][m][n]; ss += v[0] * v[0] + v[1] * v[1] + v[2] * v[2] + v[3] * v[3]; }
                    ss = xsum_fq(ss);
                    const float rs = rsqrtf(ss * (1.0f / 64.0f) + 1e-6f);
                    f32x4 y[2][2];
#pragma unroll
                    for (int bj = 0; bj < 2; ++bj)
#pragma unroll
                        for (int n = 0; n < 2; ++n) y[bj][n] = acc[ai][bj][m][n] * rs * gv[bj][n];
#pragma unroll
                    for (int n = 0; n < 2; ++n) {
                        const f32x4 cs = rcs[mm][n], sn = rsn[mm][n];
#pragma unroll
                        for (int e = 0; e < 4; ++e) {
                            const float own = y[0][n][e];
                            const float oth = __shfl_xor(own, 16);
                            const float rot = (fq == 0) ? own * cs[e] - oth * sn[e] : own * cs[e] + oth * sn[e];
                            y[0][n][e] = (fq < 2) ? rot : own;
                        }
                    }
                    if (!isk) {
                        bf16_t* qp = Q + (size_t)r * 512 + (pn * 4 + wc) * 64 + dq;
                        *(u32x4*)(qp) = pack8(y[0][0], y[0][1]); *(u32x4*)(qp + 32) = pack8(y[1][0], y[1][1]);
                    } else {
                        bf16_t* kp = KB + (size_t)r * 128 + wc * 64 + dq;
                        *(u32x4*)(kp) = pack8(y[0][0], y[0][1]); *(u32x4*)(kp + 32) = pack8(y[1][0], y[1][1]);
                        float* op = nullptr;
                        if (!prompt) op = out + O_NKS + ((size_t)layer * 1024 + (r - NPR)) * 128;
                        else if ((r & 4095) >= 3968) op = out + O_NKP + (((size_t)layer * 4 + (r >> 12)) * 128 + ((r & 4095) - 3968)) * 128;
                        if (op) { op += wc * 64 + dq;
                            *(f32x4*)(op) = y[0][0]; *(f32x4*)(op + 4) = y[0][1]; *(f32x4*)(op + 32) = y[1][0]; *(f32x4*)(op + 36) = y[1][1]; }
                    }
                }
            }
        }
#endif
#ifndef NOV
        else if (pn == 2) {
#pragma unroll
            for (int ai = 0; ai < 2; ++ai)
#pragma unroll
                for (int m = 0; m < 4; ++m) {
                    const int r = rbase + ai * 128 + m * 16;
                    bf16_t* vp = VB + (size_t)r * 128 + (wc - 2) * 64 + dq;
                    *(u32x4*)(vp) = pack8(acc[ai][0][m][0], acc[ai][0][m][1]); *(u32x4*)(vp + 32) = pack8(acc[ai][1][m][0], acc[ai][1][m][1]);
                    float* op = nullptr;
                    if (!prompt) op = out + O_NVS + ((size_t)layer * 1024 + (r - NPR)) * 128;
                    else if ((r & 4095) >= 3968) op = out + O_NVP + (((size_t)layer * 4 + (r >> 12)) * 128 + ((r & 4095) - 3968)) * 128;
                    if (op) { op += (wc - 2) * 64 + dq;
                        *(f32x4*)(op) = acc[ai][0][m][0]; *(f32x4*)(op + 4) = acc[ai][0][m][1]; *(f32x4*)(op + 32) = acc[ai][1][m][0]; *(f32x4*)(op + 36) = acc[ai][1][m][1]; }
                }
        }
#endif
#ifndef NOU
        else if (pn < 5) {
#pragma unroll
            for (int ai = 0; ai < 2; ++ai)
#pragma unroll
                for (int m = 0; m < 4; ++m) {
                    const int r = rbase + ai * 128 + m * 16;
                    f32x4 y[2][2];
#pragma unroll
                    for (int bj = 0; bj < 2; ++bj)
#pragma unroll
                        for (int n = 0; n < 2; ++n)
#pragma unroll
                            for (int e = 0; e < 4; ++e) y[bj][n][e] = gelu_f(acc[ai][bj][m][n][e]);
                    bf16_t* up = U + (size_t)r * 512 + (pn - 3) * 256 + wc * 64 + dq;
                    *(u32x4*)(up) = pack8(y[0][0], y[0][1]); *(u32x4*)(up + 32) = pack8(y[1][0], y[1][1]);
                }
        }
#endif
#ifndef NOLN
        else {
            LAS f32x2* exo = (LAS f32x2*)ex + wid * 128 + fr;
            LAS f32x2* exp_ = (LAS f32x2*)ex + (wid ^ 1) * 128 + fr;
#pragma unroll
            for (int ai = 0; ai < 2; ++ai)
#pragma unroll
                for (int m = 0; m < 4; ++m) {
                    float a = 0.f, b = 0.f;
#pragma unroll
                    for (int bj = 0; bj < 2; ++bj)
#pragma unroll
                        for (int n = 0; n < 2; ++n)
#pragma unroll
                            for (int e = 0; e < 4; ++e) { const float gl = gelu_f(acc[ai][bj][m][n][e]); a += gl; b += gl * gl; }
                    a = xsum_fq(a); b = xsum_fq(b);
                    if (fq == 0) exo[(ai * 4 + m) * 16] = (f32x2){a, b};
                }
            asm volatile("s_waitcnt lgkmcnt(0)" ::: "memory");
            __builtin_amdgcn_s_barrier();
            asm volatile("" ::: "memory");
            const int grp = (pn - 5) * 2 + (wc >> 1);
            const int w0 = (wc & 1) * 64 + dq;
            f32x4 lgv[2][2], lbv[2][2];
#pragma unroll
            for (int bj = 0; bj < 2; ++bj)
#pragma unroll
                for (int n = 0; n < 2; ++n) { lgv[bj][n] = *(const f32x4*)(lng + grp * 128 + w0 + bj * 32 + 4 * n); lbv[bj][n] = *(const f32x4*)(lnb + grp * 128 + w0 + bj * 32 + 4 * n); }
#pragma unroll
            for (int ai = 0; ai < 2; ++ai)
#pragma unroll
                for (int m = 0; m < 4; ++m) {
                    const int r = rbase + ai * 128 + m * 16;
                    const f32x2 o0 = exo[(ai * 4 + m) * 16];
                    const f32x2 o1 = exp_[(ai * 4 + m) * 16];
                    const float mean = (o0.x + o1.x) * (1.0f / 128.0f);
                    const float var = fmaxf((o0.y + o1.y) * (1.0f / 128.0f) - mean * mean, 0.f);
                    const float rstd = rsqrtf(var + 1e-6f);
                    bf16_t* vp = VG + (size_t)r * 512 + grp * 128 + w0;
                    float* op = out + O_NGS + ((size_t)layer * 1024 + (r - NPR)) * 512 + grp * 128 + w0;
#pragma unroll
                    for (int bj = 0; bj < 2; ++bj) {
                        f32x4 g0, g1;
#pragma unroll
                        for (int e = 0; e < 4; ++e) { float x0 = acc[ai][bj][m][0][e], x1 = acc[ai][bj][m][1][e]; asm volatile("" : "+v"(x0), "+v"(x1)); g0[e] = gelu_f(x0); g1[e] = gelu_f(x1); }
                        const f32x4 y0 = (g0 - mean) * rstd * lgv[bj][0] + lbv[bj][0];
                        const f32x4 y1 = (g1 - mean) * rstd * lgv[bj][1] + lbv[bj][1];
                        *(u32x4*)(vp + bj * 32) = pack8(y0, y1);
                        if (!prompt) { *(f32x4*)(op + bj * 32) = y0; *(f32x4*)(op + bj * 32 + 4) = y1; }
                    }
                    asm volatile("" ::: "memory");
                }
        }
#endif
    }
};

struct EpiFfnIn {
    static constexpr bool PERM = true, CAN_SPLIT = false, APERM = true;
    const float* cw; const float* cb; const float* cc;
    bf16_t* ACT; bf16_t* HALO; float* ncs; float* ncp;
    __device__ __forceinline__ static f32x4 shr1(f32x4 v) { f32x4 r; r[0] = dppf<0x111>(v[0]); r[1] = dppf<0x111>(v[1]); r[2] = dppf<0x111>(v[2]); r[3] = dppf<0x111>(v[3]); return r; }
    __device__ __forceinline__ static f32x4 act4(f32x4 g, f32x4 u) { f32x4 a; a[0] = silu_f(g[0]) * u[0]; a[1] = silu_f(g[1]) * u[1]; a[2] = silu_f(g[2]) * u[2]; a[3] = silu_f(g[3]) * u[3]; return a; }
    __device__ __forceinline__ void operator()(const f32x4 (&acc)[2][2][4][2], const Unit& u, int wr, int wc, int fr, int fq, LAS unsigned char*, int) const {
        const bool prompt = u.pm < 64;
        const int gc0 = u.pn * 128 + wc * 32 + 8 * fq;
        u32x2 res[2][2][4];
#pragma unroll
        for (int n = 0; n < 2; ++n) {
            const int gc = gc0 + 4 * n;
            const f32x4 w0g = *(const f32x4*)(cw + gc), w1g = *(const f32x4*)(cw + 5632 + gc), w2g = *(const f32x4*)(cw + 11264 + gc), bg = *(const f32x4*)(cb + gc);
            const f32x4 w0u = *(const f32x4*)(cw + 2816 + gc), w1u = *(const f32x4*)(cw + 5632 + 2816 + gc), w2u = *(const f32x4*)(cw + 11264 + 2816 + gc), bu = *(const f32x4*)(cb + 2816 + gc);
#pragma unroll
            for (int ai = 0; ai < 2; ++ai) {
                const int r0 = u.pm * 256 + ai * 128 + wr * 64 + 4 * fr;
                const f32x4 g0 = acc[ai][0][0][n], g1 = acc[ai][0][1][n], g2 = acc[ai][0][2][n], g3 = acc[ai][0][3][n];
                const f32x4 u0 = acc[ai][1][0][n], u1 = acc[ai][1][1][n], u2 = acc[ai][1][2][n], u3 = acc[ai][1][3][n];
                f32x4 pg2 = shr1(g2), pg3 = shr1(g3), pu2 = shr1(u2), pu3 = shr1(u3);
                if (!prompt && (fr & 1) == 0) { const float* cp = cc + (size_t)((r0 - NPR) >> 3) * 2 * 5632;
                    pg2 = *(const f32x4*)(cp + gc); pg3 = *(const f32x4*)(cp + 5632 + gc); pu2 = *(const f32x4*)(cp + 2816 + gc); pu3 = *(const f32x4*)(cp + 5632 + 2816 + gc); }
                res[n][ai][0] = pack4(act4(bg + w0g * pg2 + w1g * pg3 + w2g * g0, bu + w0u * pu2 + w1u * pu3 + w2u * u0));
                res[n][ai][1] = pack4(act4(bg + w0g * pg3 + w1g * g0 + w2g * g1, bu + w0u * pu3 + w1u * u0 + w2u * u1));
                res[n][ai][2] = pack4(act4(bg + w0g * g0 + w1g * g1 + w2g * g2, bu + w0u * u0 + w1u * u1 + w2u * u2));
                res[n][ai][3] = pack4(act4(bg + w0g * g1 + w1g * g2 + w2g * g3, bu + w0u * u1 + w1u * u2 + w2u * u3));
            }
        }
#pragma unroll
        for (int ai = 0; ai < 2; ++ai) {
            const int r0 = u.pm * 256 + ai * 128 + wr * 64 + 4 * fr;
            bf16_t* ap = ACT + (size_t)r0 * 2816 + gc0;
#pragma unroll
            for (int m = 0; m < 4; ++m) *(u32x4*)(ap + m * 2816) = (u32x4){res[0][ai][m].x, res[0][ai][m].y, res[1][ai][m].x, res[1][ai][m].y};
#pragma unroll
            for (int n = 0; n < 2; ++n) {
                const int gc = gc0 + 4 * n;
                const f32x4 g0 = acc[ai][0][0][n], g1 = acc[ai][0][1][n], g2 = acc[ai][0][2][n], g3 = acc[ai][0][3][n];
                const f32x4 u0 = acc[ai][1][0][n], u1 = acc[ai][1][1][n], u2 = acc[ai][1][2][n], u3 = acc[ai][1][3][n];
                if (prompt) {
                    if (fr == 0) { bf16_t* hp = HALO + (size_t)(r0 >> 6) * 4 * 5632;
                        *(u32x2*)(hp + gc) = pack4(g0); *(u32x2*)(hp + 2816 + gc) = pack4(u0); *(u32x2*)(hp + 5632 + gc) = pack4(g1); *(u32x2*)(hp + 5632 + 2816 + gc) = pack4(u1); }
                    if (fr == 15) { bf16_t* hp = HALO + ((size_t)(r0 >> 6) * 4 + 2) * 5632;
                        *(u32x2*)(hp + gc) = pack4(g2); *(u32x2*)(hp + 2816 + gc) = pack4(u2); *(u32x2*)(hp + 5632 + gc) = pack4(g3); *(u32x2*)(hp + 5632 + 2816 + gc) = pack4(u3);
                        if ((r0 & 4095) == 4092) { float* op = ncp + (size_t)(r0 >> 12) * 2 * 5632;
                            *(f32x4*)(op + gc) = g2; *(f32x4*)(op + 2816 + gc) = u2; *(f32x4*)(op + 5632 + gc) = g3; *(f32x4*)(op + 5632 + 2816 + gc) = u3; } }
                } else if (fr & 1) { float* op = ncs + (size_t)((r0 - NPR) >> 3) * 2 * 5632;
                    *(f32x4*)(op + gc) = g2; *(f32x4*)(op + 2816 + gc) = u2; *(f32x4*)(op + 5632 + gc) = g3; *(f32x4*)(op + 5632 + 2816 + gc) = u3; }
            }
        }
    }
};

__device__ __forceinline__ int perm_row(int nn, int ptype) {
    if (ptype == 1) { const int pn = nn >> 8, j = nn & 255; return pn * 256 + ((j >> 5) & 1) * 128 + (j >> 6) * 32 + (j & 31); }
    if (ptype == 2) { const int h = nn >= 2816 ? 1 : 0, jj = nn - h * 2816; return (jj >> 7) * 256 + h * 128 + (jj & 127); }
    return nn;
}
struct ConvJob { const float* src; bf16_t* dst; int N, K, k0, n0, ptype; };
__device__ __forceinline__ void conv_load(const ConvJob& jb, int tid, f32x4 (&v)[8]) {
#pragma unroll
    for (int i = 0; i < 8; ++i) { const int idx = tid + i * 512, kk = idx >> 6, c4 = idx & 63; v[i] = *(const f32x4*)(jb.src + (size_t)(jb.k0 + kk) * jb.N + jb.n0 + c4 * 4); }
}
__device__ __forceinline__ void conv_to_lds(int tid, const f32x4 (&v)[8], float* tl) {
#pragma unroll
    for (int i = 0; i < 8; ++i) { const int idx = tid + i * 512, kk = idx >> 6, c4 = idx & 63; float* t = tl + kk * 257 + c4 * 4; t[0] = v[i][0]; t[1] = v[i][1]; t[2] = v[i][2]; t[3] = v[i][3]; }
}
__device__ __forceinline__ void conv_store(const ConvJob& jb, int tid, const float* tl) {
#pragma unroll
    for (int i = 0; i < 4; ++i) {
        const int idx = tid + i * 512, kg = idx & 7, n = idx >> 3;
        const float* t = tl + (kg * 8) * 257 + n;
        u32x4 w; w.x = cvt_pk_bf16(t[0], t[257]); w.y = cvt_pk_bf16(t[2 * 257], t[3 * 257]); w.z = cvt_pk_bf16(t[4 * 257], t[5 * 257]); w.w = cvt_pk_bf16(t[6 * 257], t[7 * 257]);
        *(u32x4*)(jb.dst + (size_t)perm_row(jb.n0 + n, jb.ptype) * jb.K + jb.k0 + kg * 8) = w;
    }
}
__device__ __forceinline__ ConvJob conv_job_main(const Params& p, int j) {
    ConvJob jb; int l, t;
    if (j < 224) { l = j / 112; t = j % 112; jb.N = 1792; jb.K = 1024; jb.ptype = 1; jb.src = p.in[10] + (size_t)l * 1024 * 1792; jb.dst = (bf16_t*)(p.ws + W_IN) + (size_t)l * 1792 * 1024; }
    else if (j < 352) { j -= 224; l = j / 64; t = j % 64; jb.N = 1024; jb.K = 1024; jb.ptype = 0; jb.src = p.in[18] + (size_t)l * 1024 * 1024; jb.dst = (bf16_t*)(p.ws + W_OUT) + (size_t)l * 1024 * 1024; }
    else if (j < 1056) { j -= 352; l = j / 352; t = j % 352; jb.N = 5632; jb.K = 1024; jb.ptype = 2; jb.src = p.in[20] + (size_t)l * 1024 * 5632; jb.dst = (bf16_t*)(p.ws + W_FIN) + (size_t)l * 5632 * 1024; }
    else { j -= 1056; l = j / 176; t = j % 176; jb.N = 1024; jb.K = 2816; jb.ptype = 0; jb.src = p.in[23] + (size_t)l * 2816 * 1024; jb.dst = (bf16_t*)(p.ws + W_FOUT) + (size_t)l * 1024 * 2816; }
    const int nn = jb.N / 256; jb.k0 = (t / nn) * 64; jb.n0 = (t % nn) * 256;
    return jb;
}
__device__ __forceinline__ ConvJob conv_job_ada(const Params& p, int j) {
    ConvJob jb; const int l = j / 384, t = j % 384;
    jb.N = 6144; jb.K = 1024; jb.ptype = 0; jb.src = p.in[7] + (size_t)l * 1024 * 6144; jb.dst = (bf16_t*)(p.ws + W_ADA) + (size_t)l * 6144 * 1024; jb.k0 = (t / 24) * 64; jb.n0 = (t % 24) * 256;
    return jb;
}
template <bool ADA>
__device__ __forceinline__ void conv_run(const Params& p, int j0, int step, int njobs, float* tl) {
    const int tid = tid_opaque();
    if (j0 >= njobs) return;
    ConvJob cur = ADA ? conv_job_ada(p, j0) : conv_job_main(p, j0);
    f32x4 v[8];
    conv_load(cur, tid, v);
    for (int j = j0; j < njobs; j += step) {
        conv_to_lds(tid, v, tl);
        __syncthreads();
        const int jn = j + step; const bool hn = jn < njobs;
        ConvJob nxt = cur;
        if (hn) { nxt = ADA ? conv_job_ada(p, jn) : conv_job_main(p, jn); conv_load(nxt, tid, v); }
        conv_store(cur, tid, tl);
        __syncthreads();
        cur = nxt;
    }
}

__device__ __forceinline__ void phase_prep(const Params& p, unsigned char* shm) {
    float* tl = (float*)shm;
    const int nb = gridDim.x, bid = blockIdx.x, tid = tid_opaque();
    conv_run<true>(p, bid, nb, 768, tl);
    const int gtid = bid * 512 + tid, gn = nb * 512;
    bf16_t* CS = (bf16_t*)(p.ws + W_CS);
    for (int i = gtid; i < 256 * 1024 / 2; i += gn) { const int e = i * 2, row = e >> 10; float a = 0.f, b = 0.f;
        if (row < 4) { a = p.in[5][e]; b = p.in[5][e + 1]; } else if (row < 132) { a = p.in[6][e - 4096]; b = p.in[6][e - 4096 + 1]; }
        *(unsigned*)(CS + e) = cvt_pk_bf16(silu_f(a), silu_f(b)); }
    float* RT = (float*)(p.ws + W_ROPE);
    for (int i = gtid; i < 4104 * 8; i += gn) { const int pidx = i >> 3, a = i & 7; const int pos = pidx < 4096 ? pidx : 16384 + (pidx - 4096);
        const double ang = (double)pos * p.inv[a];
        const double kq = rint(ang * 0.63661977236758134308);
        double rr = fma(-kq, 1.5707963267948966192, ang); rr = fma(-kq, 6.123233995736766036e-17, rr);
        const double r2 = rr * rr;
        const double sn = rr * (1.0 + r2 * (-1.0 / 6 + r2 * (1.0 / 120 + r2 * (-1.0 / 5040 + r2 * (1.0 / 362880 + r2 * (-1.0 / 39916800))))));
        const double cs = 1.0 + r2 * (-0.5 + r2 * (1.0 / 24 + r2 * (-1.0 / 720 + r2 * (1.0 / 40320 + r2 * (-1.0 / 3628800 + r2 * (1.0 / 479001600))))));
        const int q = ((int)((long long)kq & 3));
        double c_, s_;
        if (q == 0) { c_ = cs; s_ = sn; } else if (q == 1) { c_ = -sn; s_ = cs; } else if (q == 2) { c_ = -cs; s_ = -sn; } else { c_ = sn; s_ = -cs; }
        RT[pidx * 16 + a] = (float)c_; RT[pidx * 16 + 8 + a] = (float)s_; }
    bf16_t* WSB = (bf16_t*)(p.ws + W_WS);
    for (int i = gtid; i < 2 * 4 * 128 * 128 / 2; i += gn) { const int e = i * 2, s = e & 127, t = (e >> 7) & 127;
        const float a = (s <= t) ? p.in[16][e] : 0.f, b = (s + 1 <= t) ? p.in[16][e + 1] : 0.f;
        *(unsigned*)(WSB + e) = cvt_pk_bf16(a, b); }
}

template <bool INB>
__device__ __forceinline__ void phase_norm(const float* xp, const float* xs, const bf16_t* xb, const float* gvec, const float* mod_sh, const float* mod_sc, bf16_t* H) {
    const int tid = tid_opaque(); const int wid = tid >> 6, lane = tid & 63;
    const int nw = gridDim.x * 8;
    f32x4 g[4];
#pragma unroll
    for (int i = 0; i < 4; ++i) g[i] = *(const f32x4*)(gvec + i * 256 + lane * 4);
    int r = blockIdx.x * 8 + wid;
    f32x4 v[4], sc[4], sh[4];
    auto load_row = [&](int rr, f32x4 (&vv)[4], f32x4 (&scc)[4], f32x4 (&shh)[4]) {
        const int mrow = rr < NPR ? (rr >> 12) : 4 + ((rr - NPR) >> 3);
#pragma unroll
        for (int i = 0; i < 4; ++i) { const int c = i * 256 + lane * 4;
            if (INB) vv[i] = unpack4(*(const u32x2*)(xb + (size_t)rr * 1024 + c));
            else vv[i] = *(const f32x4*)((rr < NPR ? xp + (size_t)rr * 1024 : xs + (size_t)(rr - NPR) * 1024) + c);
            scc[i] = *(const f32x4*)(mod_sc + (size_t)mrow * 12288 + c); shh[i] = *(const f32x4*)(mod_sh + (size_t)mrow * 12288 + c); }
    };
    if (r < MT) load_row(r, v, sc, sh);
    while (r < MT) {
        const int rn = r + nw; const int rnc = rn < MT ? rn : r;
        f32x4 v2[4], sc2[4], sh2[4];
        load_row(rnc, v2, sc2, sh2);
        float ss = 0.f;
#pragma unroll
        for (int i = 0; i < 4; ++i) ss += v[i][0] * v[i][0] + v[i][1] * v[i][1] + v[i][2] * v[i][2] + v[i][3] * v[i][3];
#pragma unroll
        for (int o = 32; o >= 1; o >>= 1) ss += __shfl_xor(ss, o);
        const float rs = rsqrtf(ss * (1.0f / 1024.0f) + 1e-6f);
#pragma unroll
        for (int i = 0; i < 4; ++i) *(u32x2*)(H + (size_t)r * 1024 + i * 256 + lane * 4) = pack4(v[i] * rs * g[i] * (sc[i] + 1.0f) + sh[i]);
#pragma unroll
        for (int i = 0; i < 4; ++i) { v[i] = v2[i]; sc[i] = sc2[i]; sh[i] = sh2[i]; }
        r = rn;
    }
}

__device__ __forceinline__ void attn_unit(const Params& p, int layer, bool sample, int b, int blk, int kvh, unsigned char* shm) {
    bf16_t* Ks = (bf16_t*)shm;
    bf16_t* Vt = Ks + 256 * 72;
    bf16_t* Pw = Vt + 64 * 280;
    const bf16_t* Q = (const bf16_t*)(p.ws + W_Q); const bf16_t* KB = (const bf16_t*)(p.ws + W_KB); const bf16_t* VB = (const bf16_t*)(p.ws + W_VB);
    bf16_t* MIX = (bf16_t*)(p.ws + W_MIX);
    const int tid = tid_opaque(), wid = tid >> 6, lane = tid & 63, fr = lane & 15, fq = lane >> 4;
    if (!sample) {
        const int row0 = b * 4096 + blk * 128 - 128;
#pragma unroll
        for (int i = 0; i < 4; ++i) { const int idx = tid + i * 512, j = idx >> 3, c8 = idx & 7; int gr = row0 + j; if (gr < b * 4096) gr += 128;
            *(u32x4*)(Ks + j * 72 + c8 * 8) = *(const u32x4*)(KB + (size_t)gr * 128 + kvh * 64 + c8 * 8); }
#pragma unroll
        for (int i = 0; i < 4; ++i) { const int idx = tid + i * 512, j = idx & 255, c8 = idx >> 8; int gr = row0 + j; if (gr < b * 4096) gr += 128;
            const u32x4 v = *(const u32x4*)(VB + (size_t)gr * 128 + kvh * 64 + c8 * 8);
            bf16_t* d = Vt + (c8 * 8) * 280 + j;
            d[0] = (bf16_t)(v.x & 0xffff); d[280] = (bf16_t)(v.x >> 16); d[2 * 280] = (bf16_t)(v.y & 0xffff); d[3 * 280] = (bf16_t)(v.y >> 16);
            d[4 * 280] = (bf16_t)(v.z & 0xffff); d[5 * 280] = (bf16_t)(v.z >> 16); d[6 * 280] = (bf16_t)(v.w & 0xffff); d[7 * 280] = (bf16_t)(v.w >> 16); }
        for (int i = tid; i < 64 * 24; i += 512) Vt[(i / 24) * 280 + 256 + (i % 24)] = 0;
    } else {
        const float* ck = p.in[2] + ((size_t)(layer * 128 + b) * 128) * 128 + kvh * 64;
        const float* cv = p.in[3] + ((size_t)(layer * 128 + b) * 128) * 128 + kvh * 64;
#pragma unroll
        for (int i = 0; i < 4; ++i) { const int idx = tid + i * 512, j = idx >> 4, c4 = idx & 15;
            const f32x4 v = *(const f32x4*)(ck + (size_t)j * 128 + c4 * 4); *(u32x2*)(Ks + j * 72 + c4 * 4) = pack4(v); }
#pragma unroll
        for (int i = 0; i < 4; ++i) { const int idx = tid + i * 512, j = idx & 127, c4 = idx >> 7;
            const f32x4 v = *(const f32x4*)(cv + (size_t)j * 128 + c4 * 4); const u32x2 w = pack4(v);
            bf16_t* d = Vt + (c4 * 4) * 280 + j;
            d[0] = (bf16_t)(w.x & 0xffff); d[280] = (bf16_t)(w.x >> 16); d[2 * 280] = (bf16_t)(w.y & 0xffff); d[3 * 280] = (bf16_t)(w.y >> 16); }
        if (tid < 128) { const int s = tid >> 3, c8 = tid & 7; u32x4 v = (u32x4){0u, 0u, 0u, 0u};
            if (s < 8) v = *(const u32x4*)(KB + (size_t)(NPR + b * 8 + s) * 128 + kvh * 64 + c8 * 8);
            *(u32x4*)(Ks + (128 + s) * 72 + c8 * 8) = v;
        } else if (tid < 256) { const int t2 = tid - 128, s = t2 & 15, c8 = t2 >> 4; u32x4 v = (u32x4){0u, 0u, 0u, 0u};
            if (s < 8) v = *(const u32x4*)(VB + (size_t)(NPR + b * 8 + s) * 128 + kvh * 64 + c8 * 8);
            bf16_t* d = Vt + (c8 * 8) * 280 + 128 + s;
            d[0] = (bf16_t)(v.x & 0xffff); d[280] = (bf16_t)(v.x >> 16); d[2 * 280] = (bf16_t)(v.y & 0xffff); d[3 * 280] = (bf16_t)(v.y >> 16);
            d[4 * 280] = (bf16_t)(v.z & 0xffff); d[5 * 280] = (bf16_t)(v.z >> 16); d[6 * 280] = (bf16_t)(v.w & 0xffff); d[7 * 280] = (bf16_t)(v.w >> 16);
        } else { const int t2 = tid - 256; for (int i = t2; i < 64 * 16; i += 256) Vt[(i >> 4) * 280 + 144 + (i & 15)] = 0; }
    }
    __syncthreads();
    const int hh = wid >> 1, half = wid & 1, head = kvh * 4 + hh;
    const int ntile = sample ? (half == 0 ? 1 : 0) : 4;
    const int kmin = sample ? 0 : (blk == 0 ? 128 : 0), kmax = sample ? 136 : 256;
    const float sink = p.in[13][layer * 8 + head];
    bf16_t* Pme = Pw + wid * 16 * 168;
    u32x2 ores[4][4];
    for (int rt = 0; rt < ntile; ++rt) {
        const int i0 = sample ? 0 : half * 64 + rt * 16;
        const int qi = sample ? (fr & 7) : i0 + fr;
        const size_t grow = sample ? (size_t)(NPR + b * 8 + qi) : (size_t)(b * 4096 + blk * 128 + qi);
        const bf16_t* qp = Q + grow * 512 + head * 64;
        bf16x8 qf[2]; qf[0] = *(const bf16x8*)(qp + fq * 8); qf[1] = *(const bf16x8*)(qp + 32 + fq * 8);
        f32x4 s[9];
#pragma unroll
        for (int kt = 0; kt < 9; ++kt) { s[kt] = (f32x4){0.f, 0.f, 0.f, 0.f};
#pragma unroll
            for (int ks = 0; ks < 2; ++ks) { const bf16x8 kf = *(const bf16x8*)(Ks + (i0 + 16 * kt + fr) * 72 + ks * 32 + fq * 8);
                s[kt] = __builtin_amdgcn_mfma_f32_16x16x32_bf16(kf, qf[ks], s[kt], 0, 0, 0); } }
        const float sink2 = sink * 1.4426950408889634f;
        float mx = sink2;
#pragma unroll
        for (int kt = 0; kt < 9; ++kt)
#pragma unroll
            for (int e = 0; e < 4; ++e) { const int kb = i0 + 16 * kt + 4 * fq + e;
                const bool valid = (!sample && kt >= 1 && kt <= 7) ? (i0 + 16 * kt >= kmin) : ((kb >= qi + 1) && (kb <= qi + 128) && (kb >= kmin) && (kb < kmax));
                const float sc = valid ? s[kt][e] * 0.18033688011112042f : -1e30f; s[kt][e] = sc; mx = fmaxf(mx, sc); }
        mx = xmax_fq(mx);
        float sum = 0.f;
#pragma unroll
        for (int kt = 0; kt < 9; ++kt)
#pragma unroll
            for (int e = 0; e < 4; ++e) { const float pe = __builtin_amdgcn_exp2f(s[kt][e] - mx); s[kt][e] = pe; sum += pe; }
        sum = xsum_fq(sum) + __builtin_amdgcn_exp2f(sink2 - mx);
        const float inv = 1.0f / sum;
#pragma unroll
        for (int kt = 0; kt < 9; ++kt) *(u32x2*)(Pme + fr * 168 + 16 * kt + 4 * fq) = pack4(s[kt]);
        *(u32x2*)(Pme + fr * 168 + 144 + 4 * fq) = (u32x2){0u, 0u};
        asm volatile("s_waitcnt lgkmcnt(0)" ::: "memory");
        f32x4 o[4];
#pragma unroll
        for (int dt = 0; dt < 4; ++dt) o[dt] = (f32x4){0.f, 0.f, 0.f, 0.f};
#pragma unroll
        for (int ks = 0; ks < 5; ++ks) { const bf16x8 pf = *(const bf16x8*)(Pme + fr * 168 + ks * 32 + fq * 8);
#pragma unroll
            for (int dt = 0; dt < 4; ++dt) { const bf16x8 vf = *(const bf16x8*)(Vt + (16 * dt + fr) * 280 + i0 + ks * 32 + fq * 8);
                o[dt] = __builtin_amdgcn_mfma_f32_16x16x32_bf16(vf, pf, o[dt], 0, 0, 0); } }
#pragma unroll
        for (int dt = 0; dt < 4; ++dt) {
            const u32x2 pk = pack4(o[dt] * inv);
            if (rt == 0) ores[0][dt] = pk; else if (rt == 1) ores[1][dt] = pk; else if (rt == 2) ores[2][dt] = pk; else ores[3][dt] = pk; }
        asm volatile("s_waitcnt lgkmcnt(0)" ::: "memory");
    }
#pragma unroll
    for (int rt = 0; rt < 4; ++rt) {
        if (rt < ntile && (!sample || fr < 8)) {
            const int qi = sample ? (fr & 7) : half * 64 + rt * 16 + fr;
            const size_t grow = sample ? (size_t)(NPR + b * 8 + qi) : (size_t)(b * 4096 + blk * 128 + qi);
            bf16_t* mp = MIX + grow * 1024 + head * 64 + 4 * fq;
#pragma unroll
            for (int dt = 0; dt < 4; ++dt) *(u32x2*)(mp + 16 * dt) = ores[rt][dt];
        }
    }
    __syncthreads();
}

__device__ __forceinline__ void sg_unit(const Params& p, int layer, int b, int chunk, int g, unsigned char* shm) {
    bf16_t* VGt = (bf16_t*)shm;
    const bf16_t* U = (const bf16_t*)(p.ws + W_U); const bf16_t* VG = (const bf16_t*)(p.ws + W_VG); const bf16_t* WSB = (const bf16_t*)(p.ws + W_WS);
    bf16_t* MIX = (bf16_t*)(p.ws + W_MIX);
    const int tid = tid_opaque(), wid = tid >> 6, lane = tid & 63, fr = lane & 15, fq = lane >> 4;
    const int rb = b * 4096 + chunk * 128;
    const int t0 = 16 * wid, nks = (wid >> 1) + 1;
    const bf16_t* wp = WSB + ((size_t)(layer * 4 + g) * 128 + t0 + fr) * 128 + fq * 8;
    bf16x8 wfa[4];
#pragma unroll
    for (int ks = 0; ks < 4; ++ks) wfa[ks] = *(const bf16x8*)(wp + ks * 32);
    const float bs = p.in[17][(layer * 4 + g) * 128 + t0 + fr];
    const size_t row = (size_t)(rb + t0 + fr);
    u32x2 ua[8];
#pragma unroll
    for (int wt = 0; wt < 8; ++wt) ua[wt] = *(const u32x2*)(U + row * 512 + g * 128 + 16 * wt + 4 * fq);
#pragma unroll
    for (int i = 0; i < 4; ++i) { const int idx = tid + i * 512, s = idx & 127, c8 = idx >> 7;
        const u32x4 v = *(const u32x4*)(VG + (size_t)(rb + s) * 512 + g * 128 + c8 * 8);
        bf16_t* d = VGt + (c8 * 8) * 136 + s;
        d[0] = (bf16_t)(v.x & 0xffff); d[136] = (bf16_t)(v.x >> 16); d[2 * 136] = (bf16_t)(v.y & 0xffff); d[3 * 136] = (bf16_t)(v.y >> 16);
        d[4 * 136] = (bf16_t)(v.z & 0xffff); d[5 * 136] = (bf16_t)(v.z >> 16); d[6 * 136] = (bf16_t)(v.w & 0xffff); d[7 * 136] = (bf16_t)(v.w >> 16); }
    __syncthreads();
    f32x4 z[8];
#pragma unroll
    for (int wt = 0; wt < 8; ++wt) z[wt] = (f32x4){0.f, 0.f, 0.f, 0.f};
#pragma unroll
    for (int ks = 0; ks < 4; ++ks) { if (ks >= nks) break;
#pragma unroll
        for (int wt = 0; wt < 8; ++wt) { const bf16x8 vf = *(const bf16x8*)(VGt + (16 * wt + fr) * 136 + ks * 32 + fq * 8);
            z[wt] = __builtin_amdgcn_mfma_f32_16x16x32_bf16(vf, wfa[ks], z[wt], 0, 0, 0); } }
#pragma unroll
    for (int wt = 0; wt < 8; ++wt) { const int c = g * 128 + 16 * wt + 4 * fq;
        const u32x2 uu = ua[wt];
        f32x4 o; o[0] = __uint_as_float(uu.x << 16) * (z[wt][0] + bs); o[1] = __uint_as_float(uu.x & 0xffff0000u) * (z[wt][1] + bs);
        o[2] = __uint_as_float(uu.y << 16) * (z[wt][2] + bs); o[3] = __uint_as_float(uu.y & 0xffff0000u) * (z[wt][3] + bs);
        *(u32x2*)(MIX + row * 1024 + 512 + c) = pack4(o); }
    __syncthreads();
}

__device__ __forceinline__ void phase_mix(const Params& p, int layer, unsigned char* shm) {
    const int nb = gridDim.x, bid = blockIdx.x;
#ifndef NO_MIXA
    for (int u = bid; u < 256; u += nb) attn_unit(p, layer, false, u >> 6, (u >> 1) & 31, u & 1, shm);
#endif
#ifndef NO_MIXB
    for (int u = bid; u < 256; u += nb) attn_unit(p, layer, true, u >> 1, 0, u & 1, shm);
#endif
#ifndef NO_MIXC
    for (int u = bid; u < 512; u += nb) sg_unit(p, layer, u >> 7, (u >> 2) & 31, u & 3, shm);
#endif
    const bf16_t* U = (const bf16_t*)(p.ws + W_U); const bf16_t* VG = (const bf16_t*)(p.ws + W_VG); bf16_t* MIX = (bf16_t*)(p.ws + W_MIX);
    for (int idx = bid * 512 + tid_opaque(); idx < 1024 * 128; idx += nb * 512) {
        const int r = idx >> 7, c4 = (idx & 127) * 4, b = r >> 3, t = r & 7, g = c4 >> 7;
        const float* wrow = p.in[16] + ((size_t)(layer * 4 + g) * 128 + t) * 128;
        f32x4 z = (f32x4){0.f, 0.f, 0.f, 0.f};
        const f32x4 wa = *(const f32x4*)(wrow), wb = *(const f32x4*)(wrow + 4);
        u32x2 vv[8];
#pragma unroll
        for (int s = 0; s < 8; ++s) vv[s] = *(const u32x2*)(VG + (size_t)(NPR + b * 8 + s) * 512 + c4);
#pragma unroll
        for (int s = 0; s < 8; ++s) { const float w0 = s < 4 ? wa[s & 3] : wb[s & 3]; const float w = (s <= t) ? w0 : 0.f;
            z[0] += w * __uint_as_float(vv[s].x << 16); z[1] += w * __uint_as_float(vv[s].x & 0xffff0000u); z[2] += w * __uint_as_float(vv[s].y << 16); z[3] += w * __uint_as_float(vv[s].y & 0xffff0000u); }
        const float bs = p.in[17][(layer * 4 + g) * 128 + t];
        const u32x2 uu = *(const u32x2*)(U + (size_t)(NPR + r) * 512 + c4);
        f32x4 o; o[0] = __uint_as_float(uu.x << 16) * (z[0] + bs); o[1] = __uint_as_float(uu.x & 0xffff0000u) * (z[1] + bs);
        o[2] = __uint_as_float(uu.y << 16) * (z[2] + bs); o[3] = __uint_as_float(uu.y & 0xffff0000u) * (z[3] + bs);
        *(u32x2*)(MIX + (size_t)(NPR + r) * 1024 + 512 + c4) = pack4(o);
    }
}

__device__ __forceinline__ void phase_fix(const Params& p, int layer) {
    const bf16_t* HALO = (const bf16_t*)(p.ws + W_HALO); bf16_t* ACT = (bf16_t*)(p.ws + W_R);
    const float* cw = p.in[21] + (size_t)layer * 3 * 5632; const float* cb = p.in[22] + (size_t)layer * 5632;
    const int gtid = blockIdx.x * 512 + tid_opaque(), gn = gridDim.x * 512;
    for (int idx = gtid; idx < 256 * 704; idx += gn) {
        const int blk = idx / 704, c = (idx % 704) * 4;
        const bf16_t* own = HALO + (size_t)blk * 4 * 5632; const bf16_t* prv = own - 4 * 5632;
        const bool first = (blk & 63) == 0;
        f32x4 a0, a1;
        f32x4 cg[2], cu[2];
#pragma unroll
        for (int h = 0; h < 2; ++h) {
            const int cc = c + h * 2816;
            const f32x4 w0 = *(const f32x4*)(cw + cc), w1 = *(const f32x4*)(cw + 5632 + cc), w2 = *(const f32x4*)(cw + 11264 + cc), bb = *(const f32x4*)(cb + cc);
            const f32x4 zero = (f32x4){0.f, 0.f, 0.f, 0.f};
            const f32x4 m2 = first ? zero : unpack4(*(const u32x2*)(prv + 2 * 5632 + cc)), m1 = first ? zero : unpack4(*(const u32x2*)(prv + 3 * 5632 + cc));
            const f32x4 o0 = unpack4(*(const u32x2*)(own + cc)), o1 = unpack4(*(const u32x2*)(own + 5632 + cc));
            const f32x4 r0 = bb + w0 * m2 + w1 * m1 + w2 * o0, r1 = bb + w0 * m1 + w1 * o0 + w2 * o1;
            if (h == 0) { cg[0] = r0; cg[1] = r1; } else { cu[0] = r0; cu[1] = r1; }
        }
#pragma unroll
        for (int e = 0; e < 4; ++e) { a0[e] = silu_f(cg[0][e]) * cu[0][e]; a1[e] = silu_f(cg[1][e]) * cu[1][e]; }
        *(u32x2*)(ACT + (size_t)(blk * 64) * 2816 + c) = pack4(a0);
        *(u32x2*)(ACT + (size_t)(blk * 64 + 1) * 2816 + c) = pack4(a1);
    }
}

#define XB_TMO      128
#define XB_XCNT(j)  (256  + 64 * (j))
#define XB_XSUB(j)  (1280 + 64 * (j))
#define XB_XGEN(j)  (2304 + 64 * (j))
#define XB_TOP      3328
#define XB_TOPGEN   3392
#define XCD_BAR_WORDS 3456
#define XB_SPIN_CAP (1u << 18)
__device__ __forceinline__ unsigned xb_ld(unsigned* p)              { return __hip_atomic_load(p, __ATOMIC_RELAXED, __HIP_MEMORY_SCOPE_AGENT); }
__device__ __forceinline__ unsigned xb_add(unsigned* p, unsigned v) { return __hip_atomic_fetch_add(p, v, __ATOMIC_RELAXED, __HIP_MEMORY_SCOPE_AGENT); }
__device__ __forceinline__ unsigned xb_xcc_id() { return (unsigned)__builtin_amdgcn_s_getreg((3 << 11) | 20) & 0xFu; }
#define XB_SPIN(cond, bar) do { unsigned _sp = 0; while (cond) { __builtin_amdgcn_s_sleep(1); \
    if ((++_sp & 255u) == 0u) { if (xb_ld(&(bar)[XB_TMO])) break; if (_sp > XB_SPIN_CAP) { atomicAdd(&(bar)[XB_TMO], 1u); break; } } } } while (0)
struct XcdBarrier { unsigned* bar; unsigned x; volatile LAS unsigned* st; };
__device__ __forceinline__ XcdBarrier xcd_barrier_post(unsigned* bar, volatile LAS unsigned* st) {
    XcdBarrier b; b.bar = bar; b.x = xb_xcc_id(); b.st = st;
    if (threadIdx.x == 0) (void)xb_add(&bar[XB_XCNT(b.x)], 1u);
    return b;
}
__device__ __forceinline__ void xcd_barrier_complete(unsigned* bar, unsigned x, unsigned& nloc, unsigned& nx) {
    const unsigned G = gridDim.x * gridDim.y * gridDim.z;
    unsigned sum, cnt, mine, sp = 0u;
    for (;;) {
        sum = 0u; cnt = 0u; mine = 0u;
#pragma unroll
        for (unsigned j = 0; j < 16; ++j) { const unsigned c = xb_ld(&bar[XB_XCNT(j)]); sum += c; cnt += (c > 0u) ? 1u : 0u; mine = (j == x) ? c : mine; }
        if (sum == G) break;
        __builtin_amdgcn_s_sleep(1);
        if ((++sp & 255u) == 0u) { if (xb_ld(&bar[XB_TMO])) break; if (sp > XB_SPIN_CAP) { atomicAdd(&bar[XB_TMO], 1u); break; } }
    }
    nloc = mine > 0u ? mine : 1u; nx = cnt > 0u ? cnt : 1u;
}
__device__ __forceinline__ void xcd_barrier(const XcdBarrier& b) {
    asm volatile("s_waitcnt vmcnt(0)" ::: "memory");
    __syncthreads();
    if (threadIdx.x == 0) {
        unsigned* bar = b.bar;
        __builtin_amdgcn_s_waitcnt(0);
        unsigned nloc = b.st[0], nx = b.st[1];
        if (nloc == 0u) { xcd_barrier_complete(bar, b.x, nloc, nx); b.st[0] = nloc; b.st[1] = nx; }
        const unsigned old = xb_add(&bar[XB_XSUB(b.x)], 1u);
        const unsigned gen = old / nloc;
        if (old + 1u == (gen + 1u) * nloc) {
            __builtin_amdgcn_fence(__ATOMIC_RELEASE, "agent");
            asm volatile("s_waitcnt vmcnt(0)" ::: "memory");
            const unsigned og = xb_add(&bar[XB_TOP], 1u);
            const unsigned tg = og / nx;
            if (og + 1u == (tg + 1u) * nx) xb_add(&bar[XB_TOPGEN], 1u);
            else XB_SPIN(xb_ld(&bar[XB_TOPGEN]) == tg, bar);
            __builtin_amdgcn_fence(__ATOMIC_ACQUIRE, "agent");
            xb_add(&bar[XB_XGEN(b.x)], 1u);
            asm volatile("s_waitcnt vmcnt(0)" ::: "memory");
        } else {
            XB_SPIN(xb_ld(&bar[XB_XGEN(b.x)]) == gen, bar);
            __builtin_amdgcn_fence(__ATOMIC_ACQUIRE, "agent");
            asm volatile("s_waitcnt vmcnt(0)" ::: "memory");
        }
    }
    __syncthreads();
}

__device__ __forceinline__ void run_phase(const Params& p, int ph, unsigned char* shm) {
    LAS unsigned char* lds = (LAS unsigned char*)shm;
    float* MOD = (float*)(p.ws + W_MOD);
    const int nb = gridDim.x, bid = blockIdx.x;
    if (ph == 0) { phase_prep(p, shm); return; }
    if (ph == 1) {
        const int ng = nb > 96 ? 48 : 0;
        if (ng == 0 || bid < ng) {
            pg8::StaticOrder S; S.init(256, 12288, 1024, ng ? ng : nb, bid, false);
            pg8::Gemm g{(const bf16_t*)(p.ws + W_CS), (const bf16_t*)(p.ws + W_ADA), 256, 12288, 1024};
            EpiMod E{MOD, p.in[8]};
            pg8::gemm_phase(lds, g, S, E);
        }
        if (ng == 0 || bid >= ng) {
            const int nc = ng ? nb - ng : nb, c0 = ng ? bid - ng : bid;
            conv_run<false>(p, c0, nc, 1408, (float*)shm);
        }
        return;
    }
    const int layer = (ph - 2) >> 3, sub = (ph - 2) & 7;
    const float* modl = MOD + layer * 6144;
    bf16_t* XB = (bf16_t*)(p.ws + W_XB);
    unsigned* tick = (unsigned*)(p.ws + W_BAR + 16384);
    pg8::StaticOrder S;
    switch (sub) {
    case 0: if (layer == 0) phase_norm<false>(p.in[0], p.in[1], nullptr, p.in[9], modl + 0, modl + 1024, (bf16_t*)(p.ws + W_H));
            else phase_norm<true>(nullptr, nullptr, XB, p.in[9] + layer * 1024, modl + 0, modl + 1024, (bf16_t*)(p.ws + W_H));
            break;
    case 1: { S.init(MT, 1792, 1024, nb, bid, false); S.reverse = 1;
        pg8::Gemm g{(const bf16_t*)(p.ws + W_H), (const bf16_t*)(p.ws + W_IN) + (size_t)layer * 1792 * 1024, MT, 1792, 1024};
        EpiIn E{layer, p.in[11] + layer * 64, p.in[12] + layer * 64, p.in[14] + layer * 512, p.in[15] + layer * 512, (const float*)(p.ws + W_ROPE),
                (bf16_t*)(p.ws + W_Q), (bf16_t*)(p.ws + W_KB), (bf16_t*)(p.ws + W_VB), (bf16_t*)(p.ws + W_U), (bf16_t*)(p.ws + W_VG), p.out};
        pg8::gemm_phase(lds, g, S, E); } break;
    case 2: phase_mix(p, layer, shm); break;
    case 3: { S.init(MT, 1024, 1024, nb, bid, true);
        pg8::Gemm g{(const bf16_t*)(p.ws + W_MIX), (const bf16_t*)(p.ws + W_OUT) + (size_t)layer * 1024 * 1024, MT, 1024, 1024};
        if (layer == 0) { EpiRes<false, true> E{p.in[0], p.in[1], nullptr, nullptr, XB, modl + 2048, p.ws, tick + (layer * 2 + 0) * 128}; pg8::gemm_phase(lds, g, S, E); }
        else { EpiRes<true, true> E{nullptr, nullptr, XB, nullptr, XB, modl + 2048, p.ws, tick + (layer * 2 + 0) * 128}; pg8::gemm_phase(lds, g, S, E); }
        } break;
    case 4: phase_norm<true>(nullptr, nullptr, XB, p.in[19] + layer * 1024, modl + 3072, modl + 4096, (bf16_t*)(p.ws + W_H)); break;
    case 5: { S.init(MT, 5632, 1024, nb, bid, false); S.reverse = 1;
        pg8::Gemm g{(const bf16_t*)(p.ws + W_H), (const bf16_t*)(p.ws + W_FIN) + (size_t)layer * 5632 * 1024, MT, 5632, 1024};
        EpiFfnIn E{p.in[21] + (size_t)layer * 3 * 5632, p.in[22] + (size_t)layer * 5632, p.in[4] + (size_t)layer * 128 * 2 * 5632,
                   (bf16_t*)(p.ws + W_R), (bf16_t*)(p.ws + W_HALO), p.out + O_NCS + (size_t)layer * 128 * 2 * 5632, p.out + O_NCP + (size_t)layer * 4 * 2 * 5632};
        pg8::gemm_phase(lds, g, S, E); } break;
    case 6: phase_fix(p, layer); break;
    case 7: { S.init(MT, 1024, 2816, nb, bid, true);
        pg8::Gemm g{(const bf16_t*)(p.ws + W_R), (const bf16_t*)(p.ws + W_FOUT) + (size_t)layer * 1024 * 2816, MT, 1024, 2816};
        if (layer == 0) { EpiRes<true, true> E{nullptr, nullptr, XB, nullptr, XB, modl + 5120, p.ws, tick + (layer * 2 + 1) * 128}; pg8::gemm_phase(lds, g, S, E); }
        else { EpiRes<true, false> E{nullptr, nullptr, XB, p.out, nullptr, modl + 5120, p.ws, tick + (layer * 2 + 1) * 128}; pg8::gemm_phase(lds, g, S, E); }
        } break;
    }
}

__global__ __launch_bounds__(512, 2) void mega_fwd(Params p) {
    extern __shared__ __attribute__((aligned(16))) unsigned char shm[];
    cg::grid_group grid = cg::this_grid();
    const int lo = p.ph_lo, hi = p.ph_hi;
    if (lo < 0) grid.sync();
    volatile LAS unsigned* st = (volatile LAS unsigned*)((LAS unsigned char*)shm + LDS_MISC);
    if (threadIdx.x < 4) st[threadIdx.x] = 0u;
    __syncthreads();
    XcdBarrier xb; xb.bar = (unsigned*)(p.ws + W_BAR); xb.x = 0; xb.st = st;
    if (hi - lo > 1) xb = xcd_barrier_post((unsigned*)(p.ws + W_BAR), st);
#ifndef PROBE_DUP
#define PROBE_DUP -1
#endif
#define PHASE(k) do { if (lo <= (k) && (k) < hi) run_phase(p, (k), shm); if (lo <= (k) && (k) + 1 < hi) xcd_barrier(xb); \
        if ((k) == PROBE_DUP) { run_phase(p, (k), shm); xcd_barrier(xb); } } while (0)
    PHASE(0); PHASE(1); PHASE(2); PHASE(3); PHASE(4); PHASE(5); PHASE(6); PHASE(7); PHASE(8); PHASE(9);
    PHASE(10); PHASE(11); PHASE(12); PHASE(13); PHASE(14); PHASE(15); PHASE(16); PHASE(17);
#undef PHASE
}

extern "C" void kernel_launch(void* const* d_in, const int* in_sizes, int n_in, void* d_out, int out_size, void* d_ws, size_t ws_size, hipStream_t stream) {
    static int grid = 0;
    if (grid == 0) {
        if (n_in != 24 || ws_size < W_END) { fprintf(stderr, "kernel_launch: unexpected n_in %d / ws %zu (need %zu)\n", n_in, ws_size, (size_t)W_END); grid = -1; return; }
        int dev = 0, cus = 0, per_cu = 0;
        hipGetDevice(&dev); hipDeviceGetAttribute(&cus, hipDeviceAttributeMultiprocessorCount, dev);
        if (hipFuncSetAttribute((const void*)mega_fwd, hipFuncAttributeMaxDynamicSharedMemorySize, LDS_BYTES) != hipSuccess) { fprintf(stderr, "kernel_launch: hipFuncSetAttribute failed\n"); grid = -1; return; }
        if (hipOccupancyMaxActiveBlocksPerMultiprocessor(&per_cu, (const void*)mega_fwd, 512, LDS_BYTES) != hipSuccess || per_cu < 1) { fprintf(stderr, "kernel_launch: occupancy query says %d\n", per_cu); per_cu = 1; }
        (void)hipGetLastError();
        grid = cus * 1;
        if (grid > 256) grid = 256;
    }
    if (grid < 0) return;
    Params p{};
    for (int i = 0; i < 24; ++i) p.in[i] = (const float*)d_in[i];
    p.out = (float*)d_out; p.ws = (unsigned char*)d_ws;
    for (int a = 0; a < 8; ++a) p.inv[a] = std::pow(500000.0, -(double)a / 8.0);
#if ONE_LAUNCH
    (void)hipMemsetAsync((char*)d_ws + W_BAR, 0, 32768, stream);
    p.ph_lo = 0; p.ph_hi = NPH;
    void* args[] = {&p};
    hipError_t e = hipLaunchCooperativeKernel((const void*)mega_fwd, dim3(grid), dim3(512), args, LDS_BYTES, stream);
    if (e != hipSuccess) fprintf(stderr, "cooperative launch failed: %s (grid %d)\n", hipGetErrorString(e), grid);
#else
    for (int ph = 0; ph < NPH; ++ph) {
        p.ph_lo = ph; p.ph_hi = ph + 1;
        hipLaunchKernelGGL(mega_fwd, dim3(grid), dim3(512), LDS_BYTES, stream, p);
    }
#endif
}
#ifdef TESTK
__global__ __launch_bounds__(512, 2) void tk(const bf16_t* A, const bf16_t* B, float* MOD, const float* bias) {
    extern __shared__ __attribute__((aligned(16))) unsigned char shm2[];
    pg8::StaticOrder S; S.init(256, 12288, 1024, gridDim.x, blockIdx.x, true);
    pg8::Gemm g{A, B, 256, 12288, 1024}; EpiMod E{MOD, bias};
    pg8::gemm_phase((LAS unsigned char*)shm2, g, S, E);
}
#endif
```
